# Optimizing an MI355X kernel written in HIP

```python
import jax, jax.numpy as jnp
from jax import lax
import numpy as np

D_MODEL = 1024
BATCH = 16
SEQ = 256
DEPTH = 2
DEC_BATCH = 2
DEC_SEQ = 1024
PAST_LEN = 256

GRID_W = 64
W_A = D_MODEL // 2
N_POOL_GROUPS = 4
POOL_GROUP = W_A // N_POOL_GROUPS
POOL_HALF = (1, 2, 4, 8)
N_HEADS_B = 8
HEAD_DIM_B = (D_MODEL // 2) // N_HEADS_B
W_B = N_HEADS_B * HEAD_DIM_B
WIN_H = 8
WIN_W = 16
W_C = D_MODEL // 2
W_D = D_MODEL // 2
CONV_C = 3
CONV_D = 31
N_EVEN = (DEPTH + 1) // 2
N_ODD = DEPTH // 2
IN_EVEN = 2 * W_A + 4 * W_B
IN_ODD = 4 * W_C + 3 * W_D
EPS = 1e-6

kernel_name = "hybrid_pool_natten_conv_dit_step"


def rmsnorm(x, g):
    xf = x.astype(jnp.float32)
    y = xf * lax.rsqrt(jnp.mean(xf * xf, axis=-1, keepdims=True) + EPS)
    return (y * g.astype(jnp.float32)).astype(x.dtype)


def layernorm(x, g, b):
    xf = x.astype(jnp.float32)
    mu = jnp.mean(xf, axis=-1, keepdims=True)
    var = jnp.mean(jnp.square(xf - mu), axis=-1, keepdims=True)
    y = (xf - mu) * lax.rsqrt(var + EPS)
    return (y * g.astype(jnp.float32) + b.astype(jnp.float32)).astype(x.dtype)


def modulated_norm(x, cond, norm_g, w_mod, b_mod):
    m = jax.nn.silu(cond) @ w_mod + b_mod
    shift, scale, gate = jnp.split(m, 3, axis=-1)
    return rmsnorm(x, norm_g) * (1 + scale) + shift, gate


def depthwise_conv(x, w, width):
    return lax.conv_general_dilated(x, w[:, None, :], window_strides=(1,),
                                    padding=[(width // 2, width // 2)],
                                    dimension_numbers=('NWC', 'WIO', 'NWC'),
                                    feature_group_count=x.shape[-1])


def pool_mixer(u, w_pool, pool_scale):
    bsz, t, _ = u.shape
    uf = u.astype(jnp.float32).reshape(bsz, t, N_POOL_GROUPS, POOL_GROUP)
    cs = jnp.concatenate([jnp.zeros((bsz, 1, N_POOL_GROUPS, POOL_GROUP), jnp.float32),
                          jnp.cumsum(uf, axis=1)], axis=1)
    pos = jnp.arange(t)[:, None]
    half = jnp.array(POOL_HALF, dtype=jnp.int32)[None, :]
    lo = jnp.clip(pos - half, 0, t)
    hi = jnp.clip(pos + half, 0, t)
    gidx = jnp.arange(N_POOL_GROUPS)[None, :]
    win_sum = cs[:, hi, gidx] - cs[:, lo, gidx]
    mean = win_sum / (hi - lo).astype(jnp.float32)[None, :, :, None]
    p = (mean - uf).astype(u.dtype)
    y = jnp.einsum('btgc,gcd->btgd', p, w_pool).reshape(bsz, t, W_A)
    return y * pool_scale


def context_attention(q, k, v):
    bsz, l = q.shape[:2]
    s = jnp.einsum('bqhd,bkhd->bhqk', q, k).astype(jnp.float32) * (HEAD_DIM_B ** -0.5)
    p = jax.nn.softmax(s, axis=-1).astype(v.dtype)
    return jnp.einsum('bhqk,bkhd->bqhd', p, v).reshape(bsz, l, W_B)


def neighbourhood_attention(q, k, v, kc, vc, rpb):
    bsz, t = q.shape[:2]
    rows = t // GRID_W
    kh = min(WIN_H, rows)
    kw = min(WIN_W, GRID_W)
    qg = q.reshape(bsz, rows, GRID_W, N_HEADS_B, HEAD_DIM_B)
    kg = k.reshape(bsz, rows, GRID_W, N_HEADS_B, HEAD_DIM_B)
    vg = v.reshape(bsz, rows, GRID_W, N_HEADS_B, HEAD_DIM_B)
    r = jnp.arange(rows)
    row_idx = jnp.clip(r - kh // 2, 0, rows - kh)[:, None] + jnp.arange(kh)[None, :]
    k_band = kg[:, row_idx]
    v_band = vg[:, row_idx]
    col = jnp.arange(GRID_W)
    col_start = jnp.clip(col - kw // 2, 0, GRID_W - kw)
    col_ok = (col[None, :] >= col_start[:, None]) & (col[None, :] < col_start[:, None] + kw)
    dr = row_idx - r[:, None] + (WIN_H - 1)
    dc = jnp.clip(col[None, :] - col[:, None], -(WIN_W - 1), WIN_W - 1) + (WIN_W - 1)
    bias = rpb[:, dr[:, None, :, None], dc[None, :, None, :]].astype(jnp.float32)
    scale = HEAD_DIM_B ** -0.5
    s_loc = jnp.einsum('brqhd,brkwhd->bhrqkw', qg, k_band).astype(jnp.float32) * scale + bias
    s_loc = jnp.where(col_ok[:, None, :], s_loc, -jnp.inf)
    s_ctx = jnp.einsum('brqhd,bhld->bhrql', qg, kc).astype(jnp.float32) * scale
    n_loc = kh * GRID_W
    s = jnp.concatenate([s_loc.reshape(bsz, N_HEADS_B, rows, GRID_W, n_loc), s_ctx], axis=-1)
    p = jax.nn.softmax(s, axis=-1).astype(v.dtype)
    p_loc = p[..., :n_loc].reshape(bsz, N_HEADS_B, rows, GRID_W, kh, GRID_W)
    p_ctx = p[..., n_loc:]
    o = (jnp.einsum('bhrqkw,brkwhd->brqhd', p_loc, v_band)
         + jnp.einsum('bhrql,bhld->brqhd', p_ctx, vc))
    return o.reshape(bsz, t, W_B)


def even_layer(x, cond, ctx_kv, norm_g, w_mod, b_mod, w_in, w_pool, pool_scale, rpb, w_out):
    bsz, t, _ = x.shape
    h, gate = modulated_norm(x, cond, norm_g, w_mod, b_mod)
    proj = h @ w_in
    u_a, g_a, q, k, v, g_b = jnp.split(
        proj, [W_A, 2 * W_A, 2 * W_A + W_B, 2 * W_A + 2 * W_B, 2 * W_A + 3 * W_B], axis=-1)
    q = q.reshape(bsz, t, N_HEADS_B, HEAD_DIM_B)
    k = k.reshape(bsz, t, N_HEADS_B, HEAD_DIM_B)
    v = v.reshape(bsz, t, N_HEADS_B, HEAD_DIM_B)
    a_out = pool_mixer(u_a, w_pool, pool_scale) * jax.nn.silu(g_a)
    if ctx_kv is None:
        att = context_attention(q, k, v)
        kv = (k.transpose(0, 2, 1, 3), v.transpose(0, 2, 1, 3))
    else:
        att = neighbourhood_attention(q, k, v, ctx_kv[0], ctx_kv[1], rpb)
        kv = None
    b_out = att * jax.nn.silu(g_b)
    y = jnp.concatenate([a_out, b_out], axis=-1) @ w_out
    return x + gate * y, kv


def odd_layer(x, cond, norm_g, w_mod, b_mod, w_in, conv_c, conv_d, conv_d_b, ln_g, ln_b, w_out):
    h, gate = modulated_norm(x, cond, norm_g, w_mod, b_mod)
    proj = h @ w_in
    b_c, c_c, x_c, g_c, a_d, b_d, g_d = jnp.split(
        proj, [W_C, 2 * W_C, 3 * W_C, 4 * W_C, 4 * W_C + W_D, 4 * W_C + 2 * W_D], axis=-1)
    c_out = b_c * depthwise_conv(c_c * x_c, conv_c, CONV_C) * jax.nn.silu(g_c)
    z = depthwise_conv(a_d * jax.nn.sigmoid(b_d), conv_d, CONV_D) + conv_d_b
    z = jax.nn.silu(layernorm(z, ln_g, ln_b))
    d_out = z * jax.nn.silu(g_d)
    y = jnp.concatenate([c_out, d_out], axis=-1) @ w_out
    return x + gate * y


def setup_inputs(seed: int = 0) -> dict:
    key = jax.random.key(seed)
    ks = jax.random.split(key, 24)
    nrm = lambda k, s: jax.random.normal(k, s, jnp.float32)
    D = D_MODEL
    return {
        "x_prompt": nrm(ks[0], (BATCH, SEQ, D)),
        "x_sample": nrm(ks[1], (DEC_BATCH, DEC_SEQ, D)),
        "cache_k": nrm(ks[2], (DEC_BATCH, N_EVEN, N_HEADS_B, PAST_LEN, HEAD_DIM_B)),
        "cache_v": nrm(ks[3], (DEC_BATCH, N_EVEN, N_HEADS_B, PAST_LEN, HEAD_DIM_B)),
        "c": nrm(ks[4], (DEC_BATCH, D)),
        "c_ctx": nrm(ks[5], (D,)),
        "norm_g": 1.0 + 0.02 * nrm(ks[6], (DEPTH, D)),
        "w_mod": 0.5 * D ** -0.5 * nrm(ks[7], (DEPTH, D, 3 * D)),
        "b_mod": 0.02 * nrm(ks[8], (DEPTH, 3 * D)),
        "w_in_even": D ** -0.5 * nrm(ks[9], (N_EVEN, D, IN_EVEN)),
        "w_pool": POOL_GROUP ** -0.5 * nrm(ks[10], (N_EVEN, N_POOL_GROUPS, POOL_GROUP, POOL_GROUP)),
        "pool_scale": 1.0 + 0.1 * nrm(ks[11], (N_EVEN, W_A)),
        "rpb": 0.1 * nrm(ks[12], (N_EVEN, N_HEADS_B, 2 * WIN_H - 1, 2 * WIN_W - 1)),
        "w_out_even": (W_A + W_B) ** -0.5 * nrm(ks[13], (N_EVEN, W_A + W_B, D)),
        "w_in_odd": D ** -0.5 * nrm(ks[14], (N_ODD, D, IN_ODD)),
        "conv_c": CONV_C ** -0.5 * nrm(ks[15], (N_ODD, CONV_C, W_C)),
        "conv_d": CONV_D ** -0.5 * nrm(ks[16], (N_ODD, CONV_D, W_D)),
        "conv_d_b": 0.02 * nrm(ks[17], (N_ODD, W_D)),
        "ln_g": 1.0 + 0.02 * nrm(ks[18], (N_ODD, W_D)),
        "ln_b": 0.02 * nrm(ks[19], (N_ODD, W_D)),
        "w_out_odd": (W_C + W_D) ** -0.5 * nrm(ks[20], (N_ODD, W_C + W_D, D)),
        "final_g": 1.0 + 0.02 * nrm(ks[21], (D,)),
    }


def reference(x_prompt, x_sample, cache_k, cache_v, c, c_ctx, norm_g, w_mod, b_mod,
              w_in_even, w_pool, pool_scale, rpb, w_out_even, w_in_odd, conv_c, conv_d,
              conv_d_b, ln_g, ln_b, w_out_odd, final_g):
    cond_ctx = c_ctx[None, None, :]
    cond_lat = c[:, None, :]
    xp, xs = x_prompt, x_sample
    new_k, new_v = [], []
    for layer in range(DEPTH):
        i = layer // 2
        common = (norm_g[layer], w_mod[layer], b_mod[layer])
        if layer % 2 == 0:
            ew = (w_in_even[i], w_pool[i], pool_scale[i], rpb[i], w_out_even[i])
            xp, kv = even_layer(xp, cond_ctx, None, *common, *ew)
            new_k.append(kv[0])
            new_v.append(kv[1])
            xs, _ = even_layer(xs, cond_lat, (cache_k[:, i], cache_v[:, i]), *common, *ew)
        else:
            ow = (w_in_odd[i], conv_c[i], conv_d[i], conv_d_b[i], ln_g[i], ln_b[i], w_out_odd[i])
            xp = odd_layer(xp, cond_ctx, *common, *ow)
            xs = odd_layer(xs, cond_lat, *common, *ow)
    y_prompt = rmsnorm(xp, final_g)
    y_sample = rmsnorm(xs, final_g)
    new_cache_k = jnp.stack(new_k, axis=1)
    new_cache_v = jnp.stack(new_v, axis=1)
    return (y_prompt, y_sample, new_cache_k, new_cache_v)
```

```cpp
#include <hip/hip_runtime.h>
#include <hip/hip_cooperative_groups.h>
#include <cstdio>
namespace cg = cooperative_groups;

#define PROBE_REPEAT 0x00
#define PROBE_SYNC2 0
#ifndef MULTI_LAUNCH
#define MULTI_LAUNCH 0
#endif

typedef unsigned short u16;
using bf16x8 = __attribute__((ext_vector_type(8))) short;
using f32x4 = __attribute__((ext_vector_type(4))) float;
using u32x4 = __attribute__((ext_vector_type(4))) unsigned;
using u32x2 = __attribute__((ext_vector_type(2))) unsigned;

constexpr int D = 1024;
constexpr int NP = 4096;
constexpr int NS = 2048;
constexpr int NTOK = NP + NS;
constexpr int IN_E = 3072;
constexpr int IN_O = 3584;
constexpr int NTHR = 256;
constexpr int SMEM_BYTES = 64 * 1024;

struct P {
  const float *x_prompt, *x_sample, *cache_k, *cache_v, *c, *c_ctx, *norm_g, *w_mod, *b_mod, *w_in_even, *w_pool,
      *pool_scale, *rpb, *w_out_even, *w_in_odd, *conv_c, *conv_d, *conv_d_b, *ln_g, *ln_b, *w_out_odd, *final_g;
  float* out;
  float* mod;
  u16 *wt_in_even, *wt_out_even, *wt_in_odd, *wt_out_odd, *wpt;
  u16 *h, *proj, *cat;
  u16 *kcb, *vcb;
  float *rowss;
  float *bias1;
  float* x1;
  unsigned* bar;
  unsigned long long use_cg;
};

typedef __bf16 hbf2 __attribute__((ext_vector_type(2)));
typedef float hf2 __attribute__((ext_vector_type(2)));
__device__ __forceinline__ unsigned pack2(float a, float b) {
  const hf2 v = {a, b};
  return __builtin_bit_cast(unsigned, __builtin_convertvector(v, hbf2));
}
__device__ __forceinline__ u16 f2bf(float f) { return (u16)(pack2(f, 0.f) & 0xffffu); }
__device__ __forceinline__ float bf2f(u16 h) { return __uint_as_float(((unsigned)h) << 16); }
using nf4 = __attribute__((ext_vector_type(4))) float;
__device__ __forceinline__ float4 ld_nt(const float* p) {
  const nf4 v = __builtin_nontemporal_load(reinterpret_cast<const nf4*>(p));
  return make_float4(v.x, v.y, v.z, v.w);
}
__device__ __forceinline__ void st_nt(float* p, float4 v) {
  nf4 q; q.x = v.x; q.y = v.y; q.z = v.z; q.w = v.w;
  __builtin_nontemporal_store(q, reinterpret_cast<nf4*>(p));
}
__device__ __forceinline__ float bflo(unsigned u) { return __uint_as_float(u << 16); }
__device__ __forceinline__ float bfhi(unsigned u) { return __uint_as_float(u & 0xffff0000u); }
__device__ __forceinline__ float silu_f(float x) { return x * __builtin_amdgcn_rcpf(1.f + __expf(-x)); }
__device__ __forceinline__ float sigmoid_f(float x) { return __builtin_amdgcn_rcpf(1.f + __expf(-x)); }
__device__ __forceinline__ float wave_sum(float v) {
#pragma unroll
  for (int o = 32; o >= 1; o >>= 1) v += __shfl_xor(v, o);
  return v;
}
__device__ __forceinline__ int cond_of_token(int tok) { return tok < NP ? 0 : 1 + ((tok - NP) >> 10); }

__device__ void mod_unit(const P& p, int u, float* sm) {
  const int layer = u / 96, cg32 = u % 96;
  const int tid = threadIdx.x;
  float* sc = sm;
  float* red = sm + 3 * 1024;
  __syncthreads();
#pragma unroll
  for (int q = 0; q < 12; ++q) {
    const int i = tid + q * NTHR;
    const int cv = i >> 10, k = i & 1023;
    const float v = (cv == 0) ? p.c_ctx[k] : p.c[(cv - 1) * 1024 + k];
    sc[i] = silu_f(v);
  }
  __syncthreads();
  const int cq = tid & 7, ks = tid >> 3;
  const float* W = p.w_mod + (size_t)layer * 1024 * 3072 + cg32 * 32 + cq * 4;
  float a[3][4] = {};
#pragma unroll 8
  for (int i = 0; i < 32; ++i) {
    int k = ks * 32 + i;
    const nf4 wq = __builtin_nontemporal_load(reinterpret_cast<const nf4*>(W + (size_t)k * 3072));
    float4 w = make_float4(wq.x, wq.y, wq.z, wq.w);
#pragma unroll
    for (int cv = 0; cv < 3; ++cv) {
      float s = sc[cv * 1024 + k];
      a[cv][0] += s * w.x; a[cv][1] += s * w.y; a[cv][2] += s * w.z; a[cv][3] += s * w.w;
    }
  }
#pragma unroll
  for (int cv = 0; cv < 3; ++cv)
#pragma unroll
    for (int j = 0; j < 4; ++j) {
      float v = a[cv][j];
      v += __shfl_xor(v, 8); v += __shfl_xor(v, 16); v += __shfl_xor(v, 32);
      a[cv][j] = v;
    }
  const int lane = tid & 63, wid = tid >> 6;
  if (lane < 8) {
#pragma unroll
    for (int cv = 0; cv < 3; ++cv)
#pragma unroll
      for (int j = 0; j < 4; ++j) red[wid * 96 + cv * 32 + lane * 4 + j] = a[cv][j];
  }
  __syncthreads();
  if (tid < 96) {
    int cv = tid >> 5, col = tid & 31;
    float v = red[tid] + red[96 + tid] + red[192 + tid] + red[288 + tid];
    int n = cg32 * 32 + col;
    v += p.b_mod[layer * 3072 + n];
    p.mod[(layer * 3 + cv) * 3072 + n] = v;
  }
}

__device__ __forceinline__ int perm_row_general(int s) {
  const int tile = s >> 7, c = s & 127, wc = c >> 6, q = c & 63;
  const int n = ((q >> 5) << 1) | ((q >> 2) & 1), i = (((q >> 3) & 3) << 2) | (q & 3);
  return tile * 128 + wc * 64 + n * 16 + i;
}
__device__ __forceinline__ int perm_row_odd(int s) {
  if (s >= 3072) return perm_row_general(s);
  const int region = s >> 9, ch = s & 511;
  const int type = (region == 0 || region == 3) ? 0 : (region <= 2 ? 1 : 2);
  const int member = (region == 0 || region == 1 || region == 4) ? 0 : 1;
  const int chunk = ch >> 6, wc = (ch >> 5) & 1, cw = ch & 31;
  const int n = member * 2 + ((cw >> 2) & 1), i = ((cw >> 3) << 2) | (cw & 3);
  return (type * 8 + chunk) * 128 + wc * 64 + n * 16 + i;
}
template <int MODE>
__device__ void transpose_tile(const float* __restrict__ src, u16* __restrict__ dst, int K, int N, int t, float* sm) {
  const int tid = threadIdx.x;
  const int ntn = N >> 6;
  const int k0 = (t / ntn) * 64, n0 = (t % ntn) * 64;
  __syncthreads();
  {
    const int r = tid >> 4, c4 = tid & 15;
#pragma unroll
    for (int i = 0; i < 4; ++i) {
      int k = r + 16 * i;
      const nf4 vq = __builtin_nontemporal_load(reinterpret_cast<const nf4*>(src + (size_t)(k0 + k) * N + n0 + c4 * 4));
      float4 v = make_float4(vq.x, vq.y, vq.z, vq.w);
      float* d = sm + k * 65 + c4 * 4;
      d[0] = v.x; d[1] = v.y; d[2] = v.z; d[3] = v.w;
    }
  }
  __syncthreads();
  {
    const int kc = tid & 7, nl = tid >> 3;
#pragma unroll
    for (int i = 0; i < 2; ++i) {
      int n = nl + 32 * i;
      float v[8];
#pragma unroll
      for (int j = 0; j < 8; ++j) v[j] = sm[(kc * 8 + j) * 65 + n];
      u32x4 o;
      o.x = pack2(v[0], v[1]); o.y = pack2(v[2], v[3]); o.z = pack2(v[4], v[5]); o.w = pack2(v[6], v[7]);
      const int drow = MODE == 0 ? (n0 + n) : (MODE == 1 ? perm_row_general(n0 + n) : perm_row_odd(n0 + n));
      *reinterpret_cast<u32x4*>(dst + (size_t)drow * K + k0 + kc * 8) = o;
    }
  }
}

struct TpDesc { const float* src; u16* dst; int K, N, mode, k0, n0; };
__device__ __forceinline__ TpDesc tp_desc(const P& p, int t) {
  TpDesc d;
  int tt;
  if (t < 768) { d.src = p.w_in_even; d.dst = p.wt_in_even; d.K = 1024; d.N = 3072; d.mode = 1; tt = t; }
  else if (t < 1024) { d.src = p.w_out_even; d.dst = p.wt_out_even; d.K = 1024; d.N = 1024; d.mode = 1; tt = t - 768; }
  else if (t < 1920) { d.src = p.w_in_odd; d.dst = p.wt_in_odd; d.K = 1024; d.N = 3584; d.mode = 2; tt = t - 1024; }
  else if (t < 2176) { d.src = p.w_out_odd; d.dst = p.wt_out_odd; d.K = 1024; d.N = 1024; d.mode = 1; tt = t - 1920; }
  else { const int q = t - 2176, g = q >> 2; d.src = p.w_pool + g * 16384; d.dst = p.wpt + g * 16384; d.K = 128; d.N = 128; d.mode = 0; tt = q & 3; }
  const int ntn = d.N >> 6;
  d.k0 = (tt / ntn) * 64; d.n0 = (tt % ntn) * 64;
  return d;
}
__device__ void transpose_stream(const P& p, int tfirst, int tstep, int tend, float* sm) {
  const int tid = threadIdx.x;
  const int r = tid >> 4, c4 = tid & 15;
  const int kc = tid & 7, nl = tid >> 3;
  if (tfirst >= tend) return;
  TpDesc d = tp_desc(p, tfirst);
  float4 v[4];
#pragma unroll
  for (int i = 0; i < 4; ++i) v[i] = ld_nt(d.src + (size_t)(d.k0 + r + 16 * i) * d.N + d.n0 + c4 * 4);
  for (int t = tfirst; t < tend; t += tstep) {
    __syncthreads();
#pragma unroll
    for (int i = 0; i < 4; ++i) {
      float* q = sm + (r + 16 * i) * 65 + c4 * 4;
      q[0] = v[i].x; q[1] = v[i].y; q[2] = v[i].z; q[3] = v[i].w;
    }
    const TpDesc cur = d;
    if (t + tstep < tend) {
      d = tp_desc(p, t + tstep);
#pragma unroll
      for (int i = 0; i < 4; ++i) v[i] = ld_nt(d.src + (size_t)(d.k0 + r + 16 * i) * d.N + d.n0 + c4 * 4);
    }
    __syncthreads();
#pragma unroll
    for (int i = 0; i < 2; ++i) {
      const int n = nl + 32 * i;
      float w[8];
#pragma unroll
      for (int j = 0; j < 8; ++j) w[j] = sm[(kc * 8 + j) * 65 + n];
      u32x4 o;
      o.x = pack2(w[0], w[1]); o.y = pack2(w[2], w[3]); o.z = pack2(w[4], w[5]); o.w = pack2(w[6], w[7]);
      const int sc = cur.n0 + n;
      const int drow = cur.mode == 0 ? sc : (cur.mode == 1 ? perm_row_general(sc) : perm_row_odd(sc));
      *reinterpret_cast<u32x4*>(cur.dst + (size_t)drow * cur.K + cur.k0 + kc * 8) = o;
    }
  }
}

__device__ void phase0(const P& p, char* smem) {
  float* sm = reinterpret_cast<float*>(smem);
  constexpr int T0 = 192, T1 = T0 + 768, T2 = T1 + 256, T3 = T2 + 896, T4 = T3 + 256, T5 = T4 + 16;
  auto do_unit = [&](int u) {
    if (u < T0) mod_unit(p, u, sm);
    else if (u < T1) transpose_tile<1>(p.w_in_even, p.wt_in_even, 1024, 3072, u - T0, sm);
    else if (u < T2) transpose_tile<1>(p.w_out_even, p.wt_out_even, 1024, 1024, u - T1, sm);
    else if (u < T3) transpose_tile<2>(p.w_in_odd, p.wt_in_odd, 1024, 3584, u - T2, sm);
    else if (u < T4) transpose_tile<1>(p.w_out_odd, p.wt_out_odd, 1024, 1024, u - T3, sm);
    else { int t = u - T4; int g = t >> 2; transpose_tile<0>(p.w_pool + g * 16384, p.wpt + g * 16384, 128, 128, t & 3, sm); }
  };
  if (gridDim.x == 512) {
    const int b = blockIdx.x;
    if (b < 192) {
      do_unit(b);
      transpose_stream(p, b, 192, 576, sm);
    } else {
      transpose_stream(p, 576 + (b - 192), 320, T5 - T0, sm);
    }
    return;
  }
  for (int u = blockIdx.x; u < T5; u += gridDim.x) do_unit(u);
}

__device__ void phase_norm(const P& p, int layer, const float* xa, const float* xb) {
  const int lane = threadIdx.x & 63, wid = threadIdx.x >> 6;
  if (layer == 0) {
    for (int prow = blockIdx.x * 4 + wid; prow < IN_O; prow += gridDim.x * 4) {
      const u16* wrow = p.wt_in_odd + (size_t)prow * D + lane * 16;
      const u32x4 w0 = *reinterpret_cast<const u32x4*>(wrow), w1 = *reinterpret_cast<const u32x4*>(wrow + 8);
      const float wf[16] = {bflo(w0.x), bfhi(w0.x), bflo(w0.y), bfhi(w0.y), bflo(w0.z), bfhi(w0.z), bflo(w0.w), bfhi(w0.w),
                            bflo(w1.x), bfhi(w1.x), bflo(w1.y), bfhi(w1.y), bflo(w1.z), bfhi(w1.z), bflo(w1.w), bfhi(w1.w)};
#pragma unroll
      for (int cv = 0; cv < 3; ++cv) {
        const float* sh = p.mod + (size_t)(3 + cv) * 3072 + lane * 16;
        float a = 0.f;
#pragma unroll
        for (int q = 0; q < 4; ++q) {
          const float4 s4 = *reinterpret_cast<const float4*>(sh + q * 4);
          a += s4.x * wf[q * 4] + s4.y * wf[q * 4 + 1] + s4.z * wf[q * 4 + 2] + s4.w * wf[q * 4 + 3];
        }
        a = wave_sum(a);
        if (lane == 0) p.bias1[cv * IN_O + prow] = a;
      }
    }
    for (int i = blockIdx.x * NTHR + threadIdx.x; i < 2 * 32768; i += gridDim.x * NTHR) {
      const float* src = (i < 32768 ? p.cache_k : p.cache_v) + (size_t)(i & 32767) * 8;
      u16* dst = (i < 32768 ? p.kcb : p.vcb) + (size_t)(i & 32767) * 8;
      const float4 a = ld_nt(src), c = ld_nt(src + 4);
      u32x4 o; o.x = pack2(a.x, a.y); o.y = pack2(a.z, a.w); o.z = pack2(c.x, c.y); o.w = pack2(c.z, c.w);
      *reinterpret_cast<u32x4*>(dst) = o;
    }
  }
  const float* g = p.norm_g + layer * 1024;
  for (int tok = blockIdx.x * 4 + wid; tok < NTOK; tok += gridDim.x * 4) {
    const float* x = tok < NP ? xa + (size_t)tok * D : xb + (size_t)(tok - NP) * D;
    const float* m = p.mod + (size_t)(layer * 3 + cond_of_token(tok)) * 3072;
    float4 v[4], ggv[4], shv[4], scv[4];
    float ss = 0.f;
#pragma unroll
    for (int i = 0; i < 4; ++i) {
      const int k = i * 256 + lane * 4;
      v[i] = *reinterpret_cast<const float4*>(x + k);
      ggv[i] = *reinterpret_cast<const float4*>(g + k);
      shv[i] = *reinterpret_cast<const float4*>(m + k);
      scv[i] = *reinterpret_cast<const float4*>(m + 1024 + k);
    }
#pragma unroll
    for (int i = 0; i < 4; ++i) ss += v[i].x * v[i].x + v[i].y * v[i].y + v[i].z * v[i].z + v[i].w * v[i].w;
    ss = wave_sum(ss);
    const float rinv = rsqrtf(ss * (1.f / 1024.f) + 1e-6f);
#pragma unroll
    for (int i = 0; i < 4; ++i) {
      const int k = i * 256 + lane * 4;
      const float4 gg = ggv[i], sh = shv[i], sc = scv[i];
      float h0 = v[i].x * rinv * gg.x * (1.f + sc.x) + sh.x;
      float h1 = v[i].y * rinv * gg.y * (1.f + sc.y) + sh.y;
      float h2 = v[i].z * rinv * gg.z * (1.f + sc.z) + sh.z;
      float h3 = v[i].w * rinv * gg.w * (1.f + sc.w) + sh.w;
      u32x2 o; o.x = pack2(h0, h1); o.y = pack2(h2, h3);
      *reinterpret_cast<u32x2*>(p.h + (size_t)tok * D + k) = o;
    }
  }
}

template <int EPI, int BM>
__device__ void gemm_phase(const P& p, const u16* __restrict__ A, const u16* __restrict__ Bt, int N, char* smem) {
  constexpr int K = 1024, BK = 64;
  const int tid = threadIdx.x, wid = tid >> 6, lane = tid & 63, wr = wid >> 1, wc = wid & 1, fr = lane & 15, fq = lane >> 4;
  const int NT = N >> 7;
  constexpr int MI = BM / 32;
  constexpr int NAL = BM / 32;
  const int ntiles = (NTOK / BM) * NT;
  const int srow = tid >> 3;
  const int schunk = (tid & 7) ^ ((tid >> 4) & 7);
  const u16* ga = nullptr; const u16* gb = nullptr;
  if ((int)blockIdx.x < ntiles) {
    const int mt0 = blockIdx.x / NT, nt0 = blockIdx.x % NT;
    ga = A + (size_t)(mt0 * BM + srow) * K + schunk * 8;
    gb = Bt + (size_t)(nt0 * 128 + srow) * K + schunk * 8;
    __syncthreads();
#pragma unroll
    for (int i = 0; i < NAL; ++i)
      __builtin_amdgcn_global_load_lds((const unsigned*)(ga + (size_t)(32 * i) * K), (unsigned*)(smem + i * 4096 + tid * 16), 16, 0, 0);
#pragma unroll
    for (int i = 0; i < 4; ++i)
      __builtin_amdgcn_global_load_lds((const unsigned*)(gb + (size_t)(32 * i) * K), (unsigned*)(smem + 16384 + i * 4096 + tid * 16), 16, 0, 0);
  }
  for (int tile = blockIdx.x; tile < ntiles; tile += gridDim.x) {
    const int mt = tile / NT, nt = tile % NT;
    const int brow = mt * BM, bcol = nt * 128;
    f32x4 acc[MI][4] = {};
    for (int t = 0; t < K / BK; ++t) {
      char* SA = smem + (t & 1) * 32768;
      char* SB = SA + 16384;
      asm volatile("s_waitcnt vmcnt(0)" ::: "memory");
      __syncthreads();
      if (t + 1 < K / BK) {
        char* NA = smem + ((t + 1) & 1) * 32768;
#pragma unroll
        for (int i = 0; i < NAL; ++i)
          __builtin_amdgcn_global_load_lds((const unsigned*)(ga + (size_t)(32 * i) * K + (t + 1) * BK), (unsigned*)(NA + i * 4096 + tid * 16), 16, 0, 0);
#pragma unroll
        for (int i = 0; i < 4; ++i)
          __builtin_amdgcn_global_load_lds((const unsigned*)(gb + (size_t)(32 * i) * K + (t + 1) * BK), (unsigned*)(NA + 16384 + i * 4096 + tid * 16), 16, 0, 0);
      } else {
        const int tn = tile + gridDim.x;
        if (tn < ntiles) {
          const int mtn = tn / NT, ntn = tn % NT;
          ga = A + (size_t)(mtn * BM + srow) * K + schunk * 8;
          gb = Bt + (size_t)(ntn * 128 + srow) * K + schunk * 8;
#pragma unroll
          for (int i = 0; i < NAL; ++i)
            __builtin_amdgcn_global_load_lds((const unsigned*)(ga + (size_t)(32 * i) * K), (unsigned*)(smem + i * 4096 + tid * 16), 16, 0, 0);
#pragma unroll
          for (int i = 0; i < 4; ++i)
            __builtin_amdgcn_global_load_lds((const unsigned*)(gb + (size_t)(32 * i) * K), (unsigned*)(smem + 16384 + i * 4096 + tid * 16), 16, 0, 0);
        }
      }
#pragma unroll
      for (int kk = 0; kk < 2; ++kk) {
        bf16x8 af[MI], bfr[4];
#pragma unroll
        for (int m = 0; m < MI; ++m) {
          const int r = wr * (BM / 2) + m * 16 + fr;
          af[m] = *reinterpret_cast<const bf16x8*>(SA + r * 128 + (((kk * 4 + fq) ^ ((r >> 1) & 7)) << 4));
        }
#pragma unroll
        for (int n = 0; n < 4; ++n) {
          const int r = wc * 64 + n * 16 + fr;
          bfr[n] = *reinterpret_cast<const bf16x8*>(SB + r * 128 + (((kk * 4 + fq) ^ ((r >> 1) & 7)) << 4));
        }
#pragma unroll
        for (int m = 0; m < MI; ++m)
#pragma unroll
          for (int n = 0; n < 4; ++n) acc[m][n] = __builtin_amdgcn_mfma_f32_16x16x32_bf16(bfr[n], af[m], acc[m][n], 0, 0, 0);
      }
    }
    if (EPI == 0) {
      const bool gate_tile = (nt >= 4 && nt < 8) || nt >= 20;
#pragma unroll
      for (int m = 0; m < MI; ++m) {
        const int row = brow + wr * (BM / 2) + m * 16 + fr;
#pragma unroll
        for (int np = 0; np < 2; ++np) {
          const int col = bcol + wc * 64 + np * 32 + fq * 8;
          float v[8];
#pragma unroll
          for (int j = 0; j < 4; ++j) { v[j] = acc[m][np * 2][j]; v[4 + j] = acc[m][np * 2 + 1][j]; }
          if (gate_tile) {
#pragma unroll
            for (int j = 0; j < 8; ++j) v[j] = silu_f(v[j]);
          }
          u32x4 o; o.x = pack2(v[0], v[1]); o.y = pack2(v[2], v[3]); o.z = pack2(v[4], v[5]); o.w = pack2(v[6], v[7]);
          *reinterpret_cast<u32x4*>(p.proj + (size_t)row * IN_E + col) = o;
          if (brow < NP && nt >= 12 && nt < 20) {
            const bool isv = nt >= 16;
            float* dst = p.out + (size_t)NTOK * D + (isv ? (size_t)16 * 8 * 256 * 64 : 0);
            const int cc = col - (isv ? 2048 : 1536);
            const int b = row >> 8, tt = row & 255, hh = cc >> 6, dd = cc & 63;
            float* d2 = dst + (((size_t)b * 8 + hh) * 256 + tt) * 64 + dd;
            st_nt(d2, make_float4(v[0], v[1], v[2], v[3]));
            st_nt(d2 + 4, make_float4(v[4], v[5], v[6], v[7]));
          }
        }
      }
    } else if (EPI == 2) {
      {
        const int cv = cond_of_token(brow);
        float rinv[MI];
#pragma unroll
        for (int m = 0; m < MI; ++m) {
          const float* rs = p.rowss + (size_t)(brow + wr * (BM / 2) + m * 16 + fr) * 16;
          const float4 a = *reinterpret_cast<const float4*>(rs), b2 = *reinterpret_cast<const float4*>(rs + 4);
          const float4 c2 = *reinterpret_cast<const float4*>(rs + 8), d2 = *reinterpret_cast<const float4*>(rs + 12);
          const float tot = (a.x + a.y + a.z + a.w) + (b2.x + b2.y + b2.z + b2.w) + (c2.x + c2.y + c2.z + c2.w) + (d2.x + d2.y + d2.z + d2.w);
          rinv[m] = rsqrtf(tot * (1.f / 1024.f) + 1e-6f);
        }
#pragma unroll
        for (int n = 0; n < 4; ++n) {
          const float4 bz = *reinterpret_cast<const float4*>(p.bias1 + (size_t)cv * IN_O + bcol + wc * 64 + n * 16 + fq * 4);
#pragma unroll
          for (int m = 0; m < MI; ++m) {
            acc[m][n][0] = acc[m][n][0] * rinv[m] + bz.x; acc[m][n][1] = acc[m][n][1] * rinv[m] + bz.y;
            acc[m][n][2] = acc[m][n][2] * rinv[m] + bz.z; acc[m][n][3] = acc[m][n][3] * rinv[m] + bz.w;
          }
        }
      }
      if (nt < 24) {
        const int type = nt >> 3, chunk = nt & 7;
#pragma unroll
        for (int m = 0; m < MI; ++m) {
          const int row = brow + wr * (BM / 2) + m * 16 + fr;
          float v[8];
#pragma unroll
          for (int nl = 0; nl < 2; ++nl)
#pragma unroll
            for (int j = 0; j < 4; ++j) {
              const float a = acc[m][nl][j], b = acc[m][2 + nl][j];
              v[nl * 4 + j] = type == 0 ? a * silu_f(b) : (type == 1 ? a * b : a * sigmoid_f(b));
            }
          u32x4 o; o.x = pack2(v[0], v[1]); o.y = pack2(v[2], v[3]); o.z = pack2(v[4], v[5]); o.w = pack2(v[6], v[7]);
          *reinterpret_cast<u32x4*>(p.proj + (size_t)row * 2048 + type * 512 + chunk * 64 + wc * 32 + fq * 8) = o;
        }
      } else {
#pragma unroll
        for (int m = 0; m < MI; ++m) {
          const int row = brow + wr * (BM / 2) + m * 16 + fr;
#pragma unroll
          for (int np = 0; np < 2; ++np) {
            float v[8];
#pragma unroll
            for (int j = 0; j < 4; ++j) { v[j] = silu_f(acc[m][np * 2][j]); v[4 + j] = silu_f(acc[m][np * 2 + 1][j]); }
            u32x4 o; o.x = pack2(v[0], v[1]); o.y = pack2(v[2], v[3]); o.z = pack2(v[4], v[5]); o.w = pack2(v[6], v[7]);
            *reinterpret_cast<u32x4*>(p.proj + (size_t)row * 2048 + 1536 + (nt - 24) * 128 + wc * 64 + np * 32 + fq * 8) = o;
          }
        }
      }
    } else {
      const int layer = (EPI == 1) ? 0 : 1;
      float ssq[MI] = {};
#pragma unroll
      for (int np = 0; np < 2; ++np) {
        const int col = bcol + wc * 64 + np * 32 + fq * 8;
        float4 n0 = {}, n1 = {};
        if (EPI == 1) { n0 = *reinterpret_cast<const float4*>(p.norm_g + 1024 + col); n1 = *reinterpret_cast<const float4*>(p.norm_g + 1024 + col + 4); }
#pragma unroll
        for (int m = 0; m < MI; ++m) {
          const int row = brow + wr * (BM / 2) + m * 16 + fr;
          const int cv = cond_of_token(row);
          const float* gate = p.mod + (size_t)(layer * 3 + cv) * 3072 + 2048 + col;
          const float4 g0 = *reinterpret_cast<const float4*>(gate);
          const float4 g1 = *reinterpret_cast<const float4*>(gate + 4);
          const float* xin = (EPI == 1) ? (row < NP ? p.x_prompt + (size_t)row * D + col : p.x_sample + (size_t)(row - NP) * D + col)
                                        : p.x1 + (size_t)row * D + col;
          const float4 x0 = ld_nt(xin);
          const float4 x1v = ld_nt(xin + 4);
          float4 o0, o1;
          o0.x = x0.x + g0.x * acc[m][np * 2][0]; o0.y = x0.y + g0.y * acc[m][np * 2][1];
          o0.z = x0.z + g0.z * acc[m][np * 2][2]; o0.w = x0.w + g0.w * acc[m][np * 2][3];
          o1.x = x1v.x + g1.x * acc[m][np * 2 + 1][0]; o1.y = x1v.y + g1.y * acc[m][np * 2 + 1][1];
          o1.z = x1v.z + g1.z * acc[m][np * 2 + 1][2]; o1.w = x1v.w + g1.w * acc[m][np * 2 + 1][3];
          float* xo = p.x1 + (size_t)row * D + col;
          *reinterpret_cast<float4*>(xo) = o0;
          *reinterpret_cast<float4*>(xo + 4) = o1;
          if (EPI == 1) {
            const float* sc = p.mod + (size_t)(3 + cv) * 3072 + 1024 + col;
            const float4 s0 = *reinterpret_cast<const float4*>(sc), s1 = *reinterpret_cast<const float4*>(sc + 4);
            ssq[m] += o0.x * o0.x + o0.y * o0.y + o0.z * o0.z + o0.w * o0.w + o1.x * o1.x + o1.y * o1.y + o1.z * o1.z + o1.w * o1.w;
            u32x4 hv;
            hv.x = pack2(o0.x * n0.x * (1.f + s0.x), o0.y * n0.y * (1.f + s0.y)); hv.y = pack2(o0.z * n0.z * (1.f + s0.z), o0.w * n0.w * (1.f + s0.w));
            hv.z = pack2(o1.x * n1.x * (1.f + s1.x), o1.y * n1.y * (1.f + s1.y)); hv.w = pack2(o1.z * n1.z * (1.f + s1.z), o1.w * n1.w * (1.f + s1.w));
            *reinterpret_cast<u32x4*>(p.h + (size_t)row * D + col) = hv;
          }
        }
      }
      if (EPI == 1) {
#pragma unroll
        for (int m = 0; m < MI; ++m) {
          float v = ssq[m];
          v += __shfl_xor(v, 16); v += __shfl_xor(v, 32);
          if (fq == 0) p.rowss[(size_t)(brow + wr * (BM / 2) + m * 16 + fr) * 16 + nt * 2 + wc] = v;
        }
      }
    }
  }
}

template <int MODE>
__device__ void attn_unit(const P& p, int u, char* smem) {
  const int tid = threadIdx.x, wid = tid >> 6, lane = tid & 63, fr = lane & 15, fq = lane >> 4;
  char* Ks = smem;
  u16* Vt = reinterpret_cast<u16*>(smem + 16384);
  float* rpl = reinterpret_cast<float*>(smem + 16384 + 18432);
  int h, qtok0, b, r = 0;
  if (MODE == 0) { b = u >> 5; h = (u >> 2) & 7; qtok0 = b * 256 + (u & 3) * 64; }
  else { b = u >> 7; r = (u >> 3) & 15; h = u & 7; qtok0 = NP + b * 1024 + r * 64; }
  constexpr int NSS = MODE == 0 ? 2 : 6;
  const int c0 = wid * 16;
  int ksc = c0 - 8; ksc = ksc < 0 ? 0 : (ksc > 32 ? 32 : ksc);
  const int rs = (r - 4) < 0 ? 0 : ((r - 4) > 8 ? 8 : (r - 4));
  bf16x8 qf[2];
  {
    const u16* q = p.proj + (size_t)(qtok0 + wid * 16 + fr) * IN_E + 1024 + h * 64 + fq * 8;
    qf[0] = *reinterpret_cast<const bf16x8*>(q);
    qf[1] = *reinterpret_cast<const bf16x8*>(q + 32);
  }
  u32x2 gbv[4];
#pragma unroll
  for (int dt = 0; dt < 4; ++dt)
    gbv[dt] = *reinterpret_cast<const u32x2*>(p.proj + (size_t)(qtok0 + wid * 16 + fr) * IN_E + 2560 + h * 64 + dt * 16 + fq * 4);
  const int cq = c0 + fr;
  int cstart = cq - 8; cstart = cstart < 0 ? 0 : (cstart > 48 ? 48 : cstart);
  float mrun = -1e30f, lrun = 0.f;
  f32x4 o[4] = {};
  const float scale = 0.125f;
  const int krow = tid >> 3, kchunk = tid & 7;
  const int vkey = tid & 127, vdh = tid >> 7;
  u32x4 kr[4], vr[4];
  auto prefetch = [&](int ss) {
    const u16* kb; const u16* vb; int ld;
    if (MODE == 0) { kb = p.proj + (size_t)(b * 256 + ss * 128) * IN_E + 1536 + h * 64; vb = kb + 512; ld = IN_E; }
    else if (ss < 4) { kb = p.proj + (size_t)(NP + b * 1024 + (rs + ss * 2) * 64) * IN_E + 1536 + h * 64; vb = kb + 512; ld = IN_E; }
    else { kb = p.kcb + ((size_t)(b * 8 + h) * 256 + (ss - 4) * 128) * 64; vb = p.vcb + ((size_t)(b * 8 + h) * 256 + (ss - 4) * 128) * 64; ld = 64; }
#pragma unroll
    for (int i = 0; i < 4; ++i) kr[i] = *reinterpret_cast<const u32x4*>(kb + (size_t)(krow + 32 * i) * ld + kchunk * 8);
#pragma unroll
    for (int i = 0; i < 4; ++i) vr[i] = *reinterpret_cast<const u32x4*>(vb + (size_t)vkey * ld + vdh * 32 + i * 8);
  };
  prefetch(0);
  if (MODE == 1) {
    __syncthreads();
    for (int i = tid; i < 15 * 31; i += NTHR) rpl[i] = p.rpb[h * 465 + i];
  }
#pragma unroll 1
  for (int ss = 0; ss < NSS; ++ss) {
    const bool local = (MODE == 1 && ss < 4);
    __syncthreads();
#pragma unroll
    for (int i = 0; i < 4; ++i) {
      const int row = krow + 32 * i;
      *reinterpret_cast<u32x4*>(Ks + row * 128 + ((kchunk ^ ((row >> 1) & 7)) << 4)) = kr[i];
    }
    {
      u16* vt = Vt + (vkey >> 6) * 4608 + (vdh * 32) * 72 + (vkey & 63);
#pragma unroll
      for (int i = 0; i < 4; ++i) {
        const unsigned w[4] = {vr[i].x, vr[i].y, vr[i].z, vr[i].w};
#pragma unroll
        for (int j = 0; j < 4; ++j) {
          vt[(i * 8 + 2 * j) * 72] = (u16)(w[j] & 0xffff);
          vt[(i * 8 + 2 * j + 1) * 72] = (u16)(w[j] >> 16);
        }
      }
    }
    if (ss + 1 < NSS) prefetch(ss + 1);
    __syncthreads();
#pragma unroll
    for (int s2 = 0; s2 < 2; ++s2) {
      const u16* Vs = Vt + s2 * 4608;
      const int nchunk = local ? 1 : 2;
      const int kbase = local ? ksc : 0;
      const float* rp = rpl + (rs + ss * 2 + s2 - r + 7) * 31 + 15 - cq;
      for (int ch = 0; ch < nchunk; ++ch) {
        f32x4 sv[2];
#pragma unroll
        for (int t2 = 0; t2 < 2; ++t2) {
          const int koff = kbase + ch * 32 + t2 * 16;
          const int row = s2 * 64 + koff + fr;
          const int sw = (row >> 1) & 7;
          const bf16x8 kf0 = *reinterpret_cast<const bf16x8*>(Ks + row * 128 + ((fq ^ sw) << 4));
          const bf16x8 kf1 = *reinterpret_cast<const bf16x8*>(Ks + row * 128 + (((4 + fq) ^ sw) << 4));
          f32x4 z = {0.f, 0.f, 0.f, 0.f};
          z = __builtin_amdgcn_mfma_f32_16x16x32_bf16(kf0, qf[0], z, 0, 0, 0);
          z = __builtin_amdgcn_mfma_f32_16x16x32_bf16(kf1, qf[1], z, 0, 0, 0);
          if (local) {
#pragma unroll
            for (int j = 0; j < 4; ++j) {
              const int ck = koff + fq * 4 + j;
              int dcl = ck - cq; dcl = dcl < -15 ? -15 : (dcl > 15 ? 15 : dcl);
              const float bias = rp[dcl + cq];
              const bool ok = (ck >= cstart) && (ck < cstart + 16);
              z[j] = ok ? z[j] * scale + bias : -1e30f;
            }
          } else {
#pragma unroll
            for (int j = 0; j < 4; ++j) z[j] *= scale;
          }
          sv[t2] = z;
        }
        float mx = fmaxf(fmaxf(fmaxf(sv[0][0], sv[0][1]), fmaxf(sv[0][2], sv[0][3])), fmaxf(fmaxf(sv[1][0], sv[1][1]), fmaxf(sv[1][2], sv[1][3])));
        mx = fmaxf(mx, __shfl_xor(mx, 16));
        mx = fmaxf(mx, __shfl_xor(mx, 32));
        const float mnew = fmaxf(mrun, mx);
        const float corr = __expf(mrun - mnew);
        mrun = mnew;
        float pv[8];
        float psum = 0.f;
#pragma unroll
        for (int j = 0; j < 4; ++j) { pv[j] = __expf(sv[0][j] - mnew); pv[4 + j] = __expf(sv[1][j] - mnew); }
#pragma unroll
        for (int j = 0; j < 8; ++j) psum += pv[j];
        lrun = lrun * corr + psum;
        u32x4 pk;
        pk.x = pack2(pv[0], pv[1]); pk.y = pack2(pv[2], pv[3]); pk.z = pack2(pv[4], pv[5]); pk.w = pack2(pv[6], pv[7]);
        const bf16x8 pfrag = __builtin_bit_cast(bf16x8, pk);
        const int k0 = kbase + ch * 32;
#pragma unroll
        for (int dt = 0; dt < 4; ++dt) {
          const u16* vp = Vs + (dt * 16 + fr) * 72 + k0 + fq * 4;
          u32x2 v0 = *reinterpret_cast<const u32x2*>(vp);
          u32x2 v1 = *reinterpret_cast<const u32x2*>(vp + 16);
          u32x4 vv; vv.x = v0.x; vv.y = v0.y; vv.z = v1.x; vv.w = v1.y;
          f32x4 oo = o[dt];
          oo[0] *= corr; oo[1] *= corr; oo[2] *= corr; oo[3] *= corr;
          o[dt] = __builtin_amdgcn_mfma_f32_16x16x32_bf16(__builtin_bit_cast(bf16x8, vv), pfrag, oo, 0, 0, 0);
        }
      }
    }
  }
  lrun += __shfl_xor(lrun, 16);
  lrun += __shfl_xor(lrun, 32);
  const float linv = 1.f / lrun;
  const int tok = qtok0 + wid * 16 + fr;
#pragma unroll
  for (int dt = 0; dt < 4; ++dt) {
    const int dd = h * 64 + dt * 16 + fq * 4;
    const u32x2 gb = gbv[dt];
    float r0 = o[dt][0] * linv * bflo(gb.x);
    float r1 = o[dt][1] * linv * bfhi(gb.x);
    float r2 = o[dt][2] * linv * bflo(gb.y);
    float r3 = o[dt][3] * linv * bfhi(gb.y);
    u32x2 ov; ov.x = pack2(r0, r1); ov.y = pack2(r2, r3);
    *reinterpret_cast<u32x2*>(p.cat + (size_t)tok * D + 512 + dd) = ov;
  }
}

template <int G>
__device__ void pool_unit(const P& p, int tile, char* smem) {
  constexpr int HALF = 1 << G;
  constexpr int NR = 64 + 2 * HALF;
  int tid = threadIdx.x;
  asm volatile("" : "+v"(tid));
  const int wid = tid >> 6, lane = tid & 63, fr = lane & 15, fq = lane >> 4;
  char* U = smem;
  char* W = smem + 80 * 272;
  const int T0 = tile * 64;
  int sb, se;
  if (T0 < NP) { sb = T0 & ~255; se = sb + 256; } else { sb = NP + ((T0 - NP) & ~1023); se = sb + 1024; }
  __syncthreads();
  {
    constexpr int NIT = (NR * 16 + NTHR - 1) / NTHR;
    u32x4 sv[NIT];
#pragma unroll
    for (int i = 0; i < NIT; ++i) {
      const int c = tid + i * NTHR, rr = c >> 4, c16 = c & 15;
      int tt = T0 - HALF + rr; tt = tt < sb ? sb : (tt >= se ? se - 1 : tt);
      sv[i] = *reinterpret_cast<const u32x4*>(p.proj + (size_t)tt * IN_E + G * 128 + c16 * 8);
    }
#pragma unroll
    for (int i = 0; i < NIT; ++i) {
      const int c = tid + i * NTHR, rr = c >> 4, c16 = c & 15;
      if (c < NR * 16) *reinterpret_cast<u32x4*>(U + rr * 272 + c16 * 16) = sv[i];
    }
  }
#pragma unroll
  for (int i = 0; i < 8; ++i) {
    const int c = tid + i * NTHR, rr = c >> 4, c16 = c & 15;
    *reinterpret_cast<u32x4*>(W + rr * 272 + c16 * 16) = *reinterpret_cast<const u32x4*>(p.wpt + (size_t)G * 16384 + rr * 128 + c16 * 8);
  }
  __syncthreads();
  const int t = T0 + wid * 16 + fr;
  int lo = t - HALF; lo = lo < sb ? sb : lo;
  int hi = t + HALF; hi = hi > se ? se : hi;
  const float inv = 1.f / (float)(hi - lo);
  f32x4 acc[8] = {};
#pragma unroll 1
  for (int ks = 0; ks < 4; ++ks) {
    const char* ub = U + (wid * 16 + fr) * 272 + (ks * 4 + fq) * 16;
    float sum[8] = {};
#pragma unroll
    for (int i = 0; i < 2 * HALF; ++i) {
      const int tt = t - HALF + i;
      const float m = (tt >= lo && tt < hi) ? 1.f : 0.f;
      const u32x4 w2 = *reinterpret_cast<const u32x4*>(ub + i * 272);
      sum[0] += m * bflo(w2.x); sum[1] += m * bfhi(w2.x); sum[2] += m * bflo(w2.y); sum[3] += m * bfhi(w2.y);
      sum[4] += m * bflo(w2.z); sum[5] += m * bfhi(w2.z); sum[6] += m * bflo(w2.w); sum[7] += m * bfhi(w2.w);
    }
    const u32x4 w = *reinterpret_cast<const u32x4*>(ub + HALF * 272);
    const float uu[8] = {bflo(w.x), bfhi(w.x), bflo(w.y), bfhi(w.y), bflo(w.z), bfhi(w.z), bflo(w.w), bfhi(w.w)};
    u32x4 pk;
    pk.x = pack2(sum[0] * inv - uu[0], sum[1] * inv - uu[1]);
    pk.y = pack2(sum[2] * inv - uu[2], sum[3] * inv - uu[3]);
    pk.z = pack2(sum[4] * inv - uu[4], sum[5] * inv - uu[5]);
    pk.w = pack2(sum[6] * inv - uu[6], sum[7] * inv - uu[7]);
    const bf16x8 af = __builtin_bit_cast(bf16x8, pk);
#pragma unroll
    for (int n = 0; n < 8; ++n) {
      const bf16x8 bfr = *reinterpret_cast<const bf16x8*>(W + (n * 16 + fr) * 272 + (ks * 4 + fq) * 16);
      acc[n] = __builtin_amdgcn_mfma_f32_16x16x32_bf16(bfr, af, acc[n], 0, 0, 0);
    }
  }
#pragma unroll
  for (int n = 0; n < 8; ++n) {
    const int dd = G * 128 + n * 16 + fq * 4;
    const float4 ps = *reinterpret_cast<const float4*>(p.pool_scale + dd);
    const u32x2 ga = *reinterpret_cast<const u32x2*>(p.proj + (size_t)t * IN_E + 512 + dd);
    u32x2 ov;
    ov.x = pack2(acc[n][0] * ps.x * bflo(ga.x), acc[n][1] * ps.y * bfhi(ga.x));
    ov.y = pack2(acc[n][2] * ps.z * bflo(ga.y), acc[n][3] * ps.w * bfhi(ga.y));
    *reinterpret_cast<u32x2*>(p.cat + (size_t)t * D + dd) = ov;
  }
}

__device__ void phase_even_mix(const P& p, char* smem) {
  if (gridDim.x == 512) {
    const int bx = blockIdx.x;
    if (bx < 256) {
      attn_unit<1>(p, bx, smem);
      const int q = bx, g = q & 3, tile = q >> 2;
      if (g == 0) pool_unit<0>(p, tile, smem); else if (g == 1) pool_unit<1>(p, tile, smem); else if (g == 2) pool_unit<2>(p, tile, smem); else pool_unit<3>(p, tile, smem);
    } else {
      attn_unit<0>(p, (bx - 256) * 2, smem);
      attn_unit<0>(p, (bx - 256) * 2 + 1, smem);
      if (bx < 384) {
        const int q = bx, g = q & 3, tile = q >> 2;
        if (g == 0) pool_unit<0>(p, tile, smem); else if (g == 1) pool_unit<1>(p, tile, smem); else if (g == 2) pool_unit<2>(p, tile, smem); else pool_unit<3>(p, tile, smem);
      }
    }
    return;
  }
  constexpr int U_N = 256, U_C = 512, U_P = 384;
  for (int u = blockIdx.x; u < U_N + U_C + U_P; u += gridDim.x) {
    if (u < U_N) attn_unit<1>(p, u, smem);
    else if (u < U_N + U_C) attn_unit<0>(p, u - U_N, smem);
    else {
      const int q = u - U_N - U_C, g = q & 3, tile = q >> 2;
      if (g == 0) pool_unit<0>(p, tile, smem); else if (g == 1) pool_unit<1>(p, tile, smem); else if (g == 2) pool_unit<2>(p, tile, smem); else pool_unit<3>(p, tile, smem);
    }
  }
}

__device__ void odd_unit(const P& p, int u, char* smem) {
  int tid = threadIdx.x;
  asm volatile("" : "+v"(tid));
  const int lane = tid & 63, wid = tid >> 6;
  u16* G = reinterpret_cast<u16*>(smem);
  float* red = reinterpret_cast<float*>(smem + 46 * 1024);
  const int t0 = u * 16;
  int sb, se;
  if (t0 < NP) { sb = t0 & ~255; se = sb + 256; } else { sb = NP + ((t0 - NP) & ~1023); se = sb + 1024; }
  const int ch = tid * 2;
  u32x4 sv[12];
#pragma unroll
  for (int i = 0; i < 12; ++i) {
    const int c = tid + i * NTHR, rr = c >> 6, c16 = c & 63;
    const int tt = t0 - 15 + rr;
    sv[i] = u32x4{0u, 0u, 0u, 0u};
    if (c < 46 * 64 && tt >= sb && tt < se) sv[i] = *reinterpret_cast<const u32x4*>(p.proj + (size_t)tt * 2048 + 1024 + c16 * 8);
  }
  unsigned cxw[18], bww[16], gdw[16];
#pragma unroll
  for (int q = 0; q < 18; ++q) {
    const int tt = t0 + q - 1;
    cxw[q] = 0u;
    if (tt >= sb && tt < se) cxw[q] = *reinterpret_cast<const unsigned*>(p.proj + (size_t)tt * 2048 + 512 + ch);
  }
#pragma unroll
  for (int i = 0; i < 16; ++i) {
    bww[i] = *reinterpret_cast<const unsigned*>(p.proj + (size_t)(t0 + i) * 2048 + ch);
    gdw[i] = *reinterpret_cast<const unsigned*>(p.proj + (size_t)(t0 + i) * 2048 + 1536 + ch);
  }
  float2 w[31];
#pragma unroll
  for (int j = 0; j < 31; ++j) w[j] = *reinterpret_cast<const float2*>(p.conv_d + j * 512 + ch);
  const float2 bias = *reinterpret_cast<const float2*>(p.conv_d_b + ch);
  const float2 lg = *reinterpret_cast<const float2*>(p.ln_g + ch);
  const float2 lb = *reinterpret_cast<const float2*>(p.ln_b + ch);
  const float2 wc0 = *reinterpret_cast<const float2*>(p.conv_c + ch);
  const float2 wc1 = *reinterpret_cast<const float2*>(p.conv_c + 512 + ch);
  const float2 wc2 = *reinterpret_cast<const float2*>(p.conv_c + 1024 + ch);
  __syncthreads();
#pragma unroll
  for (int i = 0; i < 12; ++i) {
    const int c = tid + i * NTHR, rr = c >> 6, c16 = c & 63;
    if (c < 46 * 64) *reinterpret_cast<u32x4*>(G + rr * 512 + c16 * 8) = sv[i];
  }
#pragma unroll
  for (int i = 0; i < 16; ++i) {
    const int tok = t0 + i;
    const float c0 = bflo(bww[i]) * (wc0.x * bflo(cxw[i]) + wc1.x * bflo(cxw[i + 1]) + wc2.x * bflo(cxw[i + 2]));
    const float c1 = bfhi(bww[i]) * (wc0.y * bfhi(cxw[i]) + wc1.y * bfhi(cxw[i + 1]) + wc2.y * bfhi(cxw[i + 2]));
    *reinterpret_cast<unsigned*>(p.cat + (size_t)tok * D + ch) = pack2(c0, c1);
  }
  __syncthreads();
#pragma unroll
  for (int hf = 0; hf < 2; ++hf) {
    float2 z[8];
#pragma unroll
    for (int i = 0; i < 8; ++i) z[i] = bias;
    const u16* Gh = G + hf * 8 * 512 + ch;
#pragma unroll
    for (int r = 0; r < 38; ++r) {
      const unsigned gv = *reinterpret_cast<const unsigned*>(Gh + r * 512);
      const float g0 = bflo(gv), g1 = bfhi(gv);
#pragma unroll
      for (int i = 0; i < 8; ++i) {
        const int j = r - i;
        if (j >= 0 && j <= 30) { z[i].x += w[j].x * g0; z[i].y += w[j].y * g1; }
      }
    }
    float* rd = red + hf * 64;
#pragma unroll
    for (int i = 0; i < 8; ++i) {
      const float sv2 = wave_sum(z[i].x + z[i].y);
      if (lane == 0) rd[wid * 8 + i] = sv2;
    }
    __syncthreads();
    float mu[8];
#pragma unroll
    for (int i = 0; i < 8; ++i) mu[i] = (rd[i] + rd[8 + i] + rd[16 + i] + rd[24 + i]) * (1.f / 512.f);
#pragma unroll
    for (int i = 0; i < 8; ++i) {
      const float d0 = z[i].x - mu[i], d1 = z[i].y - mu[i];
      const float sv2 = wave_sum(d0 * d0 + d1 * d1);
      if (lane == 0) rd[32 + wid * 8 + i] = sv2;
    }
    __syncthreads();
#pragma unroll
    for (int i = 0; i < 8; ++i) {
      const float rstd = rsqrtf((rd[32 + i] + rd[40 + i] + rd[48 + i] + rd[56 + i]) * (1.f / 512.f) + 1e-6f);
      const int tok = t0 + hf * 8 + i;
      const unsigned gd = gdw[hf * 8 + i];
      const float l0 = (z[i].x - mu[i]) * rstd * lg.x + lb.x;
      const float l1 = (z[i].y - mu[i]) * rstd * lg.y + lb.y;
      *reinterpret_cast<unsigned*>(p.cat + (size_t)tok * D + 512 + ch) = pack2(silu_f(l0) * bflo(gd), silu_f(l1) * bfhi(gd));
    }
  }
}

__device__ void phase_odd_mix(const P& p, char* smem) {
  for (int u = blockIdx.x; u < NTOK / 16; u += gridDim.x) odd_unit(p, u, smem);
}

__device__ void phase_final(const P& p) {
  const int lane = threadIdx.x & 63, wid = threadIdx.x >> 6;
  for (int tok = blockIdx.x * 4 + wid; tok < NTOK; tok += gridDim.x * 4) {
    const float* x = p.x1 + (size_t)tok * D;
    float4 v[4];
    float ss = 0.f;
#pragma unroll
    for (int i = 0; i < 4; ++i) {
      v[i] = ld_nt(x + i * 256 + lane * 4);
      ss += v[i].x * v[i].x + v[i].y * v[i].y + v[i].z * v[i].z + v[i].w * v[i].w;
    }
    ss = wave_sum(ss);
    const float rinv = rsqrtf(ss * (1.f / 1024.f) + 1e-6f);
#pragma unroll
    for (int i = 0; i < 4; ++i) {
      const int k = i * 256 + lane * 4;
      float4 gg = *reinterpret_cast<const float4*>(p.final_g + k);
      float4 o = make_float4(v[i].x * rinv * gg.x, v[i].y * rinv * gg.y, v[i].z * rinv * gg.z, v[i].w * rinv * gg.w);
      st_nt(p.out + (size_t)tok * D + k, o);
    }
  }
}

#define XB_TMO      128
#define XB_XCNT(j)  (256  + 64 * (j))
#define XB_XSUB(j)  (1280 + 64 * (j))
#define XB_XGEN(j)  (2304 + 64 * (j))
#define XB_TOP      3328
#define XB_TOPGEN   3392
#define XCD_BAR_WORDS 3456
#define XB_SPIN_CAP (1u << 18)
#define LAS __attribute__((address_space(3)))

__device__ __forceinline__ unsigned xb_ld(unsigned* p)              { return __hip_atomic_load(p, __ATOMIC_RELAXED, __HIP_MEMORY_SCOPE_AGENT); }
__device__ __forceinline__ unsigned xb_add(unsigned* p, unsigned v) { return __hip_atomic_fetch_add(p, v, __ATOMIC_RELAXED, __HIP_MEMORY_SCOPE_AGENT); }
__device__ __forceinline__ unsigned xb_xcc_id() { return (unsigned)__builtin_amdgcn_s_getreg((3 << 11) | 20) & 0xFu; }
#define XB_SPIN(cond, bar) do { unsigned _sp = 0; while (cond) { __builtin_amdgcn_s_sleep(1); \
    if ((++_sp & 255u) == 0u) { if (xb_ld(&(bar)[XB_TMO])) break; if (_sp > XB_SPIN_CAP) { atomicAdd(&(bar)[XB_TMO], 1u); break; } } } } while (0)

struct XcdBarrier {
    unsigned* bar; unsigned x;
    unsigned nloc, nx;
    volatile unsigned* st;
};

__device__ __forceinline__ XcdBarrier xcd_barrier_post(unsigned* bar, volatile unsigned* st) {
    XcdBarrier b; b.bar = bar; b.x = xb_xcc_id(); b.st = st; b.nloc = 0u; b.nx = 0u;
    if (threadIdx.x == 0) (void)xb_add(&bar[XB_XCNT(b.x)], 1u);
    return b;
}
__device__ __forceinline__ void xcd_barrier_complete(unsigned* bar, unsigned x, unsigned& nloc, unsigned& nx) {
    const unsigned G = gridDim.x * gridDim.y * gridDim.z;
    unsigned sum, cnt, mine, sp = 0u;
    for (;;) {
        sum = 0u; cnt = 0u; mine = 0u;
#pragma unroll
        for (unsigned j = 0; j < 16; ++j) { const unsigned c = xb_ld(&bar[XB_XCNT(j)]); sum += c; cnt += (c > 0u) ? 1u : 0u; mine = (j == x) ? c : mine; }
        if (sum == G) break;
        __builtin_amdgcn_s_sleep(1);
        if ((++sp & 255u) == 0u) { if (xb_ld(&bar[XB_TMO])) break; if (sp > XB_SPIN_CAP) { atomicAdd(&bar[XB_TMO], 1u); break; } }
    }
    nloc = mine > 0u ? mine : 1u; nx = cnt > 0u ? cnt : 1u;
}

__device__ __forceinline__ void xcd_barrier(XcdBarrier& b) {
    asm volatile("s_waitcnt vmcnt(0)" ::: "memory");
    __syncthreads();
    if (threadIdx.x == 0) {
        unsigned* bar = b.bar;
        __builtin_amdgcn_s_waitcnt(0);
        unsigned nloc = b.nloc, nx = b.nx;
        if (nloc == 0u) { xcd_barrier_complete(bar, b.x, nloc, nx); b.nloc = nloc; b.nx = nx; }
        const unsigned old = xb_add(&bar[XB_XSUB(b.x)], 1u);
        const unsigned gen = old / nloc;
        if (old + 1u == (gen + 1u) * nloc) {
            __builtin_amdgcn_fence(__ATOMIC_RELEASE, "agent");
            asm volatile("s_waitcnt vmcnt(0)" ::: "memory");
            const unsigned og = xb_add(&bar[XB_TOP], 1u);
            const unsigned tg = og / nx;
            if (og + 1u == (tg + 1u) * nx) xb_add(&bar[XB_TOPGEN], 1u);
            else XB_SPIN(xb_ld(&bar[XB_TOPGEN]) == tg, bar);
            __builtin_amdgcn_fence(__ATOMIC_ACQUIRE, "agent");
            xb_add(&bar[XB_XGEN(b.x)], 1u);
            asm volatile("s_waitcnt vmcnt(0)" ::: "memory");
        } else {
            XB_SPIN(xb_ld(&bar[XB_XGEN(b.x)]) == gen, bar);
            __builtin_amdgcn_fence(__ATOMIC_ACQUIRE, "agent");
            asm volatile("s_waitcnt vmcnt(0)" ::: "memory");
        }
    }
    __syncthreads();
}


template <int PH>
__device__ __forceinline__ void run_phase(const P& p, char* smem) {
  if (PH == 0) phase0(p, smem);
  if (PH == 1) phase_norm(p, 0, p.x_prompt, p.x_sample);
  if (PH == 2) gemm_phase<0, 128>(p, p.h, p.wt_in_even, IN_E, smem);
  if (PH == 3) phase_even_mix(p, smem);
  if (PH == 4) gemm_phase<1, 96>(p, p.cat, p.wt_out_even, D, smem);
  if (PH == 6) gemm_phase<2, 128>(p, p.h, p.wt_in_odd, IN_O, smem);
  if (PH == 7) phase_odd_mix(p, smem);
  if (PH == 8) gemm_phase<3, 96>(p, p.cat, p.wt_out_odd, D, smem);
  if (PH == 9) phase_final(p);
}

__global__ void __launch_bounds__(NTHR, 2) mega_kernel(P p) {
  __shared__ __attribute__((aligned(16))) char smem[SMEM_BYTES];
  cg::grid_group grid = cg::this_grid();
  XcdBarrier xb = xcd_barrier_post(p.bar, (volatile unsigned*)(p.bar + XCD_BAR_WORDS + 64 * blockIdx.x));
  if (p.use_cg) grid.sync();
#define RUNP(PH) do { run_phase<PH>(p, smem); if ((PROBE_REPEAT >> PH) & 1) { xcd_barrier(xb); run_phase<PH>(p, smem); } } while (0)
#define GSYNC() do { xcd_barrier(xb); if (PROBE_SYNC2) xcd_barrier(xb); } while (0)
  RUNP(0); GSYNC();
  RUNP(1); GSYNC();
  RUNP(2); GSYNC();
  RUNP(3); GSYNC();
  RUNP(4); GSYNC();
  RUNP(6); GSYNC();
  RUNP(7); GSYNC();
  run_phase<8>(p, smem); GSYNC();
  RUNP(9);
}

template <int PH>
__global__ void __launch_bounds__(NTHR, 2) phase_kernel(P p) {
  __shared__ __attribute__((aligned(16))) char smem[SMEM_BYTES];
  run_phase<PH>(p, smem);
}

constexpr int BAR_TOTAL_WORDS = XCD_BAR_WORDS + 64 * 2048;
static inline size_t align_up(size_t x) { return (x + 255) & ~(size_t)255; }

extern "C" void kernel_launch(void* const* d_in, const int* in_sizes, int n_in, void* d_out, int out_size, void* d_ws,
                              size_t ws_size, hipStream_t stream) {
  P p{};
  const float** f = reinterpret_cast<const float**>(&p);
  for (int i = 0; i < 22; ++i) f[i] = (const float*)d_in[i];
  p.out = (float*)d_out;
  char* w = (char*)d_ws;
  size_t off = 0;
  p.mod = (float*)(w + off); off = align_up(off + (size_t)2 * 3 * 3072 * 4);
  p.wt_in_even = (u16*)(w + off); off = align_up(off + (size_t)IN_E * D * 2);
  p.wt_out_even = (u16*)(w + off); off = align_up(off + (size_t)D * D * 2);
  p.wt_in_odd = (u16*)(w + off); off = align_up(off + (size_t)IN_O * D * 2);
  p.wt_out_odd = (u16*)(w + off); off = align_up(off + (size_t)D * D * 2);
  p.wpt = (u16*)(w + off); off = align_up(off + (size_t)4 * 128 * 128 * 2);
  p.h = (u16*)(w + off); off = align_up(off + (size_t)NTOK * D * 2);
  p.proj = (u16*)(w + off); off = align_up(off + (size_t)NTOK * IN_O * 2);
  p.cat = (u16*)(w + off); off = align_up(off + (size_t)NTOK * D * 2);
  p.x1 = (float*)(w + off); off = align_up(off + (size_t)NTOK * D * 4);
  p.kcb = (u16*)(w + off); off = align_up(off + (size_t)262144 * 2);
  p.vcb = (u16*)(w + off); off = align_up(off + (size_t)262144 * 2);
  p.rowss = (float*)(w + off); off = align_up(off + (size_t)NTOK * 16 * 4);
  p.bias1 = (float*)(w + off); off = align_up(off + (size_t)3 * IN_O * 4);
  p.bar = (unsigned*)(w + off); off = align_up(off + (size_t)BAR_TOTAL_WORDS * 4);
  p.use_cg = 0ull;

#if MULTI_LAUNCH
  const int G = 1024;
  phase_kernel<0><<<G, NTHR, 0, stream>>>(p);
  phase_kernel<1><<<G, NTHR, 0, stream>>>(p);
  phase_kernel<2><<<G, NTHR, 0, stream>>>(p);
  phase_kernel<3><<<G, NTHR, 0, stream>>>(p);
  phase_kernel<4><<<G, NTHR, 0, stream>>>(p);
  phase_kernel<6><<<G, NTHR, 0, stream>>>(p);
  phase_kernel<7><<<G, NTHR, 0, stream>>>(p);
  phase_kernel<8><<<G, NTHR, 0, stream>>>(p);
  phase_kernel<9><<<G, NTHR, 0, stream>>>(p);
#else
  static int grid_blocks = 0;
  if (!grid_blocks) {
    int dev = 0, cus = 0, per_cu = 0;
    hipGetDevice(&dev);
    hipDeviceGetAttribute(&cus, hipDeviceAttributeMultiprocessorCount, dev);
    hipOccupancyMaxActiveBlocksPerMultiprocessor(&per_cu, mega_kernel, NTHR, 0);
    if (per_cu < 1) per_cu = 1;
    grid_blocks = cus * per_cu;
  }
  (void)hipMemsetAsync(p.bar, 0, (size_t)BAR_TOTAL_WORDS * 4, stream);
  void* args[] = {&p};
  hipError_t e = hipLaunchCooperativeKernel((void*)mega_kernel, dim3(grid_blocks), dim3(NTHR), args, 0, stream);
  if (e != hipSuccess) fprintf(stderr, "cooperative launch failed: %s (grid %d)\n", hipGetErrorString(e), grid_blocks);
#endif
}
```

```cpp
#include <hip/hip_runtime.h>
#include <hip/hip_cooperative_groups.h>
#include <cstdio>
namespace cg = cooperative_groups;

#define PROBE_REPEAT 0x00
#define PROBE_SYNC2 0
#ifndef MULTI_LAUNCH
#define MULTI_LAUNCH 0
#endif

typedef unsigned short u16;
using bf16x8 = __attribute__((ext_vector_type(8))) short;
using f32x4 = __attribute__((ext_vector_type(4))) float;
using u32x4 = __attribute__((ext_vector_type(4))) unsigned;
using u32x2 = __attribute__((ext_vector_type(2))) unsigned;

constexpr int D = 1024;
constexpr int NP = 4096;
constexpr int NS = 2048;
constexpr int NTOK = NP + NS;
constexpr int IN_E = 3072;
constexpr int IN_O = 3584;
constexpr int NTHR = 256;
constexpr int SMEM_BYTES = 64 * 1024;

struct P {
  const float *x_prompt, *x_sample, *cache_k, *cache_v, *c, *c_ctx, *norm_g, *w_mod, *b_mod, *w_in_even, *w_pool,
      *pool_scale, *rpb, *w_out_even, *w_in_odd, *conv_c, *conv_d, *conv_d_b, *ln_g, *ln_b, *w_out_odd, *final_g;
  float* out;
  float* mod;
  u16 *wt_in_even, *wt_out_even, *wt_in_odd, *wt_out_odd, *wpt;
  u16 *h, *proj, *cat;
  u16 *kcb, *vcb;
  float *rowss;
  float *bias1;
  float* x1;
  unsigned* bar;
  unsigned long long use_cg;
};

typedef __bf16 hbf2 __attribute__((ext_vector_type(2)));
typedef float hf2 __attribute__((ext_vector_type(2)));
__device__ __forceinline__ unsigned pack2(float a, float b) {
  const hf2 v = {a, b};
  return __builtin_bit_cast(unsigned, __builtin_convertvector(v, hbf2));
}
__device__ __forceinline__ u16 f2bf(float f) { return (u16)(pack2(f, 0.f) & 0xffffu); }
__device__ __forceinline__ float bf2f(u16 h) { return __uint_as_float(((unsigned)h) << 16); }
using nf4 = __attribute__((ext_vector_type(4))) float;
__device__ __forceinline__ float4 ld_nt(const float* p) {
  const nf4 v = __builtin_nontemporal_load(reinterpret_cast<const nf4*>(p));
  return make_float4(v.x, v.y, v.z, v.w);
}
__device__ __forceinline__ void st_nt(float* p, float4 v) {
  nf4 q; q.x = v.x; q.y = v.y; q.z = v.z; q.w = v.w;
  __builtin_nontemporal_store(q, reinterpret_cast<nf4*>(p));
}
__device__ __forceinline__ float bflo(unsigned u) { return __uint_as_float(u << 16); }
__device__ __forceinline__ float bfhi(unsigned u) { return __uint_as_float(u & 0xffff0000u); }
__device__ __forceinline__ float silu_f(float x) { return x * __builtin_amdgcn_rcpf(1.f + __expf(-x)); }
__device__ __forceinline__ float sigmoid_f(float x) { return __builtin_amdgcn_rcpf(1.f + __expf(-x)); }
__device__ __forceinline__ float wave_sum(float v) {
#pragma unroll
  for (int o = 32; o >= 1; o >>= 1) v += __shfl_xor(v, o);
  return v;
}
__device__ __forceinline__ int cond_of_token(int tok) { return tok < NP ? 0 : 1 + ((tok - NP) >> 10); }

__device__ void mod_unit(const P& p, int u, float* sm) {
  const int layer = u / 96, cg32 = u % 96;
  const int tid = threadIdx.x;
  float* sc = sm;
  float* red = sm + 3 * 1024;
  __syncthreads();
#pragma unroll
  for (int q = 0; q < 12; ++q) {
    const int i = tid + q * NTHR;
    const int cv = i >> 10, k = i & 1023;
    const float v = (cv == 0) ? p.c_ctx[k] : p.c[(cv - 1) * 1024 + k];
    sc[i] = silu_f(v);
  }
  __syncthreads();
  const int cq = tid & 7, ks = tid >> 3;
  const float* W = p.w_mod + (size_t)layer * 1024 * 3072 + cg32 * 32 + cq * 4;
  float a[3][4] = {};
#pragma unroll 8
  for (int i = 0; i < 32; ++i) {
    int k = ks * 32 + i;
    const nf4 wq = __builtin_nontemporal_load(reinterpret_cast<const nf4*>(W + (size_t)k * 3072));
    float4 w = make_float4(wq.x, wq.y, wq.z, wq.w);
#pragma unroll
    for (int cv = 0; cv < 3; ++cv) {
      float s = sc[cv * 1024 + k];
      a[cv][0] += s * w.x; a[cv][1] += s * w.y; a[cv][2] += s * w.z; a[cv][3] += s * w.w;
    }
  }
#pragma unroll
  for (int cv = 0; cv < 3; ++cv)
#pragma unroll
    for (int j = 0; j < 4; ++j) {
      float v = a[cv][j];
      v += __shfl_xor(v, 8); v += __shfl_xor(v, 16); v += __shfl_xor(v, 32);
      a[cv][j] = v;
    }
  const int lane = tid & 63, wid = tid >> 6;
  if (lane < 8) {
#pragma unroll
    for (int cv = 0; cv < 3; ++cv)
#pragma unroll
      for (int j = 0; j < 4; ++j) red[wid * 96 + cv * 32 + lane * 4 + j] = a[cv][j];
  }
  __syncthreads();
  if (tid < 96) {
    int cv = tid >> 5, col = tid & 31;
    float v = red[tid] + red[96 + tid] + red[192 + tid] + red[288 + tid];
    int n = cg32 * 32 + col;
    v += p.b_mod[layer * 3072 + n];
    p.mod[(layer * 3 + cv) * 3072 + n] = v;
  }
}

__device__ __forceinline__ int perm_row_general(int s) {
  const int tile = s >> 7, c = s & 127, wc = c >> 6, q = c & 63;
  const int n = ((q >> 5) << 1) | ((q >> 2) & 1), i = (((q >> 3) & 3) << 2) | (q & 3);
  return tile * 128 + wc * 64 + n * 16 + i;
}
__device__ __forceinline__ int perm_row_odd(int s) {
  if (s >= 3072) return perm_row_general(s);
  const int region = s >> 9, ch = s & 511;
  const int type = (region == 0 || region == 3) ? 0 : (region <= 2 ? 1 : 2);
  const int member = (region == 0 || region == 1 || region == 4) ? 0 : 1;
  const int chunk = ch >> 6, wc = (ch >> 5) & 1, cw = ch & 31;
  const int n = member * 2 + ((cw >> 2) & 1), i = ((cw >> 3) << 2) | (cw & 3);
  return (type * 8 + chunk) * 128 + wc * 64 + n * 16 + i;
}
template <int MODE>
__device__ void transpose_tile(const float* __restrict__ src, u16* __restrict__ dst, int K, int N, int t, float* sm) {
  const int tid = threadIdx.x;
  const int ntn = N >> 6;
  const int k0 = (t / ntn) * 64, n0 = (t % ntn) * 64;
  __syncthreads();
  {
    const int r = tid >> 4, c4 = tid & 15;
#pragma unroll
    for (int i = 0; i < 4; ++i) {
      int k = r + 16 * i;
      const nf4 vq = __builtin_nontemporal_load(reinterpret_cast<const nf4*>(src + (size_t)(k0 + k) * N + n0 + c4 * 4));
      float4 v = make_float4(vq.x, vq.y, vq.z, vq.w);
      float* d = sm + k * 65 + c4 * 4;
      d[0] = v.x; d[1] = v.y; d[2] = v.z; d[3] = v.w;
    }
  }
  __syncthreads();
  {
    const int kc = tid & 7, nl = tid >> 3;
#pragma unroll
    for (int i = 0; i < 2; ++i) {
      int n = nl + 32 * i;
      float v[8];
#pragma unroll
      for (int j = 0; j < 8; ++j) v[j] = sm[(kc * 8 + j) * 65 + n];
      u32x4 o;
      o.x = pack2(v[0], v[1]); o.y = pack2(v[2], v[3]); o.z = pack2(v[4], v[5]); o.w = pack2(v[6], v[7]);
      const int drow = MODE == 0 ? (n0 + n) : (MODE == 1 ? perm_row_general(n0 + n) : perm_row_odd(n0 + n));
      *reinterpret_cast<u32x4*>(dst + (size_t)drow * K + k0 + kc * 8) = o;
    }
  }
}

__device__ void phase0(const P& p, char* smem) {
  float* sm = reinterpret_cast<float*>(smem);
  constexpr int T0 = 192, T1 = T0 + 768, T2 = T1 + 256, T3 = T2 + 896, T4 = T3 + 256, T5 = T4 + 16;
  for (int u = blockIdx.x; u < T5; u += gridDim.x) {
    if (u < T0) mod_unit(p, u, sm);
    else if (u < T1) transpose_tile<1>(p.w_in_even, p.wt_in_even, 1024, 3072, u - T0, sm);
    else if (u < T2) transpose_tile<1>(p.w_out_even, p.wt_out_even, 1024, 1024, u - T1, sm);
    else if (u < T3) transpose_tile<2>(p.w_in_odd, p.wt_in_odd, 1024, 3584, u - T2, sm);
    else if (u < T4) transpose_tile<1>(p.w_out_odd, p.wt_out_odd, 1024, 1024, u - T3, sm);
    else { int t = u - T4; int g = t >> 2; transpose_tile<0>(p.w_pool + g * 16384, p.wpt + g * 16384, 128, 128, t & 3, sm); }
  }
}

__device__ void phase_norm(const P& p, int layer, const float* xa, const float* xb) {
  const int lane = threadIdx.x & 63, wid = threadIdx.x >> 6;
  if (layer == 0) {
    for (int prow = blockIdx.x * 4 + wid; prow < IN_O; prow += gridDim.x * 4) {
      const u16* wrow = p.wt_in_odd + (size_t)prow * D + lane * 16;
      const u32x4 w0 = *reinterpret_cast<const u32x4*>(wrow), w1 = *reinterpret_cast<const u32x4*>(wrow + 8);
      const float wf[16] = {bflo(w0.x), bfhi(w0.x), bflo(w0.y), bfhi(w0.y), bflo(w0.z), bfhi(w0.z), bflo(w0.w), bfhi(w0.w),
                            bflo(w1.x), bfhi(w1.x), bflo(w1.y), bfhi(w1.y), bflo(w1.z), bfhi(w1.z), bflo(w1.w), bfhi(w1.w)};
#pragma unroll
      for (int cv = 0; cv < 3; ++cv) {
        const float* sh = p.mod + (size_t)(3 + cv) * 3072 + lane * 16;
        float a = 0.f;
#pragma unroll
        for (int q = 0; q < 4; ++q) {
          const float4 s4 = *reinterpret_cast<const float4*>(sh + q * 4);
          a += s4.x * wf[q * 4] + s4.y * wf[q * 4 + 1] + s4.z * wf[q * 4 + 2] + s4.w * wf[q * 4 + 3];
        }
        a = wave_sum(a);
        if (lane == 0) p.bias1[cv * IN_O + prow] = a;
      }
    }
    for (int i = blockIdx.x * NTHR + threadIdx.x; i < 2 * 32768; i += gridDim.x * NTHR) {
      const float* src = (i < 32768 ? p.cache_k : p.cache_v) + (size_t)(i & 32767) * 8;
      u16* dst = (i < 32768 ? p.kcb : p.vcb) + (size_t)(i & 32767) * 8;
      const float4 a = ld_nt(src), c = ld_nt(src + 4);
      u32x4 o; o.x = pack2(a.x, a.y); o.y = pack2(a.z, a.w); o.z = pack2(c.x, c.y); o.w = pack2(c.z, c.w);
      *reinterpret_cast<u32x4*>(dst) = o;
    }
  }
  const float* g = p.norm_g + layer * 1024;
  for (int tok = blockIdx.x * 4 + wid; tok < NTOK; tok += gridDim.x * 4) {
    const float* x = tok < NP ? xa + (size_t)tok * D : xb + (size_t)(tok - NP) * D;
    const float* m = p.mod + (size_t)(layer * 3 + cond_of_token(tok)) * 3072;
    float4 v[4], ggv[4], shv[4], scv[4];
    float ss = 0.f;
#pragma unroll
    for (int i = 0; i < 4; ++i) {
      const int k = i * 256 + lane * 4;
      v[i] = *reinterpret_cast<const float4*>(x + k);
      ggv[i] = *reinterpret_cast<const float4*>(g + k);
      shv[i] = *reinterpret_cast<const float4*>(m + k);
      scv[i] = *reinterpret_cast<const float4*>(m + 1024 + k);
    }
#pragma unroll
    for (int i = 0; i < 4; ++i) ss += v[i].x * v[i].x + v[i].y * v[i].y + v[i].z * v[i].z + v[i].w * v[i].w;
    ss = wave_sum(ss);
    const float rinv = rsqrtf(ss * (1.f / 1024.f) + 1e-6f);
#pragma unroll
    for (int i = 0; i < 4; ++i) {
      const int k = i * 256 + lane * 4;
      const float4 gg = ggv[i], sh = shv[i], sc = scv[i];
      float h0 = v[i].x * rinv * gg.x * (1.f + sc.x) + sh.x;
      float h1 = v[i].y * rinv * gg.y * (1.f + sc.y) + sh.y;
      float h2 = v[i].z * rinv * gg.z * (1.f + sc.z) + sh.z;
      float h3 = v[i].w * rinv * gg.w * (1.f + sc.w) + sh.w;
      u32x2 o; o.x = pack2(h0, h1); o.y = pack2(h2, h3);
      *reinterpret_cast<u32x2*>(p.h + (size_t)tok * D + k) = o;
    }
  }
}

template <int EPI, int BM>
__device__ void gemm_phase(const P& p, const u16* __restrict__ A, const u16* __restrict__ Bt, int N, char* smem) {
  constexpr int K = 1024, BK = 64;
  const int tid = threadIdx.x, wid = tid >> 6, lane = tid & 63, wr = wid >> 1, wc = wid & 1, fr = lane & 15, fq = lane >> 4;
  const int NT = N >> 7;
  constexpr int MI = BM / 32;
  constexpr int NAL = BM / 32;
  const int ntiles = (NTOK / BM) * NT;
  const int srow = tid >> 3;
  const int schunk = (tid & 7) ^ ((tid >> 4) & 7);
  const u16* ga = nullptr; const u16* gb = nullptr;
  if ((int)blockIdx.x < ntiles) {
    const int mt0 = blockIdx.x / NT, nt0 = blockIdx.x % NT;
    ga = A + (size_t)(mt0 * BM + srow) * K + schunk * 8;
    gb = Bt + (size_t)(nt0 * 128 + srow) * K + schunk * 8;
    __syncthreads();
#pragma unroll
    for (int i = 0; i < NAL; ++i)
      __builtin_amdgcn_global_load_lds((const unsigned*)(ga + (size_t)(32 * i) * K), (unsigned*)(smem + i * 4096 + tid * 16), 16, 0, 0);
#pragma unroll
    for (int i = 0; i < 4; ++i)
      __builtin_amdgcn_global_load_lds((const unsigned*)(gb + (size_t)(32 * i) * K), (unsigned*)(smem + 16384 + i * 4096 + tid * 16), 16, 0, 0);
  }
  for (int tile = blockIdx.x; tile < ntiles; tile += gridDim.x) {
    const int mt = tile / NT, nt = tile % NT;
    const int brow = mt * BM, bcol = nt * 128;
    f32x4 acc[MI][4] = {};
    for (int t = 0; t < K / BK; ++t) {
      char* SA = smem + (t & 1) * 32768;
      char* SB = SA + 16384;
      asm volatile("s_waitcnt vmcnt(0)" ::: "memory");
      __syncthreads();
      if (t + 1 < K / BK) {
        char* NA = smem + ((t + 1) & 1) * 32768;
#pragma unroll
        for (int i = 0; i < NAL; ++i)
          __builtin_amdgcn_global_load_lds((const unsigned*)(ga + (size_t)(32 * i) * K + (t + 1) * BK), (unsigned*)(NA + i * 4096 + tid * 16), 16, 0, 0);
#pragma unroll
        for (int i = 0; i < 4; ++i)
          __builtin_amdgcn_global_load_lds((const unsigned*)(gb + (size_t)(32 * i) * K + (t + 1) * BK), (unsigned*)(NA + 16384 + i * 4096 + tid * 16), 16, 0, 0);
      } else {
        const int tn = tile + gridDim.x;
        if (tn < ntiles) {
          const int mtn = tn / NT, ntn = tn % NT;
          ga = A + (size_t)(mtn * BM + srow) * K + schunk * 8;
          gb = Bt + (size_t)(ntn * 128 + srow) * K + schunk * 8;
#pragma unroll
          for (int i = 0; i < NAL; ++i)
            __builtin_amdgcn_global_load_lds((const unsigned*)(ga + (size_t)(32 * i) * K), (unsigned*)(smem + i * 4096 + tid * 16), 16, 0, 0);
#pragma unroll
          for (int i = 0; i < 4; ++i)
            __builtin_amdgcn_global_load_lds((const unsigned*)(gb + (size_t)(32 * i) * K), (unsigned*)(smem + 16384 + i * 4096 + tid * 16), 16, 0, 0);
        }
      }
#pragma unroll
      for (int kk = 0; kk < 2; ++kk) {
        bf16x8 af[MI], bfr[4];
#pragma unroll
        for (int m = 0; m < MI; ++m) {
          const int r = wr * (BM / 2) + m * 16 + fr;
          af[m] = *reinterpret_cast<const bf16x8*>(SA + r * 128 + (((kk * 4 + fq) ^ ((r >> 1) & 7)) << 4));
        }
#pragma unroll
        for (int n = 0; n < 4; ++n) {
          const int r = wc * 64 + n * 16 + fr;
          bfr[n] = *reinterpret_cast<const bf16x8*>(SB + r * 128 + (((kk * 4 + fq) ^ ((r >> 1) & 7)) << 4));
        }
#pragma unroll
        for (int m = 0; m < MI; ++m)
#pragma unroll
          for (int n = 0; n < 4; ++n) acc[m][n] = __builtin_amdgcn_mfma_f32_16x16x32_bf16(bfr[n], af[m], acc[m][n], 0, 0, 0);
      }
    }
    if (EPI == 0) {
      const bool gate_tile = (nt >= 4 && nt < 8) || nt >= 20;
#pragma unroll
      for (int m = 0; m < MI; ++m) {
        const int row = brow + wr * (BM / 2) + m * 16 + fr;
#pragma unroll
        for (int np = 0; np < 2; ++np) {
          const int col = bcol + wc * 64 + np * 32 + fq * 8;
          float v[8];
#pragma unroll
          for (int j = 0; j < 4; ++j) { v[j] = acc[m][np * 2][j]; v[4 + j] = acc[m][np * 2 + 1][j]; }
          if (gate_tile) {
#pragma unroll
            for (int j = 0; j < 8; ++j) v[j] = silu_f(v[j]);
          }
          u32x4 o; o.x = pack2(v[0], v[1]); o.y = pack2(v[2], v[3]); o.z = pack2(v[4], v[5]); o.w = pack2(v[6], v[7]);
          *reinterpret_cast<u32x4*>(p.proj + (size_t)row * IN_E + col) = o;
          if (brow < NP && nt >= 12 && nt < 20) {
            const bool isv = nt >= 16;
            float* dst = p.out + (size_t)NTOK * D + (isv ? (size_t)16 * 8 * 256 * 64 : 0);
            const int cc = col - (isv ? 2048 : 1536);
            const int b = row >> 8, tt = row & 255, hh = cc >> 6, dd = cc & 63;
            float* d2 = dst + (((size_t)b * 8 + hh) * 256 + tt) * 64 + dd;
            st_nt(d2, make_float4(v[0], v[1], v[2], v[3]));
            st_nt(d2 + 4, make_float4(v[4], v[5], v[6], v[7]));
          }
        }
      }
    } else if (EPI == 2) {
      {
        const int cv = cond_of_token(brow);
        float rinv[MI];
#pragma unroll
        for (int m = 0; m < MI; ++m) {
          const float* rs = p.rowss + (size_t)(brow + wr * (BM / 2) + m * 16 + fr) * 16;
          const float4 a = *reinterpret_cast<const float4*>(rs), b2 = *reinterpret_cast<const float4*>(rs + 4);
          const float4 c2 = *reinterpret_cast<const float4*>(rs + 8), d2 = *reinterpret_cast<const float4*>(rs + 12);
          const float tot = (a.x + a.y + a.z + a.w) + (b2.x + b2.y + b2.z + b2.w) + (c2.x + c2.y + c2.z + c2.w) + (d2.x + d2.y + d2.z + d2.w);
          rinv[m] = rsqrtf(tot * (1.f / 1024.f) + 1e-6f);
        }
#pragma unroll
        for (int n = 0; n < 4; ++n) {
          const float4 bz = *reinterpret_cast<const float4*>(p.bias1 + (size_t)cv * IN_O + bcol + wc * 64 + n * 16 + fq * 4);
#pragma unroll
          for (int m = 0; m < MI; ++m) {
            acc[m][n][0] = acc[m][n][0] * rinv[m] + bz.x; acc[m][n][1] = acc[m][n][1] * rinv[m] + bz.y;
            acc[m][n][2] = acc[m][n][2] * rinv[m] + bz.z; acc[m][n][3] = acc[m][n][3] * rinv[m] + bz.w;
          }
        }
      }
      if (nt < 24) {
        const int type = nt >> 3, chunk = nt & 7;
#pragma unroll
        for (int m = 0; m < MI; ++m) {
          const int row = brow + wr * (BM / 2) + m * 16 + fr;
          float v[8];
#pragma unroll
          for (int nl = 0; nl < 2; ++nl)
#pragma unroll
            for (int j = 0; j < 4; ++j) {
              const float a = acc[m][nl][j], b = acc[m][2 + nl][j];
              v[nl * 4 + j] = type == 0 ? a * silu_f(b) : (type == 1 ? a * b : a * sigmoid_f(b));
            }
          u32x4 o; o.x = pack2(v[0], v[1]); o.y = pack2(v[2], v[3]); o.z = pack2(v[4], v[5]); o.w = pack2(v[6], v[7]);
          *reinterpret_cast<u32x4*>(p.proj + (size_t)row * 2048 + type * 512 + chunk * 64 + wc * 32 + fq * 8) = o;
        }
      } else {
#pragma unroll
        for (int m = 0; m < MI; ++m) {
          const int row = brow + wr * (BM / 2) + m * 16 + fr;
#pragma unroll
          for (int np = 0; np < 2; ++np) {
            float v[8];
#pragma unroll
            for (int j = 0; j < 4; ++j) { v[j] = silu_f(acc[m][np * 2][j]); v[4 + j] = silu_f(acc[m][np * 2 + 1][j]); }
            u32x4 o; o.x = pack2(v[0], v[1]); o.y = pack2(v[2], v[3]); o.z = pack2(v[4], v[5]); o.w = pack2(v[6], v[7]);
            *reinterpret_cast<u32x4*>(p.proj + (size_t)row * 2048 + 1536 + (nt - 24) * 128 + wc * 64 + np * 32 + fq * 8) = o;
          }
        }
      }
    } else {
      const int layer = (EPI == 1) ? 0 : 1;
      float ssq[MI] = {};
#pragma unroll
      for (int np = 0; np < 2; ++np) {
        const int col = bcol + wc * 64 + np * 32 + fq * 8;
        float4 n0 = {}, n1 = {};
        if (EPI == 1) { n0 = *reinterpret_cast<const float4*>(p.norm_g + 1024 + col); n1 = *reinterpret_cast<const float4*>(p.norm_g + 1024 + col + 4); }
#pragma unroll
        for (int m = 0; m < MI; ++m) {
          const int row = brow + wr * (BM / 2) + m * 16 + fr;
          const int cv = cond_of_token(row);
          const float* gate = p.mod + (size_t)(layer * 3 + cv) * 3072 + 2048 + col;
          const float4 g0 = *reinterpret_cast<const float4*>(gate);
          const float4 g1 = *reinterpret_cast<const float4*>(gate + 4);
          const float* xin = (EPI == 1) ? (row < NP ? p.x_prompt + (size_t)row * D + col : p.x_sample + (size_t)(row - NP) * D + col)
                                        : p.x1 + (size_t)row * D + col;
          const float4 x0 = ld_nt(xin);
          const float4 x1v = ld_nt(xin + 4);
          float4 o0, o1;
          o0.x = x0.x + g0.x * acc[m][np * 2][0]; o0.y = x0.y + g0.y * acc[m][np * 2][1];
          o0.z = x0.z + g0.z * acc[m][np * 2][2]; o0.w = x0.w + g0.w * acc[m][np * 2][3];
          o1.x = x1v.x + g1.x * acc[m][np * 2 + 1][0]; o1.y = x1v.y + g1.y * acc[m][np * 2 + 1][1];
          o1.z = x1v.z + g1.z * acc[m][np * 2 + 1][2]; o1.w = x1v.w + g1.w * acc[m][np * 2 + 1][3];
          float* xo = p.x1 + (size_t)row * D + col;
          *reinterpret_cast<float4*>(xo) = o0;
          *reinterpret_cast<float4*>(xo + 4) = o1;
          if (EPI == 1) {
            const float* sc = p.mod + (size_t)(3 + cv) * 3072 + 1024 + col;
            const float4 s0 = *reinterpret_cast<const float4*>(sc), s1 = *reinterpret_cast<const float4*>(sc + 4);
            ssq[m] += o0.x * o0.x + o0.y * o0.y + o0.z * o0.z + o0.w * o0.w + o1.x * o1.x + o1.y * o1.y + o1.z * o1.z + o1.w * o1.w;
            u32x4 hv;
            hv.x = pack2(o0.x * n0.x * (1.f + s0.x), o0.y * n0.y * (1.f + s0.y)); hv.y = pack2(o0.z * n0.z * (1.f + s0.z), o0.w * n0.w * (1.f + s0.w));
            hv.z = pack2(o1.x * n1.x * (1.f + s1.x), o1.y * n1.y * (1.f + s1.y)); hv.w = pack2(o1.z * n1.z * (1.f + s1.z), o1.w * n1.w * (1.f + s1.w));
            *reinterpret_cast<u32x4*>(p.h + (size_t)row * D + col) = hv;
          }
        }
      }
      if (EPI == 1) {
#pragma unroll
        for (int m = 0; m < MI; ++m) {
          float v = ssq[m];
          v += __shfl_xor(v, 16); v += __shfl_xor(v, 32);
          if (fq == 0) p.rowss[(size_t)(brow + wr * (BM / 2) + m * 16 + fr) * 16 + nt * 2 + wc] = v;
        }
      }
    }
  }
}

template <int MODE>
__device__ void attn_unit(const P& p, int u, char* smem) {
  const int tid = threadIdx.x, wid = tid >> 6, lane = tid & 63, fr = lane & 15, fq = lane >> 4;
  char* Ks = smem;
  char* Vr = smem + 16384;
  float* rpl = reinterpret_cast<float*>(smem + 16384 + 20480);
  int h, qtok0, b, r = 0;
  if (MODE == 0) { b = u >> 5; h = (u >> 2) & 7; qtok0 = b * 256 + (u & 3) * 64; }
  else { b = u >> 7; r = (u >> 3) & 15; h = u & 7; qtok0 = NP + b * 1024 + r * 64; }
  constexpr int NSS = MODE == 0 ? 2 : 6;
  const int c0 = wid * 16;
  int ksc = c0 - 8; ksc = ksc < 0 ? 0 : (ksc > 32 ? 32 : ksc);
  const int rs = (r - 4) < 0 ? 0 : ((r - 4) > 8 ? 8 : (r - 4));
  bf16x8 qf[2];
  {
    const u16* q = p.proj + (size_t)(qtok0 + wid * 16 + fr) * IN_E + 1024 + h * 64 + fq * 8;
    qf[0] = *reinterpret_cast<const bf16x8*>(q);
    qf[1] = *reinterpret_cast<const bf16x8*>(q + 32);
  }
  u32x2 gbv[4];
#pragma unroll
  for (int dt = 0; dt < 4; ++dt)
    gbv[dt] = *reinterpret_cast<const u32x2*>(p.proj + (size_t)(qtok0 + wid * 16 + fr) * IN_E + 2560 + h * 64 + dt * 16 + fq * 4);
  const int cq = c0 + fr;
  int cstart = cq - 8; cstart = cstart < 0 ? 0 : (cstart > 48 ? 48 : cstart);
  float mrun = -1e30f, lrun = 0.f;
  f32x4 o[4] = {};
  const float scale = 0.125f;
  const int krow = tid >> 3, kchunk = tid & 7;
  const int vkey = tid & 127, vdh = tid >> 7;
  u32x4 kr[4], vr[4];
  auto prefetch = [&](int ss) {
    const u16* kb; const u16* vb; int ld;
    if (MODE == 0) { kb = p.proj + (size_t)(b * 256 + ss * 128) * IN_E + 1536 + h * 64; vb = kb + 512; ld = IN_E; }
    else if (ss < 4) { kb = p.proj + (size_t)(NP + b * 1024 + (rs + ss * 2) * 64) * IN_E + 1536 + h * 64; vb = kb + 512; ld = IN_E; }
    else { kb = p.kcb + ((size_t)(b * 8 + h) * 256 + (ss - 4) * 128) * 64; vb = p.vcb + ((size_t)(b * 8 + h) * 256 + (ss - 4) * 128) * 64; ld = 64; }
#pragma unroll
    for (int i = 0; i < 4; ++i) kr[i] = *reinterpret_cast<const u32x4*>(kb + (size_t)(krow + 32 * i) * ld + kchunk * 8);
#pragma unroll
    for (int i = 0; i < 4; ++i) vr[i] = *reinterpret_cast<const u32x4*>(vb + (size_t)vkey * ld + vdh * 32 + i * 8);
  };
  prefetch(0);
  if (MODE == 1) {
    __syncthreads();
    for (int i = tid; i < 15 * 31; i += NTHR) rpl[i] = p.rpb[h * 465 + i];
  }
#pragma unroll 1
  for (int ss = 0; ss < NSS; ++ss) {
    const bool local = (MODE == 1 && ss < 4);
    __syncthreads();
#pragma unroll
    for (int i = 0; i < 4; ++i) {
      const int row = krow + 32 * i;
      *reinterpret_cast<u32x4*>(Ks + row * 128 + ((kchunk ^ ((row >> 1) & 7)) << 4)) = kr[i];
    }
    {
      char* vrow = Vr + vkey * 160 + vdh * 64;
#pragma unroll
      for (int i = 0; i < 4; ++i) *reinterpret_cast<u32x4*>(vrow + i * 16) = vr[i];
    }
    if (ss + 1 < NSS) prefetch(ss + 1);
    __syncthreads();
#pragma unroll
    for (int s2 = 0; s2 < 2; ++s2) {
      const int nchunk = local ? 1 : 2;
      const int kbase = local ? ksc : 0;
      const float* rp = rpl + (rs + ss * 2 + s2 - r + 7) * 31 + 15 - cq;
      for (int ch = 0; ch < nchunk; ++ch) {
        f32x4 sv[2];
#pragma unroll
        for (int t2 = 0; t2 < 2; ++t2) {
          const int koff = kbase + ch * 32 + t2 * 16;
          const int row = s2 * 64 + koff + fr;
          const int sw = (row >> 1) & 7;
          const bf16x8 kf0 = *reinterpret_cast<const bf16x8*>(Ks + row * 128 + ((fq ^ sw) << 4));
          const bf16x8 kf1 = *reinterpret_cast<const bf16x8*>(Ks + row * 128 + (((4 + fq) ^ sw) << 4));
          f32x4 z = {0.f, 0.f, 0.f, 0.f};
          z = __builtin_amdgcn_mfma_f32_16x16x32_bf16(kf0, qf[0], z, 0, 0, 0);
          z = __builtin_amdgcn_mfma_f32_16x16x32_bf16(kf1, qf[1], z, 0, 0, 0);
          if (local) {
#pragma unroll
            for (int j = 0; j < 4; ++j) {
              const int ck = koff + fq * 4 + j;
              int dcl = ck - cq; dcl = dcl < -15 ? -15 : (dcl > 15 ? 15 : dcl);
              const float bias = rp[dcl + cq];
              const bool ok = (ck >= cstart) && (ck < cstart + 16);
              z[j] = ok ? z[j] * scale + bias : -1e30f;
            }
          } else {
#pragma unroll
            for (int j = 0; j < 4; ++j) z[j] *= scale;
          }
          sv[t2] = z;
        }
        float mx = fmaxf(fmaxf(fmaxf(sv[0][0], sv[0][1]), fmaxf(sv[0][2], sv[0][3])), fmaxf(fmaxf(sv[1][0], sv[1][1]), fmaxf(sv[1][2], sv[1][3])));
        mx = fmaxf(mx, __shfl_xor(mx, 16));
        mx = fmaxf(mx, __shfl_xor(mx, 32));
        const float mnew = fmaxf(mrun, mx);
        const float corr = __expf(mrun - mnew);
        mrun = mnew;
        float pv[8];
        float psum = 0.f;
#pragma unroll
        for (int j = 0; j < 4; ++j) { pv[j] = __expf(sv[0][j] - mnew); pv[4 + j] = __expf(sv[1][j] - mnew); }
#pragma unroll
        for (int j = 0; j < 8; ++j) psum += pv[j];
        lrun = lrun * corr + psum;
        u32x4 pk;
        pk.x = pack2(pv[0], pv[1]); pk.y = pack2(pv[2], pv[3]); pk.z = pack2(pv[4], pv[5]); pk.w = pack2(pv[6], pv[7]);
        const bf16x8 pfrag = __builtin_bit_cast(bf16x8, pk);
        const int k0 = kbase + ch * 32;
#pragma unroll
        for (int dt = 0; dt < 4; ++dt) {
          const char* vp = Vr + (s2 * 64 + k0 + fq * 4 + (fr >> 2)) * 160 + (dt * 16 + (fr & 3) * 4) * 2;
          typedef short v4i16_t __attribute__((ext_vector_type(4)));
          const v4i16_t t0 = __builtin_amdgcn_ds_read_tr16_b64_v4i16((__attribute__((address_space(3))) v4i16_t*)vp);
          const v4i16_t t1 = __builtin_amdgcn_ds_read_tr16_b64_v4i16((__attribute__((address_space(3))) v4i16_t*)(vp + 16 * 160));
          const u32x2 v0 = __builtin_bit_cast(u32x2, t0), v1 = __builtin_bit_cast(u32x2, t1);
          u32x4 vv; vv.x = v0.x; vv.y = v0.y; vv.z = v1.x; vv.w = v1.y;
          f32x4 oo = o[dt];
          oo[0] *= corr; oo[1] *= corr; oo[2] *= corr; oo[3] *= corr;
          o[dt] = __builtin_amdgcn_mfma_f32_16x16x32_bf16(__builtin_bit_cast(bf16x8, vv), pfrag, oo, 0, 0, 0);
        }
      }
    }
  }
  lrun += __shfl_xor(lrun, 16);
  lrun += __shfl_xor(lrun, 32);
  const float linv = 1.f / lrun;
  const int tok = qtok0 + wid * 16 + fr;
#pragma unroll
  for (int dt = 0; dt < 4; ++dt) {
    const int dd = h * 64 + dt * 16 + fq * 4;
    const u32x2 gb = gbv[dt];
    float r0 = o[dt][0] * linv * bflo(gb.x);
    float r1 = o[dt][1] * linv * bfhi(gb.x);
    float r2 = o[dt][2] * linv * bflo(gb.y);
    float r3 = o[dt][3] * linv * bfhi(gb.y);
    u32x2 ov; ov.x = pack2(r0, r1); ov.y = pack2(r2, r3);
    *reinterpret_cast<u32x2*>(p.cat + (size_t)tok * D + 512 + dd) = ov;
  }
}

template <int G>
__device__ void pool_unit(const P& p, int tile, char* smem) {
  constexpr int HALF = 1 << G;
  constexpr int NR = 64 + 2 * HALF;
  int tid = threadIdx.x;
  asm volatile("" : "+v"(tid));
  const int wid = tid >> 6, lane = tid & 63, fr = lane & 15, fq = lane >> 4;
  char* U = smem;
  char* W = smem + 80 * 272;
  const int T0 = tile * 64;
  int sb, se;
  if (T0 < NP) { sb = T0 & ~255; se = sb + 256; } else { sb = NP + ((T0 - NP) & ~1023); se = sb + 1024; }
  __syncthreads();
  {
    constexpr int NIT = (NR * 16 + NTHR - 1) / NTHR;
    u32x4 sv[NIT];
#pragma unroll
    for (int i = 0; i < NIT; ++i) {
      const int c = tid + i * NTHR, rr = c >> 4, c16 = c & 15;
      int tt = T0 - HALF + rr; tt = tt < sb ? sb : (tt >= se ? se - 1 : tt);
      sv[i] = *reinterpret_cast<const u32x4*>(p.proj + (size_t)tt * IN_E + G * 128 + c16 * 8);
    }
#pragma unroll
    for (int i = 0; i < NIT; ++i) {
      const int c = tid + i * NTHR, rr = c >> 4, c16 = c & 15;
      if (c < NR * 16) *reinterpret_cast<u32x4*>(U + rr * 272 + c16 * 16) = sv[i];
    }
  }
#pragma unroll
  for (int i = 0; i < 8; ++i) {
    const int c = tid + i * NTHR, rr = c >> 4, c16 = c & 15;
    *reinterpret_cast<u32x4*>(W + rr * 272 + c16 * 16) = *reinterpret_cast<const u32x4*>(p.wpt + (size_t)G * 16384 + rr * 128 + c16 * 8);
  }
  __syncthreads();
  const int t = T0 + wid * 16 + fr;
  int lo = t - HALF; lo = lo < sb ? sb : lo;
  int hi = t + HALF; hi = hi > se ? se : hi;
  const float inv = 1.f / (float)(hi - lo);
  f32x4 acc[8] = {};
#pragma unroll 1
  for (int ks = 0; ks < 4; ++ks) {
    const char* ub = U + (wid * 16 + fr) * 272 + (ks * 4 + fq) * 16;
    float sum[8] = {};
#pragma unroll
    for (int i = 0; i < 2 * HALF; ++i) {
      const int tt = t - HALF + i;
      const float m = (tt >= lo && tt < hi) ? 1.f : 0.f;
      const u32x4 w2 = *reinterpret_cast<const u32x4*>(ub + i * 272);
      sum[0] += m * bflo(w2.x); sum[1] += m * bfhi(w2.x); sum[2] += m * bflo(w2.y); sum[3] += m * bfhi(w2.y);
      sum[4] += m * bflo(w2.z); sum[5] += m * bfhi(w2.z); sum[6] += m * bflo(w2.w); sum[7] += m * bfhi(w2.w);
    }
    const u32x4 w = *reinterpret_cast<const u32x4*>(ub + HALF * 272);
    const float uu[8] = {bflo(w.x), bfhi(w.x), bflo(w.y), bfhi(w.y), bflo(w.z), bfhi(w.z), bflo(w.w), bfhi(w.w)};
    u32x4 pk;
    pk.x = pack2(sum[0] * inv - uu[0], sum[1] * inv - uu[1]);
    pk.y = pack2(sum[2] * inv - uu[2], sum[3] * inv - uu[3]);
    pk.z = pack2(sum[4] * inv - uu[4], sum[5] * inv - uu[5]);
    pk.w = pack2(sum[6] * inv - uu[6], sum[7] * inv - uu[7]);
    const bf16x8 af = __builtin_bit_cast(bf16x8, pk);
#pragma unroll
    for (int n = 0; n < 8; ++n) {
      const bf16x8 bfr = *reinterpret_cast<const bf16x8*>(W + (n * 16 + fr) * 272 + (ks * 4 + fq) * 16);
      acc[n] = __builtin_amdgcn_mfma_f32_16x16x32_bf16(bfr, af, acc[n], 0, 0, 0);
    }
  }
#pragma unroll
  for (int n = 0; n < 8; ++n) {
    const int dd = G * 128 + n * 16 + fq * 4;
    const float4 ps = *reinterpret_cast<const float4*>(p.pool_scale + dd);
    const u32x2 ga = *reinterpret_cast<const u32x2*>(p.proj + (size_t)t * IN_E + 512 + dd);
    u32x2 ov;
    ov.x = pack2(acc[n][0] * ps.x * bflo(ga.x), acc[n][1] * ps.y * bfhi(ga.x));
    ov.y = pack2(acc[n][2] * ps.z * bflo(ga.y), acc[n][3] * ps.w * bfhi(ga.y));
    *reinterpret_cast<u32x2*>(p.cat + (size_t)t * D + dd) = ov;
  }
}

__device__ void phase_even_mix(const P& p, char* smem) {
  if (gridDim.x == 512) {
    const int bx = blockIdx.x;
    if (bx < 256) {
      attn_unit<1>(p, bx, smem);
      const int q = bx, g = q & 3, tile = q >> 2;
      if (g == 0) pool_unit<0>(p, tile, smem); else if (g == 1) pool_unit<1>(p, tile, smem); else if (g == 2) pool_unit<2>(p, tile, smem); else pool_unit<3>(p, tile, smem);
    } else {
      attn_unit<0>(p, (bx - 256) * 2, smem);
      attn_unit<0>(p, (bx - 256) * 2 + 1, smem);
      if (bx < 384) {
        const int q = bx, g = q & 3, tile = q >> 2;
        if (g == 0) pool_unit<0>(p, tile, smem); else if (g == 1) pool_unit<1>(p, tile, smem); else if (g == 2) pool_unit<2>(p, tile, smem); else pool_unit<3>(p, tile, smem);
      }
    }
    return;
  }
  constexpr int U_N = 256, U_C = 512, U_P = 384;
  for (int u = blockIdx.x; u < U_N + U_C + U_P; u += gridDim.x) {
    if (u < U_N) attn_unit<1>(p, u, smem);
    else if (u < U_N + U_C) attn_unit<0>(p, u - U_N, smem);
    else {
      const int q = u - U_N - U_C, g = q & 3, tile = q >> 2;
      if (g == 0) pool_unit<0>(p, tile, smem); else if (g == 1) pool_unit<1>(p, tile, smem); else if (g == 2) pool_unit<2>(p, tile, smem); else pool_unit<3>(p, tile, smem);
    }
  }
}

__device__ void odd_unit(const P& p, int u, char* smem) {
  int tid = threadIdx.x;
  asm volatile("" : "+v"(tid));
  const int lane = tid & 63, wid = tid >> 6;
  u16* G = reinterpret_cast<u16*>(smem);
  float* red = reinterpret_cast<float*>(smem + 46 * 1024);
  const int t0 = u * 16;
  int sb, se;
  if (t0 < NP) { sb = t0 & ~255; se = sb + 256; } else { sb = NP + ((t0 - NP) & ~1023); se = sb + 1024; }
  const int ch = tid * 2;
  u32x4 sv[12];
#pragma unroll
  for (int i = 0; i < 12; ++i) {
    const int c = tid + i * NTHR, rr = c >> 6, c16 = c & 63;
    const int tt = t0 - 15 + rr;
    sv[i] = u32x4{0u, 0u, 0u, 0u};
    if (c < 46 * 64 && tt >= sb && tt < se) sv[i] = *reinterpret_cast<const u32x4*>(p.proj + (size_t)tt * 2048 + 1024 + c16 * 8);
  }
  unsigned cxw[18], bww[16], gdw[16];
#pragma unroll
  for (int q = 0; q < 18; ++q) {
    const int tt = t0 + q - 1;
    cxw[q] = 0u;
    if (tt >= sb && tt < se) cxw[q] = *reinterpret_cast<const unsigned*>(p.proj + (size_t)tt * 2048 + 512 + ch);
  }
#pragma unroll
  for (int i = 0; i < 16; ++i) {
    bww[i] = *reinterpret_cast<const unsigned*>(p.proj + (size_t)(t0 + i) * 2048 + ch);
    gdw[i] = *reinterpret_cast<const unsigned*>(p.proj + (size_t)(t0 + i) * 2048 + 1536 + ch);
  }
  float2 w[31];
#pragma unroll
  for (int j = 0; j < 31; ++j) w[j] = *reinterpret_cast<const float2*>(p.conv_d + j * 512 + ch);
  const float2 bias = *reinterpret_cast<const float2*>(p.conv_d_b + ch);
  const float2 lg = *reinterpret_cast<const float2*>(p.ln_g + ch);
  const float2 lb = *reinterpret_cast<const float2*>(p.ln_b + ch);
  const float2 wc0 = *reinterpret_cast<const float2*>(p.conv_c + ch);
  const float2 wc1 = *reinterpret_cast<const float2*>(p.conv_c + 512 + ch);
  const float2 wc2 = *reinterpret_cast<const float2*>(p.conv_c + 1024 + ch);
  __syncthreads();
#pragma unroll
  for (int i = 0; i < 12; ++i) {
    const int c = tid + i * NTHR, rr = c >> 6, c16 = c & 63;
    if (c < 46 * 64) *reinterpret_cast<u32x4*>(G + rr * 512 + c16 * 8) = sv[i];
  }
#pragma unroll
  for (int i = 0; i < 16; ++i) {
    const int tok = t0 + i;
    const float c0 = bflo(bww[i]) * (wc0.x * bflo(cxw[i]) + wc1.x * bflo(cxw[i + 1]) + wc2.x * bflo(cxw[i + 2]));
    const float c1 = bfhi(bww[i]) * (wc0.y * bfhi(cxw[i]) + wc1.y * bfhi(cxw[i + 1]) + wc2.y * bfhi(cxw[i + 2]));
    *reinterpret_cast<unsigned*>(p.cat + (size_t)tok * D + ch) = pack2(c0, c1);
  }
  __syncthreads();
#pragma unroll
  for (int hf = 0; hf < 2; ++hf) {
    float2 z[8];
#pragma unroll
    for (int i = 0; i < 8; ++i) z[i] = bias;
    const u16* Gh = G + hf * 8 * 512 + ch;
#pragma unroll
    for (int r = 0; r < 38; ++r) {
      const unsigned gv = *reinterpret_cast<const unsigned*>(Gh + r * 512);
      const float g0 = bflo(gv), g1 = bfhi(gv);
#pragma unroll
      for (int i = 0; i < 8; ++i) {
        const int j = r - i;
        if (j >= 0 && j <= 30) { z[i].x += w[j].x * g0; z[i].y += w[j].y * g1; }
      }
    }
    float* rd = red + hf * 64;
#pragma unroll
    for (int i = 0; i < 8; ++i) {
      const float sv2 = wave_sum(z[i].x + z[i].y);
      if (lane == 0) rd[wid * 8 + i] = sv2;
    }
    __syncthreads();
    float mu[8];
#pragma unroll
    for (int i = 0; i < 8; ++i) mu[i] = (rd[i] + rd[8 + i] + rd[16 + i] + rd[24 + i]) * (1.f / 512.f);
#pragma unroll
    for (int i = 0; i < 8; ++i) {
      const float d0 = z[i].x - mu[i], d1 = z[i].y - mu[i];
      const float sv2 = wave_sum(d0 * d0 + d1 * d1);
      if (lane == 0) rd[32 + wid * 8 + i] = sv2;
    }
    __syncthreads();
#pragma unroll
    for (int i = 0; i < 8; ++i) {
      const float rstd = rsqrtf((rd[32 + i] + rd[40 + i] + rd[48 + i] + rd[56 + i]) * (1.f / 512.f) + 1e-6f);
      const int tok = t0 + hf * 8 + i;
      const unsigned gd = gdw[hf * 8 + i];
      const float l0 = (z[i].x - mu[i]) * rstd * lg.x + lb.x;
      const float l1 = (z[i].y - mu[i]) * rstd * lg.y + lb.y;
      *reinterpret_cast<unsigned*>(p.cat + (size_t)tok * D + 512 + ch) = pack2(silu_f(l0) * bflo(gd), silu_f(l1) * bfhi(gd));
    }
  }
}

__device__ void phase_odd_mix(const P& p, char* smem) {
  for (int u = blockIdx.x; u < NTOK / 16; u += gridDim.x) odd_unit(p, u, smem);
}

__device__ void phase_final(const P& p) {
  const int lane = threadIdx.x & 63, wid = threadIdx.x >> 6;
  for (int tok = blockIdx.x * 4 + wid; tok < NTOK; tok += gridDim.x * 4) {
    const float* x = p.x1 + (size_t)tok * D;
    float4 v[4];
    float ss = 0.f;
#pragma unroll
    for (int i = 0; i < 4; ++i) {
      v[i] = ld_nt(x + i * 256 + lane * 4);
      ss += v[i].x * v[i].x + v[i].y * v[i].y + v[i].z * v[i].z + v[i].w * v[i].w;
    }
    ss = wave_sum(ss);
    const float rinv = rsqrtf(ss * (1.f / 1024.f) + 1e-6f);
#pragma unroll
    for (int i = 0; i < 4; ++i) {
      const int k = i * 256 + lane * 4;
      float4 gg = *reinterpret_cast<const float4*>(p.final_g + k);
      float4 o = make_float4(v[i].x * rinv * gg.x, v[i].y * rinv * gg.y, v[i].z * rinv * gg.z, v[i].w * rinv * gg.w);
      st_nt(p.out + (size_t)tok * D + k, o);
    }
  }
}

#define XB_TMO      128
#define XB_XCNT(j)  (256  + 64 * (j))
#define XB_XSUB(j)  (1280 + 64 * (j))
#define XB_XGEN(j)  (2304 + 64 * (j))
#define XB_TOP      3328
#define XB_TOPGEN   3392
#define XCD_BAR_WORDS 3456
#define XB_SPIN_CAP (1u << 18)
#define LAS __attribute__((address_space(3)))

__device__ __forceinline__ unsigned xb_ld(unsigned* p)              { return __hip_atomic_load(p, __ATOMIC_RELAXED, __HIP_MEMORY_SCOPE_AGENT); }
__device__ __forceinline__ unsigned xb_add(unsigned* p, unsigned v) { return __hip_atomic_fetch_add(p, v, __ATOMIC_RELAXED, __HIP_MEMORY_SCOPE_AGENT); }
__device__ __forceinline__ unsigned xb_xcc_id() { return (unsigned)__builtin_amdgcn_s_getreg((3 << 11) | 20) & 0xFu; }
#define XB_SPIN(cond, bar) do { unsigned _sp = 0; while (cond) { __builtin_amdgcn_s_sleep(1); \
    if ((++_sp & 255u) == 0u) { if (xb_ld(&(bar)[XB_TMO])) break; if (_sp > XB_SPIN_CAP) { atomicAdd(&(bar)[XB_TMO], 1u); break; } } } } while (0)

struct XcdBarrier {
    unsigned* bar; unsigned x;
    unsigned nloc, nx;
    volatile unsigned* st;
};

__device__ __forceinline__ XcdBarrier xcd_barrier_post(unsigned* bar, volatile unsigned* st) {
    XcdBarrier b; b.bar = bar; b.x = xb_xcc_id(); b.st = st; b.nloc = 0u; b.nx = 0u;
    if (threadIdx.x == 0) (void)xb_add(&bar[XB_XCNT(b.x)], 1u);
    return b;
}
__device__ __forceinline__ void xcd_barrier_complete(unsigned* bar, unsigned x, unsigned& nloc, unsigned& nx) {
    const unsigned G = gridDim.x * gridDim.y * gridDim.z;
    unsigned sum, cnt, mine, sp = 0u;
    for (;;) {
        sum = 0u; cnt = 0u; mine = 0u;
#pragma unroll
        for (unsigned j = 0; j < 16; ++j) { const unsigned c = xb_ld(&bar[XB_XCNT(j)]); sum += c; cnt += (c > 0u) ? 1u : 0u; mine = (j == x) ? c : mine; }
        if (sum == G) break;
        __builtin_amdgcn_s_sleep(1);
        if ((++sp & 255u) == 0u) { if (xb_ld(&bar[XB_TMO])) break; if (sp > XB_SPIN_CAP) { atomicAdd(&bar[XB_TMO], 1u); break; } }
    }
    nloc = mine > 0u ? mine : 1u; nx = cnt > 0u ? cnt : 1u;
}

__device__ __forceinline__ void xcd_barrier(XcdBarrier& b) {
    asm volatile("s_waitcnt vmcnt(0)" ::: "memory");
    __syncthreads();
    if (threadIdx.x == 0) {
        unsigned* bar = b.bar;
        __builtin_amdgcn_s_waitcnt(0);
        unsigned nloc = b.nloc, nx = b.nx;
        if (nloc == 0u) { xcd_barrier_complete(bar, b.x, nloc, nx); b.nloc = nloc; b.nx = nx; }
        const unsigned old = xb_add(&bar[XB_XSUB(b.x)], 1u);
        const unsigned gen = old / nloc;
        if (old + 1u == (gen + 1u) * nloc) {
            __builtin_amdgcn_fence(__ATOMIC_RELEASE, "agent");
            asm volatile("s_waitcnt vmcnt(0)" ::: "memory");
            const unsigned og = xb_add(&bar[XB_TOP], 1u);
            const unsigned tg = og / nx;
            if (og + 1u == (tg + 1u) * nx) xb_add(&bar[XB_TOPGEN], 1u);
            else XB_SPIN(xb_ld(&bar[XB_TOPGEN]) == tg, bar);
            __builtin_amdgcn_fence(__ATOMIC_ACQUIRE, "agent");
            xb_add(&bar[XB_XGEN(b.x)], 1u);
            asm volatile("s_waitcnt vmcnt(0)" ::: "memory");
        } else {
            XB_SPIN(xb_ld(&bar[XB_XGEN(b.x)]) == gen, bar);
            __builtin_amdgcn_fence(__ATOMIC_ACQUIRE, "agent");
            asm volatile("s_waitcnt vmcnt(0)" ::: "memory");
        }
    }
    __syncthreads();
}


template <int PH>
__device__ __forceinline__ void run_phase(const P& p, char* smem) {
  if (PH == 0) phase0(p, smem);
  if (PH == 1) phase_norm(p, 0, p.x_prompt, p.x_sample);
  if (PH == 2) gemm_phase<0, 128>(p, p.h, p.wt_in_even, IN_E, smem);
  if (PH == 3) phase_even_mix(p, smem);
  if (PH == 4) gemm_phase<1, 96>(p, p.cat, p.wt_out_even, D, smem);
  if (PH == 6) gemm_phase<2, 128>(p, p.h, p.wt_in_odd, IN_O, smem);
  if (PH == 7) phase_odd_mix(p, smem);
  if (PH == 8) gemm_phase<3, 96>(p, p.cat, p.wt_out_odd, D, smem);
  if (PH == 9) phase_final(p);
}

__global__ void __launch_bounds__(NTHR, 2) mega_kernel(P p) {
  __shared__ __attribute__((aligned(16))) char smem[SMEM_BYTES];
  cg::grid_group grid = cg::this_grid();
  XcdBarrier xb = xcd_barrier_post(p.bar, (volatile unsigned*)(p.bar + XCD_BAR_WORDS + 64 * blockIdx.x));
  if (p.use_cg) grid.sync();
#define RUNP(PH) do { run_phase<PH>(p, smem); if ((PROBE_REPEAT >> PH) & 1) { xcd_barrier(xb); run_phase<PH>(p, smem); } } while (0)
#define GSYNC() do { xcd_barrier(xb); if (PROBE_SYNC2) xcd_barrier(xb); } while (0)
  RUNP(0); GSYNC();
  RUNP(1); GSYNC();
  RUNP(2); GSYNC();
  RUNP(3); GSYNC();
  RUNP(4); GSYNC();
  RUNP(6); GSYNC();
  RUNP(7); GSYNC();
  run_phase<8>(p, smem); GSYNC();
  RUNP(9);
}

template <int PH>
__global__ void __launch_bounds__(NTHR, 2) phase_kernel(P p) {
  __shared__ __attribute__((aligned(16))) char smem[SMEM_BYTES];
  run_phase<PH>(p, smem);
}

constexpr int BAR_TOTAL_WORDS = XCD_BAR_WORDS + 64 * 2048;
static inline size_t align_up(size_t x) { return (x + 255) & ~(size_t)255; }

extern "C" void kernel_launch(void* const* d_in, const int* in_sizes, int n_in, void* d_out, int out_size, void* d_ws,
                              size_t ws_size, hipStream_t stream) {
  P p{};
  const float** f = reinterpret_cast<const float**>(&p);
  for (int i = 0; i < 22; ++i) f[i] = (const float*)d_in[i];
  p.out = (float*)d_out;
  char* w = (char*)d_ws;
  size_t off = 0;
  p.mod = (float*)(w + off); off = align_up(off + (size_t)2 * 3 * 3072 * 4);
  p.wt_in_even = (u16*)(w + off); off = align_up(off + (size_t)IN_E * D * 2);
  p.wt_out_even = (u16*)(w + off); off = align_up(off + (size_t)D * D * 2);
  p.wt_in_odd = (u16*)(w + off); off = align_up(off + (size_t)IN_O * D * 2);
  p.wt_out_odd = (u16*)(w + off); off = align_up(off + (size_t)D * D * 2);
  p.wpt = (u16*)(w + off); off = align_up(off + (size_t)4 * 128 * 128 * 2);
  p.h = (u16*)(w + off); off = align_up(off + (size_t)NTOK * D * 2);
  p.proj = (u16*)(w + off); off = align_up(off + (size_t)NTOK * IN_O * 2);
  p.cat = (u16*)(w + off); off = align_up(off + (size_t)NTOK * D * 2);
  p.x1 = (float*)(w + off); off = align_up(off + (size_t)NTOK * D * 4);
  p.kcb = (u16*)(w + off); off = align_up(off + (size_t)262144 * 2);
  p.vcb = (u16*)(w + off); off = align_up(off + (size_t)262144 * 2);
  p.rowss = (float*)(w + off); off = align_up(off + (size_t)NTOK * 16 * 4);
  p.bias1 = (float*)(w + off); off = align_up(off + (size_t)3 * IN_O * 4);
  p.bar = (unsigned*)(w + off); off = align_up(off + (size_t)BAR_TOTAL_WORDS * 4);
  p.use_cg = 0ull;

#if MULTI_LAUNCH
  const int G = 1024;
  phase_kernel<0><<<G, NTHR, 0, stream>>>(p);
  phase_kernel<1><<<G, NTHR, 0, stream>>>(p);
  phase_kernel<2><<<G, NTHR, 0, stream>>>(p);
  phase_kernel<3><<<G, NTHR, 0, stream>>>(p);
  phase_kernel<4><<<G, NTHR, 0, stream>>>(p);
  phase_kernel<6><<<G, NTHR, 0, stream>>>(p);
  phase_kernel<7><<<G, NTHR, 0, stream>>>(p);
  phase_kernel<8><<<G, NTHR, 0, stream>>>(p);
  phase_kernel<9><<<G, NTHR, 0, stream>>>(p);
#else
  static int grid_blocks = 0;
  if (!grid_blocks) {
    int dev = 0, cus = 0, per_cu = 0;
    hipGetDevice(&dev);
    hipDeviceGetAttribute(&cus, hipDeviceAttributeMultiprocessorCount, dev);
    hipOccupancyMaxActiveBlocksPerMultiprocessor(&per_cu, mega_kernel, NTHR, 0);
    if (per_cu < 1) per_cu = 1;
    grid_blocks = cus * per_cu;
  }
  (void)hipMemsetAsync(p.bar, 0, (size_t)BAR_TOTAL_WORDS * 4, stream);
  void* args[] = {&p};
  hipError_t e = hipLaunchCooperativeKernel((void*)mega_kernel, dim3(grid_blocks), dim3(NTHR), args, 0, stream);
  if (e != hipSuccess) fprintf(stderr, "cooperative launch failed: %s (grid %d)\n", hipGetErrorString(e), grid_blocks);
#endif
}
```

```cpp
#include <hip/hip_runtime.h>
#include <hip/hip_cooperative_groups.h>
#include <cstdio>
namespace cg = cooperative_groups;

#define PROBE_REPEAT 0x00
#define PROBE_SYNC2 0
#ifndef MULTI_LAUNCH
#define MULTI_LAUNCH 0
#endif

typedef unsigned short u16;
using bf16x8 = __attribute__((ext_vector_type(8))) short;
using f32x4 = __attribute__((ext_vector_type(4))) float;
using u32x4 = __attribute__((ext_vector_type(4))) unsigned;
using u32x2 = __attribute__((ext_vector_type(2))) unsigned;

constexpr int D = 1024;
constexpr int NP = 4096;
constexpr int NS = 2048;
constexpr int NTOK = NP + NS;
constexpr int IN_E = 3072;
constexpr int IN_O = 3584;
constexpr int NTHR = 256;
constexpr int SMEM_BYTES = 64 * 1024;

struct P {
  const float *x_prompt, *x_sample, *cache_k, *cache_v, *c, *c_ctx, *norm_g, *w_mod, *b_mod, *w_in_even, *w_pool,
      *pool_scale, *rpb, *w_out_even, *w_in_odd, *conv_c, *conv_d, *conv_d_b, *ln_g, *ln_b, *w_out_odd, *final_g;
  float* out;
  float* mod;
  u16 *wt_in_even, *wt_out_even, *wt_in_odd, *wt_out_odd, *wpt;
  u16 *h, *proj, *cat;
  u16 *kcb, *vcb;
  float *rowss;
  float *bias1;
  float* x1;
  unsigned* bar;
  unsigned long long use_cg;
};

typedef __bf16 hbf2 __attribute__((ext_vector_type(2)));
typedef float hf2 __attribute__((ext_vector_type(2)));
__device__ __forceinline__ unsigned pack2(float a, float b) {
  const hf2 v = {a, b};
  return __builtin_bit_cast(unsigned, __builtin_convertvector(v, hbf2));
}
__device__ __forceinline__ u16 f2bf(float f) { return (u16)(pack2(f, 0.f) & 0xffffu); }
__device__ __forceinline__ float bf2f(u16 h) { return __uint_as_float(((unsigned)h) << 16); }
__device__ __forceinline__ float bflo(unsigned u) { return __uint_as_float(u << 16); }
__device__ __forceinline__ float bfhi(unsigned u) { return __uint_as_float(u & 0xffff0000u); }
__device__ __forceinline__ float silu_f(float x) { return x * __builtin_amdgcn_rcpf(1.f + __expf(-x)); }
__device__ __forceinline__ float sigmoid_f(float x) { return __builtin_amdgcn_rcpf(1.f + __expf(-x)); }
__device__ __forceinline__ float wave_sum(float v) {
#pragma unroll
  for (int o = 32; o >= 1; o >>= 1) v += __shfl_xor(v, o);
  return v;
}
__device__ __forceinline__ int cond_of_token(int tok) { return tok < NP ? 0 : 1 + ((tok - NP) >> 10); }

__device__ void mod_unit(const P& p, int u, float* sm) {
  const int layer = u / 96, cg32 = u % 96;
  const int tid = threadIdx.x;
  float* sc = sm;
  float* red = sm + 3 * 1024;
  __syncthreads();
#pragma unroll
  for (int q = 0; q < 12; ++q) {
    const int i = tid + q * NTHR;
    const int cv = i >> 10, k = i & 1023;
    const float v = (cv == 0) ? p.c_ctx[k] : p.c[(cv - 1) * 1024 + k];
    sc[i] = silu_f(v);
  }
  __syncthreads();
  const int cq = tid & 7, ks = tid >> 3;
  const float* W = p.w_mod + (size_t)layer * 1024 * 3072 + cg32 * 32 + cq * 4;
  float a[3][4] = {};
#pragma unroll 8
  for (int i = 0; i < 32; ++i) {
    int k = ks * 32 + i;
    using nf4 = __attribute__((ext_vector_type(4))) float;
    const nf4 wq = __builtin_nontemporal_load(reinterpret_cast<const nf4*>(W + (size_t)k * 3072));
    float4 w = make_float4(wq.x, wq.y, wq.z, wq.w);
#pragma unroll
    for (int cv = 0; cv < 3; ++cv) {
      float s = sc[cv * 1024 + k];
      a[cv][0] += s * w.x; a[cv][1] += s * w.y; a[cv][2] += s * w.z; a[cv][3] += s * w.w;
    }
  }
#pragma unroll
  for (int cv = 0; cv < 3; ++cv)
#pragma unroll
    for (int j = 0; j < 4; ++j) {
      float v = a[cv][j];
      v += __shfl_xor(v, 8); v += __shfl_xor(v, 16); v += __shfl_xor(v, 32);
      a[cv][j] = v;
    }
  const int lane = tid & 63, wid = tid >> 6;
  if (lane < 8) {
#pragma unroll
    for (int cv = 0; cv < 3; ++cv)
#pragma unroll
      for (int j = 0; j < 4; ++j) red[wid * 96 + cv * 32 + lane * 4 + j] = a[cv][j];
  }
  __syncthreads();
  if (tid < 96) {
    int cv = tid >> 5, col = tid & 31;
    float v = red[tid] + red[96 + tid] + red[192 + tid] + red[288 + tid];
    int n = cg32 * 32 + col;
    v += p.b_mod[layer * 3072 + n];
    p.mod[(layer * 3 + cv) * 3072 + n] = v;
  }
}

__device__ __forceinline__ int perm_row_general(int s) {
  const int tile = s >> 7, c = s & 127, wc = c >> 6, q = c & 63;
  const int n = ((q >> 5) << 1) | ((q >> 2) & 1), i = (((q >> 3) & 3) << 2) | (q & 3);
  return tile * 128 + wc * 64 + n * 16 + i;
}
__device__ __forceinline__ int perm_row_odd(int s) {
  if (s >= 3072) return perm_row_general(s);
  const int region = s >> 9, ch = s & 511;
  const int type = (region == 0 || region == 3) ? 0 : (region <= 2 ? 1 : 2);
  const int member = (region == 0 || region == 1 || region == 4) ? 0 : 1;
  const int chunk = ch >> 6, wc = (ch >> 5) & 1, cw = ch & 31;
  const int n = member * 2 + ((cw >> 2) & 1), i = ((cw >> 3) << 2) | (cw & 3);
  return (type * 8 + chunk) * 128 + wc * 64 + n * 16 + i;
}
template <int MODE>
__device__ void transpose_tile(const float* __restrict__ src, u16* __restrict__ dst, int K, int N, int t, float* sm) {
  const int tid = threadIdx.x;
  const int ntn = N >> 6;
  const int k0 = (t / ntn) * 64, n0 = (t % ntn) * 64;
  __syncthreads();
  {
    const int r = tid >> 4, c4 = tid & 15;
#pragma unroll
    for (int i = 0; i < 4; ++i) {
      int k = r + 16 * i;
      using nf4 = __attribute__((ext_vector_type(4))) float;
      const nf4 vq = __builtin_nontemporal_load(reinterpret_cast<const nf4*>(src + (size_t)(k0 + k) * N + n0 + c4 * 4));
      float4 v = make_float4(vq.x, vq.y, vq.z, vq.w);
      float* d = sm + k * 65 + c4 * 4;
      d[0] = v.x; d[1] = v.y; d[2] = v.z; d[3] = v.w;
    }
  }
  __syncthreads();
  {
    const int kc = tid & 7, nl = tid >> 3;
#pragma unroll
    for (int i = 0; i < 2; ++i) {
      int n = nl + 32 * i;
      float v[8];
#pragma unroll
      for (int j = 0; j < 8; ++j) v[j] = sm[(kc * 8 + j) * 65 + n];
      u32x4 o;
      o.x = pack2(v[0], v[1]); o.y = pack2(v[2], v[3]); o.z = pack2(v[4], v[5]); o.w = pack2(v[6], v[7]);
      const int drow = MODE == 0 ? (n0 + n) : (MODE == 1 ? perm_row_general(n0 + n) : perm_row_odd(n0 + n));
      *reinterpret_cast<u32x4*>(dst + (size_t)drow * K + k0 + kc * 8) = o;
    }
  }
}

__device__ void phase0(const P& p, char* smem) {
  float* sm = reinterpret_cast<float*>(smem);
  constexpr int T0 = 192, T1 = T0 + 768, T2 = T1 + 256, T3 = T2 + 896, T4 = T3 + 256, T5 = T4 + 16;
  for (int u = blockIdx.x; u < T5; u += gridDim.x) {
    if (u < T0) mod_unit(p, u, sm);
    else if (u < T1) transpose_tile<1>(p.w_in_even, p.wt_in_even, 1024, 3072, u - T0, sm);
    else if (u < T2) transpose_tile<1>(p.w_out_even, p.wt_out_even, 1024, 1024, u - T1, sm);
    else if (u < T3) transpose_tile<2>(p.w_in_odd, p.wt_in_odd, 1024, 3584, u - T2, sm);
    else if (u < T4) transpose_tile<1>(p.w_out_odd, p.wt_out_odd, 1024, 1024, u - T3, sm);
    else { int t = u - T4; int g = t >> 2; transpose_tile<0>(p.w_pool + g * 16384, p.wpt + g * 16384, 128, 128, t & 3, sm); }
  }
}

__device__ void phase_norm(const P& p, int layer, const float* xa, const float* xb) {
  const int lane = threadIdx.x & 63, wid = threadIdx.x >> 6;
  if (layer == 0) {
    for (int prow = blockIdx.x * 4 + wid; prow < IN_O; prow += gridDim.x * 4) {
      const u16* wrow = p.wt_in_odd + (size_t)prow * D + lane * 16;
      const u32x4 w0 = *reinterpret_cast<const u32x4*>(wrow), w1 = *reinterpret_cast<const u32x4*>(wrow + 8);
      const float wf[16] = {bflo(w0.x), bfhi(w0.x), bflo(w0.y), bfhi(w0.y), bflo(w0.z), bfhi(w0.z), bflo(w0.w), bfhi(w0.w),
                            bflo(w1.x), bfhi(w1.x), bflo(w1.y), bfhi(w1.y), bflo(w1.z), bfhi(w1.z), bflo(w1.w), bfhi(w1.w)};
#pragma unroll
      for (int cv = 0; cv < 3; ++cv) {
        const float* sh = p.mod + (size_t)(3 + cv) * 3072 + lane * 16;
        float a = 0.f;
#pragma unroll
        for (int q = 0; q < 4; ++q) {
          const float4 s4 = *reinterpret_cast<const float4*>(sh + q * 4);
          a += s4.x * wf[q * 4] + s4.y * wf[q * 4 + 1] + s4.z * wf[q * 4 + 2] + s4.w * wf[q * 4 + 3];
        }
        a = wave_sum(a);
        if (lane == 0) p.bias1[cv * IN_O + prow] = a;
      }
    }
    for (int i = blockIdx.x * NTHR + threadIdx.x; i < 2 * 32768; i += gridDim.x * NTHR) {
      const float* src = (i < 32768 ? p.cache_k : p.cache_v) + (size_t)(i & 32767) * 8;
      u16* dst = (i < 32768 ? p.kcb : p.vcb) + (size_t)(i & 32767) * 8;
      const float4 a = *reinterpret_cast<const float4*>(src), c = *reinterpret_cast<const float4*>(src + 4);
      u32x4 o; o.x = pack2(a.x, a.y); o.y = pack2(a.z, a.w); o.z = pack2(c.x, c.y); o.w = pack2(c.z, c.w);
      *reinterpret_cast<u32x4*>(dst) = o;
    }
  }
  const float* g = p.norm_g + layer * 1024;
  for (int tok = blockIdx.x * 4 + wid; tok < NTOK; tok += gridDim.x * 4) {
    const float* x = tok < NP ? xa + (size_t)tok * D : xb + (size_t)(tok - NP) * D;
    const float* m = p.mod + (size_t)(layer * 3 + cond_of_token(tok)) * 3072;
    float4 v[4], ggv[4], shv[4], scv[4];
    float ss = 0.f;
#pragma unroll
    for (int i = 0; i < 4; ++i) {
      const int k = i * 256 + lane * 4;
      v[i] = *reinterpret_cast<const float4*>(x + k);
      ggv[i] = *reinterpret_cast<const float4*>(g + k);
      shv[i] = *reinterpret_cast<const float4*>(m + k);
      scv[i] = *reinterpret_cast<const float4*>(m + 1024 + k);
    }
#pragma unroll
    for (int i = 0; i < 4; ++i) ss += v[i].x * v[i].x + v[i].y * v[i].y + v[i].z * v[i].z + v[i].w * v[i].w;
    ss = wave_sum(ss);
    const float rinv = rsqrtf(ss * (1.f / 1024.f) + 1e-6f);
#pragma unroll
    for (int i = 0; i < 4; ++i) {
      const int k = i * 256 + lane * 4;
      const float4 gg = ggv[i], sh = shv[i], sc = scv[i];
      float h0 = v[i].x * rinv * gg.x * (1.f + sc.x) + sh.x;
      float h1 = v[i].y * rinv * gg.y * (1.f + sc.y) + sh.y;
      float h2 = v[i].z * rinv * gg.z * (1.f + sc.z) + sh.z;
      float h3 = v[i].w * rinv * gg.w * (1.f + sc.w) + sh.w;
      u32x2 o; o.x = pack2(h0, h1); o.y = pack2(h2, h3);
      *reinterpret_cast<u32x2*>(p.h + (size_t)tok * D + k) = o;
    }
  }
}

template <int EPI, int BM>
__device__ void gemm_phase(const P& p, const u16* __restrict__ A, const u16* __restrict__ Bt, int N, char* smem) {
  constexpr int K = 1024, BK = 64;
  const int tid = threadIdx.x, wid = tid >> 6, lane = tid & 63, wr = wid >> 1, wc = wid & 1, fr = lane & 15, fq = lane >> 4;
  const int NT = N >> 7;
  constexpr int MI = BM / 32;
  constexpr int NAL = BM / 32;
  const int ntiles = (NTOK / BM) * NT;
  const int srow = tid >> 3;
  const int schunk = (tid & 7) ^ ((tid >> 4) & 7);
  const u16* ga = nullptr; const u16* gb = nullptr;
  if ((int)blockIdx.x < ntiles) {
    const int mt0 = blockIdx.x / NT, nt0 = blockIdx.x % NT;
    ga = A + (size_t)(mt0 * BM + srow) * K + schunk * 8;
    gb = Bt + (size_t)(nt0 * 128 + srow) * K + schunk * 8;
    __syncthreads();
#pragma unroll
    for (int i = 0; i < NAL; ++i)
      __builtin_amdgcn_global_load_lds((const unsigned*)(ga + (size_t)(32 * i) * K), (unsigned*)(smem + i * 4096 + tid * 16), 16, 0, 0);
#pragma unroll
    for (int i = 0; i < 4; ++i)
      __builtin_amdgcn_global_load_lds((const unsigned*)(gb + (size_t)(32 * i) * K), (unsigned*)(smem + 16384 + i * 4096 + tid * 16), 16, 0, 0);
  }
  for (int tile = blockIdx.x; tile < ntiles; tile += gridDim.x) {
    const int mt = tile / NT, nt = tile % NT;
    const int brow = mt * BM, bcol = nt * 128;
    f32x4 acc[MI][4] = {};
    for (int t = 0; t < K / BK; ++t) {
      char* SA = smem + (t & 1) * 32768;
      char* SB = SA + 16384;
      asm volatile("s_waitcnt vmcnt(0)" ::: "memory");
      __syncthreads();
      if (t + 1 < K / BK) {
        char* NA = smem + ((t + 1) & 1) * 32768;
#pragma unroll
        for (int i = 0; i < NAL; ++i)
          __builtin_amdgcn_global_load_lds((const unsigned*)(ga + (size_t)(32 * i) * K + (t + 1) * BK), (unsigned*)(NA + i * 4096 + tid * 16), 16, 0, 0);
#pragma unroll
        for (int i = 0; i < 4; ++i)
          __builtin_amdgcn_global_load_lds((const unsigned*)(gb + (size_t)(32 * i) * K + (t + 1) * BK), (unsigned*)(NA + 16384 + i * 4096 + tid * 16), 16, 0, 0);
      } else {
        const int tn = tile + gridDim.x;
        if (tn < ntiles) {
          const int mtn = tn / NT, ntn = tn % NT;
          ga = A + (size_t)(mtn * BM + srow) * K + schunk * 8;
          gb = Bt + (size_t)(ntn * 128 + srow) * K + schunk * 8;
#pragma unroll
          for (int i = 0; i < NAL; ++i)
            __builtin_amdgcn_global_load_lds((const unsigned*)(ga + (size_t)(32 * i) * K), (unsigned*)(smem + i * 4096 + tid * 16), 16, 0, 0);
#pragma unroll
          for (int i = 0; i < 4; ++i)
            __builtin_amdgcn_global_load_lds((const unsigned*)(gb + (size_t)(32 * i) * K), (unsigned*)(smem + 16384 + i * 4096 + tid * 16), 16, 0, 0);
        }
      }
#pragma unroll
      for (int kk = 0; kk < 2; ++kk) {
        bf16x8 af[MI], bfr[4];
#pragma unroll
        for (int m = 0; m < MI; ++m) {
          const int r = wr * (BM / 2) + m * 16 + fr;
          af[m] = *reinterpret_cast<const bf16x8*>(SA + r * 128 + (((kk * 4 + fq) ^ ((r >> 1) & 7)) << 4));
        }
#pragma unroll
        for (int n = 0; n < 4; ++n) {
          const int r = wc * 64 + n * 16 + fr;
          bfr[n] = *reinterpret_cast<const bf16x8*>(SB + r * 128 + (((kk * 4 + fq) ^ ((r >> 1) & 7)) << 4));
        }
#pragma unroll
        for (int m = 0; m < MI; ++m)
#pragma unroll
          for (int n = 0; n < 4; ++n) acc[m][n] = __builtin_amdgcn_mfma_f32_16x16x32_bf16(bfr[n], af[m], acc[m][n], 0, 0, 0);
      }
    }
    if (EPI == 0) {
      const bool gate_tile = (nt >= 4 && nt < 8) || nt >= 20;
#pragma unroll
      for (int m = 0; m < MI; ++m) {
        const int row = brow + wr * (BM / 2) + m * 16 + fr;
#pragma unroll
        for (int np = 0; np < 2; ++np) {
          const int col = bcol + wc * 64 + np * 32 + fq * 8;
          float v[8];
#pragma unroll
          for (int j = 0; j < 4; ++j) { v[j] = acc[m][np * 2][j]; v[4 + j] = acc[m][np * 2 + 1][j]; }
          if (gate_tile) {
#pragma unroll
            for (int j = 0; j < 8; ++j) v[j] = silu_f(v[j]);
          }
          u32x4 o; o.x = pack2(v[0], v[1]); o.y = pack2(v[2], v[3]); o.z = pack2(v[4], v[5]); o.w = pack2(v[6], v[7]);
          *reinterpret_cast<u32x4*>(p.proj + (size_t)row * IN_E + col) = o;
          if (brow < NP && nt >= 12 && nt < 20) {
            const bool isv = nt >= 16;
            float* dst = p.out + (size_t)NTOK * D + (isv ? (size_t)16 * 8 * 256 * 64 : 0);
            const int cc = col - (isv ? 2048 : 1536);
            const int b = row >> 8, tt = row & 255, hh = cc >> 6, dd = cc & 63;
            float* d2 = dst + (((size_t)b * 8 + hh) * 256 + tt) * 64 + dd;
            *reinterpret_cast<float4*>(d2) = make_float4(v[0], v[1], v[2], v[3]);
            *reinterpret_cast<float4*>(d2 + 4) = make_float4(v[4], v[5], v[6], v[7]);
          }
        }
      }
    } else if (EPI == 2) {
      {
        float rinv[MI];
        int cvm[MI];
#pragma unroll
        for (int m = 0; m < MI; ++m) {
          const int row = brow + wr * (BM / 2) + m * 16 + fr;
          cvm[m] = cond_of_token(row);
          const float* rs = p.rowss + (size_t)row * 16;
          const float4 a = *reinterpret_cast<const float4*>(rs), b2 = *reinterpret_cast<const float4*>(rs + 4);
          const float4 c2 = *reinterpret_cast<const float4*>(rs + 8), d2 = *reinterpret_cast<const float4*>(rs + 12);
          const float tot = (a.x + a.y + a.z + a.w) + (b2.x + b2.y + b2.z + b2.w) + (c2.x + c2.y + c2.z + c2.w) + (d2.x + d2.y + d2.z + d2.w);
          rinv[m] = rsqrtf(tot * (1.f / 1024.f) + 1e-6f);
        }
#pragma unroll
        for (int n = 0; n < 4; ++n) {
#pragma unroll
          for (int m = 0; m < MI; ++m) {
            const float4 bz = *reinterpret_cast<const float4*>(p.bias1 + (size_t)cvm[m] * IN_O + bcol + wc * 64 + n * 16 + fq * 4);
            acc[m][n][0] = acc[m][n][0] * rinv[m] + bz.x; acc[m][n][1] = acc[m][n][1] * rinv[m] + bz.y;
            acc[m][n][2] = acc[m][n][2] * rinv[m] + bz.z; acc[m][n][3] = acc[m][n][3] * rinv[m] + bz.w;
          }
        }
      }
      if (nt < 24) {
        const int type = nt >> 3, chunk = nt & 7;
#pragma unroll
        for (int m = 0; m < MI; ++m) {
          const int row = brow + wr * (BM / 2) + m * 16 + fr;
          float v[8];
#pragma unroll
          for (int nl = 0; nl < 2; ++nl)
#pragma unroll
            for (int j = 0; j < 4; ++j) {
              const float a = acc[m][nl][j], b = acc[m][2 + nl][j];
              v[nl * 4 + j] = type == 0 ? a * silu_f(b) : (type == 1 ? a * b : a * sigmoid_f(b));
            }
          u32x4 o; o.x = pack2(v[0], v[1]); o.y = pack2(v[2], v[3]); o.z = pack2(v[4], v[5]); o.w = pack2(v[6], v[7]);
          *reinterpret_cast<u32x4*>(p.proj + (size_t)row * 2048 + type * 512 + chunk * 64 + wc * 32 + fq * 8) = o;
        }
      } else {
#pragma unroll
        for (int m = 0; m < MI; ++m) {
          const int row = brow + wr * (BM / 2) + m * 16 + fr;
#pragma unroll
          for (int np = 0; np < 2; ++np) {
            float v[8];
#pragma unroll
            for (int j = 0; j < 4; ++j) { v[j] = silu_f(acc[m][np * 2][j]); v[4 + j] = silu_f(acc[m][np * 2 + 1][j]); }
            u32x4 o; o.x = pack2(v[0], v[1]); o.y = pack2(v[2], v[3]); o.z = pack2(v[4], v[5]); o.w = pack2(v[6], v[7]);
            *reinterpret_cast<u32x4*>(p.proj + (size_t)row * 2048 + 1536 + (nt - 24) * 128 + wc * 64 + np * 32 + fq * 8) = o;
          }
        }
      }
    } else {
      const int layer = (EPI == 1) ? 0 : 1;
      float ssq[MI] = {};
#pragma unroll
      for (int np = 0; np < 2; ++np) {
        const int col = bcol + wc * 64 + np * 32 + fq * 8;
        float4 n0 = {}, n1 = {};
        if (EPI == 1) { n0 = *reinterpret_cast<const float4*>(p.norm_g + 1024 + col); n1 = *reinterpret_cast<const float4*>(p.norm_g + 1024 + col + 4); }
#pragma unroll
        for (int m = 0; m < MI; ++m) {
          const int row = brow + wr * (BM / 2) + m * 16 + fr;
          const int cv = cond_of_token(row);
          const float* gate = p.mod + (size_t)(layer * 3 + cv) * 3072 + 2048 + col;
          const float4 g0 = *reinterpret_cast<const float4*>(gate);
          const float4 g1 = *reinterpret_cast<const float4*>(gate + 4);
          const float* xin = (EPI == 1) ? (row < NP ? p.x_prompt + (size_t)row * D + col : p.x_sample + (size_t)(row - NP) * D + col)
                                        : p.x1 + (size_t)row * D + col;
          const float4 x0 = *reinterpret_cast<const float4*>(xin);
          const float4 x1v = *reinterpret_cast<const float4*>(xin + 4);
          float4 o0, o1;
          o0.x = x0.x + g0.x * acc[m][np * 2][0]; o0.y = x0.y + g0.y * acc[m][np * 2][1];
          o0.z = x0.z + g0.z * acc[m][np * 2][2]; o0.w = x0.w + g0.w * acc[m][np * 2][3];
          o1.x = x1v.x + g1.x * acc[m][np * 2 + 1][0]; o1.y = x1v.y + g1.y * acc[m][np * 2 + 1][1];
          o1.z = x1v.z + g1.z * acc[m][np * 2 + 1][2]; o1.w = x1v.w + g1.w * acc[m][np * 2 + 1][3];
          float* xo = p.x1 + (size_t)row * D + col;
          *reinterpret_cast<float4*>(xo) = o0;
          *reinterpret_cast<float4*>(xo + 4) = o1;
          if (EPI == 1) {
            const float* sc = p.mod + (size_t)(3 + cv) * 3072 + 1024 + col;
            const float4 s0 = *reinterpret_cast<const float4*>(sc), s1 = *reinterpret_cast<const float4*>(sc + 4);
            ssq[m] += o0.x * o0.x + o0.y * o0.y + o0.z * o0.z + o0.w * o0.w + o1.x * o1.x + o1.y * o1.y + o1.z * o1.z + o1.w * o1.w;
            u32x4 hv;
            hv.x = pack2(o0.x * n0.x * (1.f + s0.x), o0.y * n0.y * (1.f + s0.y)); hv.y = pack2(o0.z * n0.z * (1.f + s0.z), o0.w * n0.w * (1.f + s0.w));
            hv.z = pack2(o1.x * n1.x * (1.f + s1.x), o1.y * n1.y * (1.f + s1.y)); hv.w = pack2(o1.z * n1.z * (1.f + s1.z), o1.w * n1.w * (1.f + s1.w));
            *reinterpret_cast<u32x4*>(p.h + (size_t)row * D + col) = hv;
          }
        }
      }
      if (EPI == 1) {
#pragma unroll
        for (int m = 0; m < MI; ++m) {
          float v = ssq[m];
          v += __shfl_xor(v, 16); v += __shfl_xor(v, 32);
          if (fq == 0) p.rowss[(size_t)(brow + wr * (BM / 2) + m * 16 + fr) * 16 + nt * 2 + wc] = v;
        }
      }
    }
  }
}

template <int MODE>
__device__ void attn_unit(const P& p, int u, char* smem) {
  const int tid = threadIdx.x, wid = tid >> 6, lane = tid & 63, fr = lane & 15, fq = lane >> 4;
  char* Ks = smem;
  u16* Vt = reinterpret_cast<u16*>(smem + 16384);
  float* rpl = reinterpret_cast<float*>(smem + 16384 + 18432);
  int h, qtok0, b, r = 0;
  if (MODE == 0) { b = u >> 5; h = (u >> 2) & 7; qtok0 = b * 256 + (u & 3) * 64; }
  else { b = u >> 7; r = (u >> 3) & 15; h = u & 7; qtok0 = NP + b * 1024 + r * 64; }
  constexpr int NSS = MODE == 0 ? 2 : 6;
  const int c0 = wid * 16;
  int ksc = c0 - 8; ksc = ksc < 0 ? 0 : (ksc > 32 ? 32 : ksc);
  const int rs = (r - 4) < 0 ? 0 : ((r - 4) > 8 ? 8 : (r - 4));
  bf16x8 qf[2];
  {
    const u16* q = p.proj + (size_t)(qtok0 + wid * 16 + fr) * IN_E + 1024 + h * 64 + fq * 8;
    qf[0] = *reinterpret_cast<const bf16x8*>(q);
    qf[1] = *reinterpret_cast<const bf16x8*>(q + 32);
  }
  u32x2 gbv[4];
#pragma unroll
  for (int dt = 0; dt < 4; ++dt)
    gbv[dt] = *reinterpret_cast<const u32x2*>(p.proj + (size_t)(qtok0 + wid * 16 + fr) * IN_E + 2560 + h * 64 + dt * 16 + fq * 4);
  const int cq = c0 + fr;
  int cstart = cq - 8; cstart = cstart < 0 ? 0 : (cstart > 48 ? 48 : cstart);
  float mrun = -1e30f, lrun = 0.f;
  f32x4 o[4] = {};
  const float scale = 0.125f;
  const int krow = tid >> 3, kchunk = tid & 7;
  const int vkey = tid & 127, vdh = tid >> 7;
  u32x4 kr[4], vr[4];
  auto prefetch = [&](int ss) {
    const u16* kb; const u16* vb; int ld;
    if (MODE == 0) { kb = p.proj + (size_t)(b * 256 + ss * 128) * IN_E + 1536 + h * 64; vb = kb + 512; ld = IN_E; }
    else if (ss < 4) { kb = p.proj + (size_t)(NP + b * 1024 + (rs + ss * 2) * 64) * IN_E + 1536 + h * 64; vb = kb + 512; ld = IN_E; }
    else { kb = p.kcb + ((size_t)(b * 8 + h) * 256 + (ss - 4) * 128) * 64; vb = p.vcb + ((size_t)(b * 8 + h) * 256 + (ss - 4) * 128) * 64; ld = 64; }
#pragma unroll
    for (int i = 0; i < 4; ++i) kr[i] = *reinterpret_cast<const u32x4*>(kb + (size_t)(krow + 32 * i) * ld + kchunk * 8);
#pragma unroll
    for (int i = 0; i < 4; ++i) vr[i] = *reinterpret_cast<const u32x4*>(vb + (size_t)vkey * ld + vdh * 32 + i * 8);
  };
  prefetch(0);
  if (MODE == 1) {
    __syncthreads();
    for (int i = tid; i < 15 * 31; i += NTHR) rpl[i] = p.rpb[h * 465 + i];
  }
#pragma unroll 1
  for (int ss = 0; ss < NSS; ++ss) {
    const bool local = (MODE == 1 && ss < 4);
    __syncthreads();
#pragma unroll
    for (int i = 0; i < 4; ++i) {
      const int row = krow + 32 * i;
      *reinterpret_cast<u32x4*>(Ks + row * 128 + ((kchunk ^ ((row >> 1) & 7)) << 4)) = kr[i];
    }
    {
      u16* vt = Vt + (vkey >> 6) * 4608 + (vdh * 32) * 72 + (vkey & 63);
#pragma unroll
      for (int i = 0; i < 4; ++i) {
        const unsigned w[4] = {vr[i].x, vr[i].y, vr[i].z, vr[i].w};
#pragma unroll
        for (int j = 0; j < 4; ++j) {
          vt[(i * 8 + 2 * j) * 72] = (u16)(w[j] & 0xffff);
          vt[(i * 8 + 2 * j + 1) * 72] = (u16)(w[j] >> 16);
        }
      }
    }
    if (ss + 1 < NSS) prefetch(ss + 1);
    __syncthreads();
#pragma unroll
    for (int s2 = 0; s2 < 2; ++s2) {
      const u16* Vs = Vt + s2 * 4608;
      const int nchunk = local ? 1 : 2;
      const int kbase = local ? ksc : 0;
      const float* rp = rpl + (rs + ss * 2 + s2 - r + 7) * 31 + 15 - cq;
      for (int ch = 0; ch < nchunk; ++ch) {
        f32x4 sv[2];
#pragma unroll
        for (int t2 = 0; t2 < 2; ++t2) {
          const int koff = kbase + ch * 32 + t2 * 16;
          const int row = s2 * 64 + koff + fr;
          const int sw = (row >> 1) & 7;
          const bf16x8 kf0 = *reinterpret_cast<const bf16x8*>(Ks + row * 128 + ((fq ^ sw) << 4));
          const bf16x8 kf1 = *reinterpret_cast<const bf16x8*>(Ks + row * 128 + (((4 + fq) ^ sw) << 4));
          f32x4 z = {0.f, 0.f, 0.f, 0.f};
          z = __builtin_amdgcn_mfma_f32_16x16x32_bf16(kf0, qf[0], z, 0, 0, 0);
          z = __builtin_amdgcn_mfma_f32_16x16x32_bf16(kf1, qf[1], z, 0, 0, 0);
          if (local) {
#pragma unroll
            for (int j = 0; j < 4; ++j) {
              const int ck = koff + fq * 4 + j;
              int dcl = ck - cq; dcl = dcl < -15 ? -15 : (dcl > 15 ? 15 : dcl);
              const float bias = rp[dcl + cq];
              const bool ok = (ck >= cstart) && (ck < cstart + 16);
              z[j] = ok ? z[j] * scale + bias : -1e30f;
            }
          } else {
#pragma unroll
            for (int j = 0; j < 4; ++j) z[j] *= scale;
          }
          sv[t2] = z;
        }
        float mx = fmaxf(fmaxf(fmaxf(sv[0][0], sv[0][1]), fmaxf(sv[0][2], sv[0][3])), fmaxf(fmaxf(sv[1][0], sv[1][1]), fmaxf(sv[1][2], sv[1][3])));
        mx = fmaxf(mx, __shfl_xor(mx, 16));
        mx = fmaxf(mx, __shfl_xor(mx, 32));
        const float mnew = fmaxf(mrun, mx);
        const float corr = __expf(mrun - mnew);
        mrun = mnew;
        float pv[8];
        float psum = 0.f;
#pragma unroll
        for (int j = 0; j < 4; ++j) { pv[j] = __expf(sv[0][j] - mnew); pv[4 + j] = __expf(sv[1][j] - mnew); }
#pragma unroll
        for (int j = 0; j < 8; ++j) psum += pv[j];
        lrun = lrun * corr + psum;
        u32x4 pk;
        pk.x = pack2(pv[0], pv[1]); pk.y = pack2(pv[2], pv[3]); pk.z = pack2(pv[4], pv[5]); pk.w = pack2(pv[6], pv[7]);
        const bf16x8 pfrag = __builtin_bit_cast(bf16x8, pk);
        const int k0 = kbase + ch * 32;
#pragma unroll
        for (int dt = 0; dt < 4; ++dt) {
          const u16* vp = Vs + (dt * 16 + fr) * 72 + k0 + fq * 4;
          u32x2 v0 = *reinterpret_cast<const u32x2*>(vp);
          u32x2 v1 = *reinterpret_cast<const u32x2*>(vp + 16);
          u32x4 vv; vv.x = v0.x; vv.y = v0.y; vv.z = v1.x; vv.w = v1.y;
          f32x4 oo = o[dt];
          oo[0] *= corr; oo[1] *= corr; oo[2] *= corr; oo[3] *= corr;
          o[dt] = __builtin_amdgcn_mfma_f32_16x16x32_bf16(__builtin_bit_cast(bf16x8, vv), pfrag, oo, 0, 0, 0);
        }
      }
    }
  }
  lrun += __shfl_xor(lrun, 16);
  lrun += __shfl_xor(lrun, 32);
  const float linv = 1.f / lrun;
  const int tok = qtok0 + wid * 16 + fr;
#pragma unroll
  for (int dt = 0; dt < 4; ++dt) {
    const int dd = h * 64 + dt * 16 + fq * 4;
    const u32x2 gb = gbv[dt];
    float r0 = o[dt][0] * linv * bflo(gb.x);
    float r1 = o[dt][1] * linv * bfhi(gb.x);
    float r2 = o[dt][2] * linv * bflo(gb.y);
    float r3 = o[dt][3] * linv * bfhi(gb.y);
    u32x2 ov; ov.x = pack2(r0, r1); ov.y = pack2(r2, r3);
    *reinterpret_cast<u32x2*>(p.cat + (size_t)tok * D + 512 + dd) = ov;
  }
}

template <int G>
__device__ void pool_unit(const P& p, int tile, char* smem) {
  constexpr int HALF = 1 << G;
  constexpr int NR = 64 + 2 * HALF;
  int tid = threadIdx.x;
  asm volatile("" : "+v"(tid));
  const int wid = tid >> 6, lane = tid & 63, fr = lane & 15, fq = lane >> 4;
  char* U = smem;
  char* W = smem + 80 * 272;
  const int T0 = tile * 64;
  int sb, se;
  if (T0 < NP) { sb = T0 & ~255; se = sb + 256; } else { sb = NP + ((T0 - NP) & ~1023); se = sb + 1024; }
  __syncthreads();
  {
    constexpr int NIT = (NR * 16 + NTHR - 1) / NTHR;
    u32x4 sv[NIT];
#pragma unroll
    for (int i = 0; i < NIT; ++i) {
      const int c = tid + i * NTHR, rr = c >> 4, c16 = c & 15;
      int tt = T0 - HALF + rr; tt = tt < sb ? sb : (tt >= se ? se - 1 : tt);
      sv[i] = *reinterpret_cast<const u32x4*>(p.proj + (size_t)tt * IN_E + G * 128 + c16 * 8);
    }
#pragma unroll
    for (int i = 0; i < NIT; ++i) {
      const int c = tid + i * NTHR, rr = c >> 4, c16 = c & 15;
      if (c < NR * 16) *reinterpret_cast<u32x4*>(U + rr * 272 + c16 * 16) = sv[i];
    }
  }
#pragma unroll
  for (int i = 0; i < 8; ++i) {
    const int c = tid + i * NTHR, rr = c >> 4, c16 = c & 15;
    *reinterpret_cast<u32x4*>(W + rr * 272 + c16 * 16) = *reinterpret_cast<const u32x4*>(p.wpt + (size_t)G * 16384 + rr * 128 + c16 * 8);
  }
  __syncthreads();
  const int t = T0 + wid * 16 + fr;
  int lo = t - HALF; lo = lo < sb ? sb : lo;
  int hi = t + HALF; hi = hi > se ? se : hi;
  const float inv = 1.f / (float)(hi - lo);
  f32x4 acc[8] = {};
#pragma unroll 1
  for (int ks = 0; ks < 4; ++ks) {
    const char* ub = U + (wid * 16 + fr) * 272 + (ks * 4 + fq) * 16;
    float sum[8] = {};
#pragma unroll
    for (int i = 0; i < 2 * HALF; ++i) {
      const int tt = t - HALF + i;
      const float m = (tt >= lo && tt < hi) ? 1.f : 0.f;
      const u32x4 w2 = *reinterpret_cast<const u32x4*>(ub + i * 272);
      sum[0] += m * bflo(w2.x); sum[1] += m * bfhi(w2.x); sum[2] += m * bflo(w2.y); sum[3] += m * bfhi(w2.y);
      sum[4] += m * bflo(w2.z); sum[5] += m * bfhi(w2.z); sum[6] += m * bflo(w2.w); sum[7] += m * bfhi(w2.w);
    }
    const u32x4 w = *reinterpret_cast<const u32x4*>(ub + HALF * 272);
    const float uu[8] = {bflo(w.x), bfhi(w.x), bflo(w.y), bfhi(w.y), bflo(w.z), bfhi(w.z), bflo(w.w), bfhi(w.w)};
    u32x4 pk;
    pk.x = pack2(sum[0] * inv - uu[0], sum[1] * inv - uu[1]);
    pk.y = pack2(sum[2] * inv - uu[2], sum[3] * inv - uu[3]);
    pk.z = pack2(sum[4] * inv - uu[4], sum[5] * inv - uu[5]);
    pk.w = pack2(sum[6] * inv - uu[6], sum[7] * inv - uu[7]);
    const bf16x8 af = __builtin_bit_cast(bf16x8, pk);
#pragma unroll
    for (int n = 0; n < 8; ++n) {
      const bf16x8 bfr = *reinterpret_cast<const bf16x8*>(W + (n * 16 + fr) * 272 + (ks * 4 + fq) * 16);
      acc[n] = __builtin_amdgcn_mfma_f32_16x16x32_bf16(bfr, af, acc[n], 0, 0, 0);
    }
  }
#pragma unroll
  for (int n = 0; n < 8; ++n) {
    const int dd = G * 128 + n * 16 + fq * 4;
    const float4 ps = *reinterpret_cast<const float4*>(p.pool_scale + dd);
    const u32x2 ga = *reinterpret_cast<const u32x2*>(p.proj + (size_t)t * IN_E + 512 + dd);
    u32x2 ov;
    ov.x = pack2(acc[n][0] * ps.x * bflo(ga.x), acc[n][1] * ps.y * bfhi(ga.x));
    ov.y = pack2(acc[n][2] * ps.z * bflo(ga.y), acc[n][3] * ps.w * bfhi(ga.y));
    *reinterpret_cast<u32x2*>(p.cat + (size_t)t * D + dd) = ov;
  }
}

__device__ void phase_even_mix(const P& p, char* smem) {
  if (gridDim.x == 512) {
    const int bx = blockIdx.x;
    if (bx < 256) {
      attn_unit<1>(p, bx, smem);
      const int q = bx, g = q & 3, tile = q >> 2;
      if (g == 0) pool_unit<0>(p, tile, smem); else if (g == 1) pool_unit<1>(p, tile, smem); else if (g == 2) pool_unit<2>(p, tile, smem); else pool_unit<3>(p, tile, smem);
    } else {
      attn_unit<0>(p, (bx - 256) * 2, smem);
      attn_unit<0>(p, (bx - 256) * 2 + 1, smem);
      if (bx < 384) {
        const int q = bx, g = q & 3, tile = q >> 2;
        if (g == 0) pool_unit<0>(p, tile, smem); else if (g == 1) pool_unit<1>(p, tile, smem); else if (g == 2) pool_unit<2>(p, tile, smem); else pool_unit<3>(p, tile, smem);
      }
    }
    return;
  }
  constexpr int U_N = 256, U_C = 512, U_P = 384;
  for (int u = blockIdx.x; u < U_N + U_C + U_P; u += gridDim.x) {
    if (u < U_N) attn_unit<1>(p, u, smem);
    else if (u < U_N + U_C) attn_unit<0>(p, u - U_N, smem);
    else {
      const int q = u - U_N - U_C, g = q & 3, tile = q >> 2;
      if (g == 0) pool_unit<0>(p, tile, smem); else if (g == 1) pool_unit<1>(p, tile, smem); else if (g == 2) pool_unit<2>(p, tile, smem); else pool_unit<3>(p, tile, smem);
    }
  }
}

__device__ void odd_unit(const P& p, int u, char* smem) {
  int tid = threadIdx.x;
  asm volatile("" : "+v"(tid));
  const int lane = tid & 63, wid = tid >> 6;
  u16* G = reinterpret_cast<u16*>(smem);
  float* red = reinterpret_cast<float*>(smem + 46 * 1024);
  const int t0 = u * 16;
  int sb, se;
  if (t0 < NP) { sb = t0 & ~255; se = sb + 256; } else { sb = NP + ((t0 - NP) & ~1023); se = sb + 1024; }
  const int ch = tid * 2;
  u32x4 sv[12];
#pragma unroll
  for (int i = 0; i < 12; ++i) {
    const int c = tid + i * NTHR, rr = c >> 6, c16 = c & 63;
    const int tt = t0 - 15 + rr;
    sv[i] = u32x4{0u, 0u, 0u, 0u};
    if (c < 46 * 64 && tt >= sb && tt < se) sv[i] = *reinterpret_cast<const u32x4*>(p.proj + (size_t)tt * 2048 + 1024 + c16 * 8);
  }
  unsigned cxw[18], bww[16], gdw[16];
#pragma unroll
  for (int q = 0; q < 18; ++q) {
    const int tt = t0 + q - 1;
    cxw[q] = 0u;
    if (tt >= sb && tt < se) cxw[q] = *reinterpret_cast<const unsigned*>(p.proj + (size_t)tt * 2048 + 512 + ch);
  }
#pragma unroll
  for (int i = 0; i < 16; ++i) {
    bww[i] = *reinterpret_cast<const unsigned*>(p.proj + (size_t)(t0 + i) * 2048 + ch);
    gdw[i] = *reinterpret_cast<const unsigned*>(p.proj + (size_t)(t0 + i) * 2048 + 1536 + ch);
  }
  float2 w[31];
#pragma unroll
  for (int j = 0; j < 31; ++j) w[j] = *reinterpret_cast<const float2*>(p.conv_d + j * 512 + ch);
  const float2 bias = *reinterpret_cast<const float2*>(p.conv_d_b + ch);
  const float2 lg = *reinterpret_cast<const float2*>(p.ln_g + ch);
  const float2 lb = *reinterpret_cast<const float2*>(p.ln_b + ch);
  const float2 wc0 = *reinterpret_cast<const float2*>(p.conv_c + ch);
  const float2 wc1 = *reinterpret_cast<const float2*>(p.conv_c + 512 + ch);
  const float2 wc2 = *reinterpret_cast<const float2*>(p.conv_c + 1024 + ch);
  __syncthreads();
#pragma unroll
  for (int i = 0; i < 12; ++i) {
    const int c = tid + i * NTHR, rr = c >> 6, c16 = c & 63;
    if (c < 46 * 64) *reinterpret_cast<u32x4*>(G + rr * 512 + c16 * 8) = sv[i];
  }
#pragma unroll
  for (int i = 0; i < 16; ++i) {
    const int tok = t0 + i;
    const float c0 = bflo(bww[i]) * (wc0.x * bflo(cxw[i]) + wc1.x * bflo(cxw[i + 1]) + wc2.x * bflo(cxw[i + 2]));
    const float c1 = bfhi(bww[i]) * (wc0.y * bfhi(cxw[i]) + wc1.y * bfhi(cxw[i + 1]) + wc2.y * bfhi(cxw[i + 2]));
    *reinterpret_cast<unsigned*>(p.cat + (size_t)tok * D + ch) = pack2(c0, c1);
  }
  __syncthreads();
#pragma unroll
  for (int hf = 0; hf < 2; ++hf) {
    float2 z[8];
#pragma unroll
    for (int i = 0; i < 8; ++i) z[i] = bias;
    const u16* Gh = G + hf * 8 * 512 + ch;
#pragma unroll
    for (int r = 0; r < 38; ++r) {
      const unsigned gv = *reinterpret_cast<const unsigned*>(Gh + r * 512);
      const float g0 = bflo(gv), g1 = bfhi(gv);
#pragma unroll
      for (int i = 0; i < 8; ++i) {
        const int j = r - i;
        if (j >= 0 && j <= 30) { z[i].x += w[j].x * g0; z[i].y += w[j].y * g1; }
      }
    }
    float* rd = red + hf * 64;
#pragma unroll
    for (int i = 0; i < 8; ++i) {
      const float sv2 = wave_sum(z[i].x + z[i].y);
      if (lane == 0) rd[wid * 8 + i] = sv2;
    }
    __syncthreads();
    float mu[8];
#pragma unroll
    for (int i = 0; i < 8; ++i) mu[i] = (rd[i] + rd[8 + i] + rd[16 + i] + rd[24 + i]) * (1.f / 512.f);
#pragma unroll
    for (int i = 0; i < 8; ++i) {
      const float d0 = z[i].x - mu[i], d1 = z[i].y - mu[i];
      const float sv2 = wave_sum(d0 * d0 + d1 * d1);
      if (lane == 0) rd[32 + wid * 8 + i] = sv2;
    }
    __syncthreads();
#pragma unroll
    for (int i = 0; i < 8; ++i) {
      const float rstd = rsqrtf((rd[32 + i] + rd[40 + i] + rd[48 + i] + rd[56 + i]) * (1.f / 512.f) + 1e-6f);
      const int tok = t0 + hf * 8 + i;
      const unsigned gd = gdw[hf * 8 + i];
      const float l0 = (z[i].x - mu[i]) * rstd * lg.x + lb.x;
      const float l1 = (z[i].y - mu[i]) * rstd * lg.y + lb.y;
      *reinterpret_cast<unsigned*>(p.cat + (size_t)tok * D + 512 + ch) = pack2(silu_f(l0) * bflo(gd), silu_f(l1) * bfhi(gd));
    }
  }
}

__device__ void phase_odd_mix(const P& p, char* smem) {
  for (int u = blockIdx.x; u < NTOK / 16; u += gridDim.x) odd_unit(p, u, smem);
}

__device__ void phase_final(const P& p) {
  const int lane = threadIdx.x & 63, wid = threadIdx.x >> 6;
  for (int tok = blockIdx.x * 4 + wid; tok < NTOK; tok += gridDim.x * 4) {
    const float* x = p.x1 + (size_t)tok * D;
    float4 v[4];
    float ss = 0.f;
#pragma unroll
    for (int i = 0; i < 4; ++i) {
      v[i] = *reinterpret_cast<const float4*>(x + i * 256 + lane * 4);
      ss += v[i].x * v[i].x + v[i].y * v[i].y + v[i].z * v[i].z + v[i].w * v[i].w;
    }
    ss = wave_sum(ss);
    const float rinv = rsqrtf(ss * (1.f / 1024.f) + 1e-6f);
#pragma unroll
    for (int i = 0; i < 4; ++i) {
      const int k = i * 256 + lane * 4;
      float4 gg = *reinterpret_cast<const float4*>(p.final_g + k);
      float4 o = make_float4(v[i].x * rinv * gg.x, v[i].y * rinv * gg.y, v[i].z * rinv * gg.z, v[i].w * rinv * gg.w);
      *reinterpret_cast<float4*>(p.out + (size_t)tok * D + k) = o;
    }
  }
}

#define XB_TMO      128
#define XB_XCNT(j)  (256  + 64 * (j))
#define XB_XSUB(j)  (1280 + 64 * (j))
#define XB_XGEN(j)  (2304 + 64 * (j))
#define XB_TOP      3328
#define XB_TOPGEN   3392
#define XCD_BAR_WORDS 3456
#define XB_SPIN_CAP (1u << 18)
#define LAS __attribute__((address_space(3)))

__device__ __forceinline__ unsigned xb_ld(unsigned* p)              { return __hip_atomic_load(p, __ATOMIC_RELAXED, __HIP_MEMORY_SCOPE_AGENT); }
__device__ __forceinline__ unsigned xb_add(unsigned* p, unsigned v) { return __hip_atomic_fetch_add(p, v, __ATOMIC_RELAXED, __HIP_MEMORY_SCOPE_AGENT); }
__device__ __forceinline__ unsigned xb_xcc_id() { return (unsigned)__builtin_amdgcn_s_getreg((3 << 11) | 20) & 0xFu; }
#define XB_SPIN(cond, bar) do { unsigned _sp = 0; while (cond) { __builtin_amdgcn_s_sleep(1); \
    if ((++_sp & 255u) == 0u) { if (xb_ld(&(bar)[XB_TMO])) break; if (_sp > XB_SPIN_CAP) { atomicAdd(&(bar)[XB_TMO], 1u); break; } } } } while (0)

struct XcdBarrier {
    unsigned* bar; unsigned x;
    unsigned nloc, nx;
    volatile unsigned* st;
};

__device__ __forceinline__ XcdBarrier xcd_barrier_post(unsigned* bar, volatile unsigned* st) {
    XcdBarrier b; b.bar = bar; b.x = xb_xcc_id(); b.st = st; b.nloc = 0u; b.nx = 0u;
    if (threadIdx.x == 0) (void)xb_add(&bar[XB_XCNT(b.x)], 1u);
    return b;
}
__device__ __forceinline__ void xcd_barrier_complete(unsigned* bar, unsigned x, unsigned& nloc, unsigned& nx) {
    const unsigned G = gridDim.x * gridDim.y * gridDim.z;
    unsigned sum, cnt, mine, sp = 0u;
    for (;;) {
        sum = 0u; cnt = 0u; mine = 0u;
#pragma unroll
        for (unsigned j = 0; j < 16; ++j) { const unsigned c = xb_ld(&bar[XB_XCNT(j)]); sum += c; cnt += (c > 0u) ? 1u : 0u; mine = (j == x) ? c : mine; }
        if (sum == G) break;
        __builtin_amdgcn_s_sleep(1);
        if ((++sp & 255u) == 0u) { if (xb_ld(&bar[XB_TMO])) break; if (sp > XB_SPIN_CAP) { atomicAdd(&bar[XB_TMO], 1u); break; } }
    }
    nloc = mine > 0u ? mine : 1u; nx = cnt > 0u ? cnt : 1u;
}

__device__ __forceinline__ void xcd_barrier(XcdBarrier& b) {
    asm volatile("s_waitcnt vmcnt(0)" ::: "memory");
    __syncthreads();
    if (threadIdx.x == 0) {
        unsigned* bar = b.bar;
        __builtin_amdgcn_s_waitcnt(0);
        unsigned nloc = b.nloc, nx = b.nx;
        if (nloc == 0u) { xcd_barrier_complete(bar, b.x, nloc, nx); b.nloc = nloc; b.nx = nx; }
        const unsigned old = xb_add(&bar[XB_XSUB(b.x)], 1u);
        const unsigned gen = old / nloc;
        if (old + 1u == (gen + 1u) * nloc) {
            __builtin_amdgcn_fence(__ATOMIC_RELEASE, "agent");
            asm volatile("s_waitcnt vmcnt(0)" ::: "memory");
            const unsigned og = xb_add(&bar[XB_TOP], 1u);
            const unsigned tg = og / nx;
            if (og + 1u == (tg + 1u) * nx) xb_add(&bar[XB_TOPGEN], 1u);
            else XB_SPIN(xb_ld(&bar[XB_TOPGEN]) == tg, bar);
            __builtin_amdgcn_fence(__ATOMIC_ACQUIRE, "agent");
            xb_add(&bar[XB_XGEN(b.x)], 1u);
            asm volatile("s_waitcnt vmcnt(0)" ::: "memory");
        } else {
            XB_SPIN(xb_ld(&bar[XB_XGEN(b.x)]) == gen, bar);
            __builtin_amdgcn_fence(__ATOMIC_ACQUIRE, "agent");
            asm volatile("s_waitcnt vmcnt(0)" ::: "memory");
        }
    }
    __syncthreads();
}


template <int PH>
__device__ __forceinline__ void run_phase(const P& p, char* smem) {
  if (PH == 0) phase0(p, smem);
  if (PH == 1) phase_norm(p, 0, p.x_prompt, p.x_sample);
  if (PH == 2) gemm_phase<0, 128>(p, p.h, p.wt_in_even, IN_E, smem);
  if (PH == 3) phase_even_mix(p, smem);
  if (PH == 4) gemm_phase<1, 96>(p, p.cat, p.wt_out_even, D, smem);
  if (PH == 6) gemm_phase<2, 96>(p, p.h, p.wt_in_odd, IN_O, smem);
  if (PH == 7) phase_odd_mix(p, smem);
  if (PH == 8) gemm_phase<3, 96>(p, p.cat, p.wt_out_odd, D, smem);
  if (PH == 9) phase_final(p);
}

__global__ void __launch_bounds__(NTHR, 2) mega_kernel(P p) {
  __shared__ __attribute__((aligned(16))) char smem[SMEM_BYTES];
  cg::grid_group grid = cg::this_grid();
  XcdBarrier xb = xcd_barrier_post(p.bar, (volatile unsigned*)(p.bar + XCD_BAR_WORDS + 64 * blockIdx.x));
  if (p.use_cg) grid.sync();
#define RUNP(PH) do { run_phase<PH>(p, smem); if ((PROBE_REPEAT >> PH) & 1) { xcd_barrier(xb); run_phase<PH>(p, smem); } } while (0)
#define GSYNC() do { xcd_barrier(xb); if (PROBE_SYNC2) xcd_barrier(xb); } while (0)
  RUNP(0); GSYNC();
  RUNP(1); GSYNC();
  RUNP(2); GSYNC();
  RUNP(3); GSYNC();
  RUNP(4); GSYNC();
  RUNP(6); GSYNC();
  RUNP(7); GSYNC();
  run_phase<8>(p, smem); GSYNC();
  RUNP(9);
}

template <int PH>
__global__ void __launch_bounds__(NTHR, 2) phase_kernel(P p) {
  __shared__ __attribute__((aligned(16))) char smem[SMEM_BYTES];
  run_phase<PH>(p, smem);
}

constexpr int BAR_TOTAL_WORDS = XCD_BAR_WORDS + 64 * 2048;
static inline size_t align_up(size_t x) { return (x + 255) & ~(size_t)255; }

extern "C" void kernel_launch(void* const* d_in, const int* in_sizes, int n_in, void* d_out, int out_size, void* d_ws,
                              size_t ws_size, hipStream_t stream) {
  P p{};
  const float** f = reinterpret_cast<const float**>(&p);
  for (int i = 0; i < 22; ++i) f[i] = (const float*)d_in[i];
  p.out = (float*)d_out;
  char* w = (char*)d_ws;
  size_t off = 0;
  p.mod = (float*)(w + off); off = align_up(off + (size_t)2 * 3 * 3072 * 4);
  p.wt_in_even = (u16*)(w + off); off = align_up(off + (size_t)IN_E * D * 2);
  p.wt_out_even = (u16*)(w + off); off = align_up(off + (size_t)D * D * 2);
  p.wt_in_odd = (u16*)(w + off); off = align_up(off + (size_t)IN_O * D * 2);
  p.wt_out_odd = (u16*)(w + off); off = align_up(off + (size_t)D * D * 2);
  p.wpt = (u16*)(w + off); off = align_up(off + (size_t)4 * 128 * 128 * 2);
  p.h = (u16*)(w + off); off = align_up(off + (size_t)NTOK * D * 2);
  p.proj = (u16*)(w + off); off = align_up(off + (size_t)NTOK * IN_O * 2);
  p.cat = (u16*)(w + off); off = align_up(off + (size_t)NTOK * D * 2);
  p.x1 = (float*)(w + off); off = align_up(off + (size_t)NTOK * D * 4);
  p.kcb = (u16*)(w + off); off = align_up(off + (size_t)262144 * 2);
  p.vcb = (u16*)(w + off); off = align_up(off + (size_t)262144 * 2);
  p.rowss = (float*)(w + off); off = align_up(off + (size_t)NTOK * 16 * 4);
  p.bias1 = (float*)(w + off); off = align_up(off + (size_t)3 * IN_O * 4);
  p.bar = (unsigned*)(w + off); off = align_up(off + (size_t)BAR_TOTAL_WORDS * 4);
  p.use_cg = 0ull;

#if MULTI_LAUNCH
  const int G = 1024;
  phase_kernel<0><<<G, NTHR, 0, stream>>>(p);
  phase_kernel<1><<<G, NTHR, 0, stream>>>(p);
  phase_kernel<2><<<G, NTHR, 0, stream>>>(p);
  phase_kernel<3><<<G, NTHR, 0, stream>>>(p);
  phase_kernel<4><<<G, NTHR, 0, stream>>>(p);
  phase_kernel<6><<<G, NTHR, 0, stream>>>(p);
  phase_kernel<7><<<G, NTHR, 0, stream>>>(p);
  phase_kernel<8><<<G, NTHR, 0, stream>>>(p);
  phase_kernel<9><<<G, NTHR, 0, stream>>>(p);
#else
  static int grid_blocks = 0;
  if (!grid_blocks) {
    int dev = 0, cus = 0, per_cu = 0;
    hipGetDevice(&dev);
    hipDeviceGetAttribute(&cus, hipDeviceAttributeMultiprocessorCount, dev);
    hipOccupancyMaxActiveBlocksPerMultiprocessor(&per_cu, mega_kernel, NTHR, 0);
    if (per_cu < 1) per_cu = 1;
    grid_blocks = cus * per_cu;
  }
  (void)hipMemsetAsync(p.bar, 0, (size_t)BAR_TOTAL_WORDS * 4, stream);
  void* args[] = {&p};
  hipError_t e = hipLaunchCooperativeKernel((void*)mega_kernel, dim3(grid_blocks), dim3(NTHR), args, 0, stream);
  if (e != hipSuccess) fprintf(stderr, "cooperative launch failed: %s (grid %d)\n", hipGetErrorString(e), grid_blocks);
#endif
}
```

```cpp
#include <hip/hip_runtime.h>
#include <hip/hip_cooperative_groups.h>
#include <cstdio>
namespace cg = cooperative_groups;

#define PROBE_REPEAT 0x00
#define PROBE_SYNC2 0
#ifndef MULTI_LAUNCH
#define MULTI_LAUNCH 0
#endif

typedef unsigned short u16;
using bf16x8 = __attribute__((ext_vector_type(8))) short;
using f32x4 = __attribute__((ext_vector_type(4))) float;
using u32x4 = __attribute__((ext_vector_type(4))) unsigned;
using u32x2 = __attribute__((ext_vector_type(2))) unsigned;

constexpr int D = 1024;
constexpr int NP = 4096;
constexpr int NS = 2048;
constexpr int NTOK = NP + NS;
constexpr int IN_E = 3072;
constexpr int IN_O = 3584;
constexpr int NTHR = 256;
constexpr int SMEM_BYTES = 64 * 1024;

struct P {
  const float *x_prompt, *x_sample, *cache_k, *cache_v, *c, *c_ctx, *norm_g, *w_mod, *b_mod, *w_in_even, *w_pool,
      *pool_scale, *rpb, *w_out_even, *w_in_odd, *conv_c, *conv_d, *conv_d_b, *ln_g, *ln_b, *w_out_odd, *final_g;
  float* out;
  float* mod;
  u16 *wt_in_even, *wt_out_even, *wt_in_odd, *wt_out_odd, *wpt;
  u16 *h, *proj, *cat;
  u16 *kcb, *vcb;
  float *rowss;
  float *bias1;
  float* x1;
  unsigned* bar;
  unsigned long long use_cg;
};

typedef __bf16 hbf2 __attribute__((ext_vector_type(2)));
typedef float hf2 __attribute__((ext_vector_type(2)));
__device__ __forceinline__ unsigned pack2(float a, float b) {
  const hf2 v = {a, b};
  return __builtin_bit_cast(unsigned, __builtin_convertvector(v, hbf2));
}
__device__ __forceinline__ u16 f2bf(float f) { return (u16)(pack2(f, 0.f) & 0xffffu); }
__device__ __forceinline__ float bf2f(u16 h) { return __uint_as_float(((unsigned)h) << 16); }
__device__ __forceinline__ float bflo(unsigned u) { return __uint_as_float(u << 16); }
__device__ __forceinline__ float bfhi(unsigned u) { return __uint_as_float(u & 0xffff0000u); }
__device__ __forceinline__ float silu_f(float x) { return x * __builtin_amdgcn_rcpf(1.f + __expf(-x)); }
__device__ __forceinline__ float sigmoid_f(float x) { return __builtin_amdgcn_rcpf(1.f + __expf(-x)); }
__device__ __forceinline__ float wave_sum(float v) {
#pragma unroll
  for (int o = 32; o >= 1; o >>= 1) v += __shfl_xor(v, o);
  return v;
}
__device__ __forceinline__ int cond_of_token(int tok) { return tok < NP ? 0 : 1 + ((tok - NP) >> 10); }

__device__ void mod_unit(const P& p, int u, float* sm) {
  const int layer = u / 96, cg32 = u % 96;
  const int tid = threadIdx.x;
  float* sc = sm;
  float* red = sm + 3 * 1024;
  __syncthreads();
#pragma unroll
  for (int q = 0; q < 12; ++q) {
    const int i = tid + q * NTHR;
    const int cv = i >> 10, k = i & 1023;
    const float v = (cv == 0) ? p.c_ctx[k] : p.c[(cv - 1) * 1024 + k];
    sc[i] = silu_f(v);
  }
  __syncthreads();
  const int cq = tid & 7, ks = tid >> 3;
  const float* W = p.w_mod + (size_t)layer * 1024 * 3072 + cg32 * 32 + cq * 4;
  float a[3][4] = {};
#pragma unroll 8
  for (int i = 0; i < 32; ++i) {
    int k = ks * 32 + i;
    using nf4 = __attribute__((ext_vector_type(4))) float;
    const nf4 wq = __builtin_nontemporal_load(reinterpret_cast<const nf4*>(W + (size_t)k * 3072));
    float4 w = make_float4(wq.x, wq.y, wq.z, wq.w);
#pragma unroll
    for (int cv = 0; cv < 3; ++cv) {
      float s = sc[cv * 1024 + k];
      a[cv][0] += s * w.x; a[cv][1] += s * w.y; a[cv][2] += s * w.z; a[cv][3] += s * w.w;
    }
  }
#pragma unroll
  for (int cv = 0; cv < 3; ++cv)
#pragma unroll
    for (int j = 0; j < 4; ++j) {
      float v = a[cv][j];
      v += __shfl_xor(v, 8); v += __shfl_xor(v, 16); v += __shfl_xor(v, 32);
      a[cv][j] = v;
    }
  const int lane = tid & 63, wid = tid >> 6;
  if (lane < 8) {
#pragma unroll
    for (int cv = 0; cv < 3; ++cv)
#pragma unroll
      for (int j = 0; j < 4; ++j) red[wid * 96 + cv * 32 + lane * 4 + j] = a[cv][j];
  }
  __syncthreads();
  if (tid < 96) {
    int cv = tid >> 5, col = tid & 31;
    float v = red[tid] + red[96 + tid] + red[192 + tid] + red[288 + tid];
    int n = cg32 * 32 + col;
    v += p.b_mod[layer * 3072 + n];
    p.mod[(layer * 3 + cv) * 3072 + n] = v;
  }
}

__device__ __forceinline__ int perm_row_general(int s) {
  const int tile = s >> 7, c = s & 127, wc = c >> 6, q = c & 63;
  const int n = ((q >> 5) << 1) | ((q >> 2) & 1), i = (((q >> 3) & 3) << 2) | (q & 3);
  return tile * 128 + wc * 64 + n * 16 + i;
}
__device__ __forceinline__ int perm_row_odd(int s) {
  if (s >= 3072) return perm_row_general(s);
  const int region = s >> 9, ch = s & 511;
  const int type = (region == 0 || region == 3) ? 0 : (region <= 2 ? 1 : 2);
  const int member = (region == 0 || region == 1 || region == 4) ? 0 : 1;
  const int chunk = ch >> 6, wc = (ch >> 5) & 1, cw = ch & 31;
  const int n = member * 2 + ((cw >> 2) & 1), i = ((cw >> 3) << 2) | (cw & 3);
  return (type * 8 + chunk) * 128 + wc * 64 + n * 16 + i;
}
template <int MODE>
__device__ void transpose_tile(const float* __restrict__ src, u16* __restrict__ dst, int K, int N, int t, float* sm) {
  const int tid = threadIdx.x;
  const int ntn = N >> 6;
  const int k0 = (t / ntn) * 64, n0 = (t % ntn) * 64;
  __syncthreads();
  {
    const int r = tid >> 4, c4 = tid & 15;
#pragma unroll
    for (int i = 0; i < 4; ++i) {
      int k = r + 16 * i;
      using nf4 = __attribute__((ext_vector_type(4))) float;
      const nf4 vq = __builtin_nontemporal_load(reinterpret_cast<const nf4*>(src + (size_t)(k0 + k) * N + n0 + c4 * 4));
      float4 v = make_float4(vq.x, vq.y, vq.z, vq.w);
      float* d = sm + k * 65 + c4 * 4;
      d[0] = v.x; d[1] = v.y; d[2] = v.z; d[3] = v.w;
    }
  }
  __syncthreads();
  {
    const int kc = tid & 7, nl = tid >> 3;
#pragma unroll
    for (int i = 0; i < 2; ++i) {
      int n = nl + 32 * i;
      float v[8];
#pragma unroll
      for (int j = 0; j < 8; ++j) v[j] = sm[(kc * 8 + j) * 65 + n];
      u32x4 o;
      o.x = pack2(v[0], v[1]); o.y = pack2(v[2], v[3]); o.z = pack2(v[4], v[5]); o.w = pack2(v[6], v[7]);
      const int drow = MODE == 0 ? (n0 + n) : (MODE == 1 ? perm_row_general(n0 + n) : perm_row_odd(n0 + n));
      *reinterpret_cast<u32x4*>(dst + (size_t)drow * K + k0 + kc * 8) = o;
    }
  }
}

__device__ void phase0(const P& p, char* smem) {
  float* sm = reinterpret_cast<float*>(smem);
  constexpr int T0 = 192, T1 = T0 + 768, T2 = T1 + 256, T3 = T2 + 896, T4 = T3 + 256, T5 = T4 + 16;
  for (int u = blockIdx.x; u < T5; u += gridDim.x) {
    if (u < T0) mod_unit(p, u, sm);
    else if (u < T1) transpose_tile<1>(p.w_in_even, p.wt_in_even, 1024, 3072, u - T0, sm);
    else if (u < T2) transpose_tile<1>(p.w_out_even, p.wt_out_even, 1024, 1024, u - T1, sm);
    else if (u < T3) transpose_tile<2>(p.w_in_odd, p.wt_in_odd, 1024, 3584, u - T2, sm);
    else if (u < T4) transpose_tile<1>(p.w_out_odd, p.wt_out_odd, 1024, 1024, u - T3, sm);
    else { int t = u - T4; int g = t >> 2; transpose_tile<0>(p.w_pool + g * 16384, p.wpt + g * 16384, 128, 128, t & 3, sm); }
  }
}

__device__ void phase_norm(const P& p, int layer, const float* xa, const float* xb) {
  const int lane = threadIdx.x & 63, wid = threadIdx.x >> 6;
  if (layer == 0) {
    for (int prow = blockIdx.x * 4 + wid; prow < IN_O; prow += gridDim.x * 4) {
      const u16* wrow = p.wt_in_odd + (size_t)prow * D + lane * 16;
      const u32x4 w0 = *reinterpret_cast<const u32x4*>(wrow), w1 = *reinterpret_cast<const u32x4*>(wrow + 8);
      const float wf[16] = {bflo(w0.x), bfhi(w0.x), bflo(w0.y), bfhi(w0.y), bflo(w0.z), bfhi(w0.z), bflo(w0.w), bfhi(w0.w),
                            bflo(w1.x), bfhi(w1.x), bflo(w1.y), bfhi(w1.y), bflo(w1.z), bfhi(w1.z), bflo(w1.w), bfhi(w1.w)};
#pragma unroll
      for (int cv = 0; cv < 3; ++cv) {
        const float* sh = p.mod + (size_t)(3 + cv) * 3072 + lane * 16;
        float a = 0.f;
#pragma unroll
        for (int q = 0; q < 4; ++q) {
          const float4 s4 = *reinterpret_cast<const float4*>(sh + q * 4);
          a += s4.x * wf[q * 4] + s4.y * wf[q * 4 + 1] + s4.z * wf[q * 4 + 2] + s4.w * wf[q * 4 + 3];
        }
        a = wave_sum(a);
        if (lane == 0) p.bias1[cv * IN_O + prow] = a;
      }
    }
    for (int i = blockIdx.x * NTHR + threadIdx.x; i < 2 * 32768; i += gridDim.x * NTHR) {
      const float* src = (i < 32768 ? p.cache_k : p.cache_v) + (size_t)(i & 32767) * 8;
      u16* dst = (i < 32768 ? p.kcb : p.vcb) + (size_t)(i & 32767) * 8;
      const float4 a = *reinterpret_cast<const float4*>(src), c = *reinterpret_cast<const float4*>(src + 4);
      u32x4 o; o.x = pack2(a.x, a.y); o.y = pack2(a.z, a.w); o.z = pack2(c.x, c.y); o.w = pack2(c.z, c.w);
      *reinterpret_cast<u32x4*>(dst) = o;
    }
  }
  const float* g = p.norm_g + layer * 1024;
  for (int tok = blockIdx.x * 4 + wid; tok < NTOK; tok += gridDim.x * 4) {
    const float* x = tok < NP ? xa + (size_t)tok * D : xb + (size_t)(tok - NP) * D;
    const float* m = p.mod + (size_t)(layer * 3 + cond_of_token(tok)) * 3072;
    float4 v[4], ggv[4], shv[4], scv[4];
    float ss = 0.f;
#pragma unroll
    for (int i = 0; i < 4; ++i) {
      const int k = i * 256 + lane * 4;
      v[i] = *reinterpret_cast<const float4*>(x + k);
      ggv[i] = *reinterpret_cast<const float4*>(g + k);
      shv[i] = *reinterpret_cast<const float4*>(m + k);
      scv[i] = *reinterpret_cast<const float4*>(m + 1024 + k);
    }
#pragma unroll
    for (int i = 0; i < 4; ++i) ss += v[i].x * v[i].x + v[i].y * v[i].y + v[i].z * v[i].z + v[i].w * v[i].w;
    ss = wave_sum(ss);
    const float rinv = rsqrtf(ss * (1.f / 1024.f) + 1e-6f);
#pragma unroll
    for (int i = 0; i < 4; ++i) {
      const int k = i * 256 + lane * 4;
      const float4 gg = ggv[i], sh = shv[i], sc = scv[i];
      float h0 = v[i].x * rinv * gg.x * (1.f + sc.x) + sh.x;
      float h1 = v[i].y * rinv * gg.y * (1.f + sc.y) + sh.y;
      float h2 = v[i].z * rinv * gg.z * (1.f + sc.z) + sh.z;
      float h3 = v[i].w * rinv * gg.w * (1.f + sc.w) + sh.w;
      u32x2 o; o.x = pack2(h0, h1); o.y = pack2(h2, h3);
      *reinterpret_cast<u32x2*>(p.h + (size_t)tok * D + k) = o;
    }
  }
}

template <int EPI, int BM>
__device__ void gemm_phase(const P& p, const u16* __restrict__ A, const u16* __restrict__ Bt, int N, char* smem) {
  constexpr int K = 1024, BK = 64;
  const int tid = threadIdx.x, wid = tid >> 6, lane = tid & 63, wr = wid >> 1, wc = wid & 1, fr = lane & 15, fq = lane >> 4;
  const int NT = N >> 7;
  constexpr int MI = BM / 32;
  constexpr int NAL = BM / 32;
  const int ntiles = (NTOK / BM) * NT;
  const int srow = tid >> 3;
  const int schunk = (tid & 7) ^ ((tid >> 4) & 7);
  const u16* ga = nullptr; const u16* gb = nullptr;
  if ((int)blockIdx.x < ntiles) {
    const int mt0 = blockIdx.x / NT, nt0 = blockIdx.x % NT;
    ga = A + (size_t)(mt0 * BM + srow) * K + schunk * 8;
    gb = Bt + (size_t)(nt0 * 128 + srow) * K + schunk * 8;
    __syncthreads();
#pragma unroll
    for (int i = 0; i < NAL; ++i)
      __builtin_amdgcn_global_load_lds((const unsigned*)(ga + (size_t)(32 * i) * K), (unsigned*)(smem + i * 4096 + tid * 16), 16, 0, 0);
#pragma unroll
    for (int i = 0; i < 4; ++i)
      __builtin_amdgcn_global_load_lds((const unsigned*)(gb + (size_t)(32 * i) * K), (unsigned*)(smem + 16384 + i * 4096 + tid * 16), 16, 0, 0);
  }
  for (int tile = blockIdx.x; tile < ntiles; tile += gridDim.x) {
    const int mt = tile / NT, nt = tile % NT;
    const int brow = mt * BM, bcol = nt * 128;
    f32x4 acc[MI][4] = {};
    for (int t = 0; t < K / BK; ++t) {
      char* SA = smem + (t & 1) * 32768;
      char* SB = SA + 16384;
      asm volatile("s_waitcnt vmcnt(0)" ::: "memory");
      __syncthreads();
      if (t + 1 < K / BK) {
        char* NA = smem + ((t + 1) & 1) * 32768;
#pragma unroll
        for (int i = 0; i < NAL; ++i)
          __builtin_amdgcn_global_load_lds((const unsigned*)(ga + (size_t)(32 * i) * K + (t + 1) * BK), (unsigned*)(NA + i * 4096 + tid * 16), 16, 0, 0);
#pragma unroll
        for (int i = 0; i < 4; ++i)
          __builtin_amdgcn_global_load_lds((const unsigned*)(gb + (size_t)(32 * i) * K + (t + 1) * BK), (unsigned*)(NA + 16384 + i * 4096 + tid * 16), 16, 0, 0);
      } else {
        const int tn = tile + gridDim.x;
        if (tn < ntiles) {
          const int mtn = tn / NT, ntn = tn % NT;
          ga = A + (size_t)(mtn * BM + srow) * K + schunk * 8;
          gb = Bt + (size_t)(ntn * 128 + srow) * K + schunk * 8;
#pragma unroll
          for (int i = 0; i < NAL; ++i)
            __builtin_amdgcn_global_load_lds((const unsigned*)(ga + (size_t)(32 * i) * K), (unsigned*)(smem + i * 4096 + tid * 16), 16, 0, 0);
#pragma unroll
          for (int i = 0; i < 4; ++i)
            __builtin_amdgcn_global_load_lds((const unsigned*)(gb + (size_t)(32 * i) * K), (unsigned*)(smem + 16384 + i * 4096 + tid * 16), 16, 0, 0);
        }
      }
      {
        bf16x8 af[2][MI], bfr[2][4];
#pragma unroll
        for (int kk = 0; kk < 2; ++kk) {
#pragma unroll
          for (int n = 0; n < 4; ++n) {
            const int r = wc * 64 + n * 16 + fr;
            bfr[kk][n] = *reinterpret_cast<const bf16x8*>(SB + r * 128 + (((kk * 4 + fq) ^ ((r >> 1) & 7)) << 4));
          }
#pragma unroll
          for (int m = 0; m < MI; ++m) {
            const int r = wr * (BM / 2) + m * 16 + fr;
            af[kk][m] = *reinterpret_cast<const bf16x8*>(SA + r * 128 + (((kk * 4 + fq) ^ ((r >> 1) & 7)) << 4));
          }
        }
#pragma unroll
        for (int kk = 0; kk < 2; ++kk)
#pragma unroll
          for (int m = 0; m < MI; ++m)
#pragma unroll
            for (int n = 0; n < 4; ++n) acc[m][n] = __builtin_amdgcn_mfma_f32_16x16x32_bf16(bfr[kk][n], af[kk][m], acc[m][n], 0, 0, 0);
        __builtin_amdgcn_sched_group_barrier(0x100, MI + 4, 0);
#pragma unroll
        for (int i = 0; i < MI + 4; ++i) {
          __builtin_amdgcn_sched_group_barrier(0x008, 2, 0);
          __builtin_amdgcn_sched_group_barrier(0x100, 1, 0);
        }
        __builtin_amdgcn_sched_group_barrier(0x008, 8 * MI - 2 * (MI + 4), 0);
      }
    }
    if (EPI == 0) {
      const bool gate_tile = (nt >= 4 && nt < 8) || nt >= 20;
#pragma unroll
      for (int m = 0; m < MI; ++m) {
        const int row = brow + wr * (BM / 2) + m * 16 + fr;
#pragma unroll
        for (int np = 0; np < 2; ++np) {
          const int col = bcol + wc * 64 + np * 32 + fq * 8;
          float v[8];
#pragma unroll
          for (int j = 0; j < 4; ++j) { v[j] = acc[m][np * 2][j]; v[4 + j] = acc[m][np * 2 + 1][j]; }
          if (gate_tile) {
#pragma unroll
            for (int j = 0; j < 8; ++j) v[j] = silu_f(v[j]);
          }
          u32x4 o; o.x = pack2(v[0], v[1]); o.y = pack2(v[2], v[3]); o.z = pack2(v[4], v[5]); o.w = pack2(v[6], v[7]);
          *reinterpret_cast<u32x4*>(p.proj + (size_t)row * IN_E + col) = o;
          if (brow < NP && nt >= 12 && nt < 20) {
            const bool isv = nt >= 16;
            float* dst = p.out + (size_t)NTOK * D + (isv ? (size_t)16 * 8 * 256 * 64 : 0);
            const int cc = col - (isv ? 2048 : 1536);
            const int b = row >> 8, tt = row & 255, hh = cc >> 6, dd = cc & 63;
            float* d2 = dst + (((size_t)b * 8 + hh) * 256 + tt) * 64 + dd;
            *reinterpret_cast<float4*>(d2) = make_float4(v[0], v[1], v[2], v[3]);
            *reinterpret_cast<float4*>(d2 + 4) = make_float4(v[4], v[5], v[6], v[7]);
          }
        }
      }
    } else if (EPI == 2) {
      {
        const int cv = cond_of_token(brow);
        float rinv[MI];
#pragma unroll
        for (int m = 0; m < MI; ++m) {
          const float* rs = p.rowss + (size_t)(brow + wr * (BM / 2) + m * 16 + fr) * 16;
          const float4 a = *reinterpret_cast<const float4*>(rs), b2 = *reinterpret_cast<const float4*>(rs + 4);
          const float4 c2 = *reinterpret_cast<const float4*>(rs + 8), d2 = *reinterpret_cast<const float4*>(rs + 12);
          const float tot = (a.x + a.y + a.z + a.w) + (b2.x + b2.y + b2.z + b2.w) + (c2.x + c2.y + c2.z + c2.w) + (d2.x + d2.y + d2.z + d2.w);
          rinv[m] = rsqrtf(tot * (1.f / 1024.f) + 1e-6f);
        }
#pragma unroll
        for (int n = 0; n < 4; ++n) {
          const float4 bz = *reinterpret_cast<const float4*>(p.bias1 + (size_t)cv * IN_O + bcol + wc * 64 + n * 16 + fq * 4);
#pragma unroll
          for (int m = 0; m < MI; ++m) {
            acc[m][n][0] = acc[m][n][0] * rinv[m] + bz.x; acc[m][n][1] = acc[m][n][1] * rinv[m] + bz.y;
            acc[m][n][2] = acc[m][n][2] * rinv[m] + bz.z; acc[m][n][3] = acc[m][n][3] * rinv[m] + bz.w;
          }
        }
      }
      if (nt < 24) {
        const int type = nt >> 3, chunk = nt & 7;
#pragma unroll
        for (int m = 0; m < MI; ++m) {
          const int row = brow + wr * (BM / 2) + m * 16 + fr;
          float v[8];
#pragma unroll
          for (int nl = 0; nl < 2; ++nl)
#pragma unroll
            for (int j = 0; j < 4; ++j) {
              const float a = acc[m][nl][j], b = acc[m][2 + nl][j];
              v[nl * 4 + j] = type == 0 ? a * silu_f(b) : (type == 1 ? a * b : a * sigmoid_f(b));
            }
          u32x4 o; o.x = pack2(v[0], v[1]); o.y = pack2(v[2], v[3]); o.z = pack2(v[4], v[5]); o.w = pack2(v[6], v[7]);
          *reinterpret_cast<u32x4*>(p.proj + (size_t)row * 2048 + type * 512 + chunk * 64 + wc * 32 + fq * 8) = o;
        }
      } else {
#pragma unroll
        for (int m = 0; m < MI; ++m) {
          const int row = brow + wr * (BM / 2) + m * 16 + fr;
#pragma unroll
          for (int np = 0; np < 2; ++np) {
            float v[8];
#pragma unroll
            for (int j = 0; j < 4; ++j) { v[j] = silu_f(acc[m][np * 2][j]); v[4 + j] = silu_f(acc[m][np * 2 + 1][j]); }
            u32x4 o; o.x = pack2(v[0], v[1]); o.y = pack2(v[2], v[3]); o.z = pack2(v[4], v[5]); o.w = pack2(v[6], v[7]);
            *reinterpret_cast<u32x4*>(p.proj + (size_t)row * 2048 + 1536 + (nt - 24) * 128 + wc * 64 + np * 32 + fq * 8) = o;
          }
        }
      }
    } else {
      const int layer = (EPI == 1) ? 0 : 1;
      float ssq[MI] = {};
#pragma unroll
      for (int np = 0; np < 2; ++np) {
        const int col = bcol + wc * 64 + np * 32 + fq * 8;
        float4 n0 = {}, n1 = {};
        if (EPI == 1) { n0 = *reinterpret_cast<const float4*>(p.norm_g + 1024 + col); n1 = *reinterpret_cast<const float4*>(p.norm_g + 1024 + col + 4); }
#pragma unroll
        for (int m = 0; m < MI; ++m) {
          const int row = brow + wr * (BM / 2) + m * 16 + fr;
          const int cv = cond_of_token(row);
          const float* gate = p.mod + (size_t)(layer * 3 + cv) * 3072 + 2048 + col;
          const float4 g0 = *reinterpret_cast<const float4*>(gate);
          const float4 g1 = *reinterpret_cast<const float4*>(gate + 4);
          const float* xin = (EPI == 1) ? (row < NP ? p.x_prompt + (size_t)row * D + col : p.x_sample + (size_t)(row - NP) * D + col)
                                        : p.x1 + (size_t)row * D + col;
          const float4 x0 = *reinterpret_cast<const float4*>(xin);
          const float4 x1v = *reinterpret_cast<const float4*>(xin + 4);
          float4 o0, o1;
          o0.x = x0.x + g0.x * acc[m][np * 2][0]; o0.y = x0.y + g0.y * acc[m][np * 2][1];
          o0.z = x0.z + g0.z * acc[m][np * 2][2]; o0.w = x0.w + g0.w * acc[m][np * 2][3];
          o1.x = x1v.x + g1.x * acc[m][np * 2 + 1][0]; o1.y = x1v.y + g1.y * acc[m][np * 2 + 1][1];
          o1.z = x1v.z + g1.z * acc[m][np * 2 + 1][2]; o1.w = x1v.w + g1.w * acc[m][np * 2 + 1][3];
          float* xo = p.x1 + (size_t)row * D + col;
          *reinterpret_cast<float4*>(xo) = o0;
          *reinterpret_cast<float4*>(xo + 4) = o1;
          if (EPI == 1) {
            const float* sc = p.mod + (size_t)(3 + cv) * 3072 + 1024 + col;
            const float4 s0 = *reinterpret_cast<const float4*>(sc), s1 = *reinterpret_cast<const float4*>(sc + 4);
            ssq[m] += o0.x * o0.x + o0.y * o0.y + o0.z * o0.z + o0.w * o0.w + o1.x * o1.x + o1.y * o1.y + o1.z * o1.z + o1.w * o1.w;
            u32x4 hv;
            hv.x = pack2(o0.x * n0.x * (1.f + s0.x), o0.y * n0.y * (1.f + s0.y)); hv.y = pack2(o0.z * n0.z * (1.f + s0.z), o0.w * n0.w * (1.f + s0.w));
            hv.z = pack2(o1.x * n1.x * (1.f + s1.x), o1.y * n1.y * (1.f + s1.y)); hv.w = pack2(o1.z * n1.z * (1.f + s1.z), o1.w * n1.w * (1.f + s1.w));
            *reinterpret_cast<u32x4*>(p.h + (size_t)row * D + col) = hv;
          }
        }
      }
      if (EPI == 1) {
#pragma unroll
        for (int m = 0; m < MI; ++m) {
          float v = ssq[m];
          v += __shfl_xor(v, 16); v += __shfl_xor(v, 32);
          if (fq == 0) p.rowss[(size_t)(brow + wr * (BM / 2) + m * 16 + fr) * 16 + nt * 2 + wc] = v;
        }
      }
    }
  }
}

template <int MODE>
__device__ void attn_unit(const P& p, int u, char* smem) {
  const int tid = threadIdx.x, wid = tid >> 6, lane = tid & 63, fr = lane & 15, fq = lane >> 4;
  char* Ks = smem;
  u16* Vt = reinterpret_cast<u16*>(smem + 16384);
  float* rpl = reinterpret_cast<float*>(smem + 16384 + 18432);
  int h, qtok0, b, r = 0;
  if (MODE == 0) { b = u >> 5; h = (u >> 2) & 7; qtok0 = b * 256 + (u & 3) * 64; }
  else { b = u >> 7; r = (u >> 3) & 15; h = u & 7; qtok0 = NP + b * 1024 + r * 64; }
  constexpr int NSS = MODE == 0 ? 2 : 6;
  const int c0 = wid * 16;
  int ksc = c0 - 8; ksc = ksc < 0 ? 0 : (ksc > 32 ? 32 : ksc);
  const int rs = (r - 4) < 0 ? 0 : ((r - 4) > 8 ? 8 : (r - 4));
  bf16x8 qf[2];
  {
    const u16* q = p.proj + (size_t)(qtok0 + wid * 16 + fr) * IN_E + 1024 + h * 64 + fq * 8;
    qf[0] = *reinterpret_cast<const bf16x8*>(q);
    qf[1] = *reinterpret_cast<const bf16x8*>(q + 32);
  }
  u32x2 gbv[4];
#pragma unroll
  for (int dt = 0; dt < 4; ++dt)
    gbv[dt] = *reinterpret_cast<const u32x2*>(p.proj + (size_t)(qtok0 + wid * 16 + fr) * IN_E + 2560 + h * 64 + dt * 16 + fq * 4);
  const int cq = c0 + fr;
  int cstart = cq - 8; cstart = cstart < 0 ? 0 : (cstart > 48 ? 48 : cstart);
  float mrun = -1e30f, lrun = 0.f;
  f32x4 o[4] = {};
  const float scale = 0.125f;
  const int krow = tid >> 3, kchunk = tid & 7;
  const int vkey = tid & 127, vdh = tid >> 7;
  u32x4 kr[4], vr[4];
  auto prefetch = [&](int ss) {
    const u16* kb; const u16* vb; int ld;
    if (MODE == 0) { kb = p.proj + (size_t)(b * 256 + ss * 128) * IN_E + 1536 + h * 64; vb = kb + 512; ld = IN_E; }
    else if (ss < 4) { kb = p.proj + (size_t)(NP + b * 1024 + (rs + ss * 2) * 64) * IN_E + 1536 + h * 64; vb = kb + 512; ld = IN_E; }
    else { kb = p.kcb + ((size_t)(b * 8 + h) * 256 + (ss - 4) * 128) * 64; vb = p.vcb + ((size_t)(b * 8 + h) * 256 + (ss - 4) * 128) * 64; ld = 64; }
#pragma unroll
    for (int i = 0; i < 4; ++i) kr[i] = *reinterpret_cast<const u32x4*>(kb + (size_t)(krow + 32 * i) * ld + kchunk * 8);
#pragma unroll
    for (int i = 0; i < 4; ++i) vr[i] = *reinterpret_cast<const u32x4*>(vb + (size_t)vkey * ld + vdh * 32 + i * 8);
  };
  prefetch(0);
  if (MODE == 1) {
    __syncthreads();
    for (int i = tid; i < 15 * 31; i += NTHR) rpl[i] = p.rpb[h * 465 + i];
  }
#pragma unroll 1
  for (int ss = 0; ss < NSS; ++ss) {
    const bool local = (MODE == 1 && ss < 4);
    __syncthreads();
#pragma unroll
    for (int i = 0; i < 4; ++i) {
      const int row = krow + 32 * i;
      *reinterpret_cast<u32x4*>(Ks + row * 128 + ((kchunk ^ ((row >> 1) & 7)) << 4)) = kr[i];
    }
    {
      u16* vt = Vt + (vkey >> 6) * 4608 + (vdh * 32) * 72 + (vkey & 63);
#pragma unroll
      for (int i = 0; i < 4; ++i) {
        const unsigned w[4] = {vr[i].x, vr[i].y, vr[i].z, vr[i].w};
#pragma unroll
        for (int j = 0; j < 4; ++j) {
          vt[(i * 8 + 2 * j) * 72] = (u16)(w[j] & 0xffff);
          vt[(i * 8 + 2 * j + 1) * 72] = (u16)(w[j] >> 16);
        }
      }
    }
    if (ss + 1 < NSS) prefetch(ss + 1);
    __syncthreads();
#pragma unroll
    for (int s2 = 0; s2 < 2; ++s2) {
      const u16* Vs = Vt + s2 * 4608;
      const int nchunk = local ? 1 : 2;
      const int kbase = local ? ksc : 0;
      const float* rp = rpl + (rs + ss * 2 + s2 - r + 7) * 31 + 15 - cq;
      for (int ch = 0; ch < nchunk; ++ch) {
        f32x4 sv[2];
#pragma unroll
        for (int t2 = 0; t2 < 2; ++t2) {
          const int koff = kbase + ch * 32 + t2 * 16;
          const int row = s2 * 64 + koff + fr;
          const int sw = (row >> 1) & 7;
          const bf16x8 kf0 = *reinterpret_cast<const bf16x8*>(Ks + row * 128 + ((fq ^ sw) << 4));
          const bf16x8 kf1 = *reinterpret_cast<const bf16x8*>(Ks + row * 128 + (((4 + fq) ^ sw) << 4));
          f32x4 z = {0.f, 0.f, 0.f, 0.f};
          z = __builtin_amdgcn_mfma_f32_16x16x32_bf16(kf0, qf[0], z, 0, 0, 0);
          z = __builtin_amdgcn_mfma_f32_16x16x32_bf16(kf1, qf[1], z, 0, 0, 0);
          if (local) {
#pragma unroll
            for (int j = 0; j < 4; ++j) {
              const int ck = koff + fq * 4 + j;
              int dcl = ck - cq; dcl = dcl < -15 ? -15 : (dcl > 15 ? 15 : dcl);
              const float bias = rp[dcl + cq];
              const bool ok = (ck >= cstart) && (ck < cstart + 16);
              z[j] = ok ? z[j] * scale + bias : -1e30f;
            }
          } else {
#pragma unroll
            for (int j = 0; j < 4; ++j) z[j] *= scale;
          }
          sv[t2] = z;
        }
        float mx = fmaxf(fmaxf(fmaxf(sv[0][0], sv[0][1]), fmaxf(sv[0][2], sv[0][3])), fmaxf(fmaxf(sv[1][0], sv[1][1]), fmaxf(sv[1][2], sv[1][3])));
        mx = fmaxf(mx, __shfl_xor(mx, 16));
        mx = fmaxf(mx, __shfl_xor(mx, 32));
        const float mnew = fmaxf(mrun, mx);
        const float corr = __expf(mrun - mnew);
        mrun = mnew;
        float pv[8];
        float psum = 0.f;
#pragma unroll
        for (int j = 0; j < 4; ++j) { pv[j] = __expf(sv[0][j] - mnew); pv[4 + j] = __expf(sv[1][j] - mnew); }
#pragma unroll
        for (int j = 0; j < 8; ++j) psum += pv[j];
        lrun = lrun * corr + psum;
        u32x4 pk;
        pk.x = pack2(pv[0], pv[1]); pk.y = pack2(pv[2], pv[3]); pk.z = pack2(pv[4], pv[5]); pk.w = pack2(pv[6], pv[7]);
        const bf16x8 pfrag = __builtin_bit_cast(bf16x8, pk);
        const int k0 = kbase + ch * 32;
#pragma unroll
        for (int dt = 0; dt < 4; ++dt) {
          const u16* vp = Vs + (dt * 16 + fr) * 72 + k0 + fq * 4;
          u32x2 v0 = *reinterpret_cast<const u32x2*>(vp);
          u32x2 v1 = *reinterpret_cast<const u32x2*>(vp + 16);
          u32x4 vv; vv.x = v0.x; vv.y = v0.y; vv.z = v1.x; vv.w = v1.y;
          f32x4 oo = o[dt];
          oo[0] *= corr; oo[1] *= corr; oo[2] *= corr; oo[3] *= corr;
          o[dt] = __builtin_amdgcn_mfma_f32_16x16x32_bf16(__builtin_bit_cast(bf16x8, vv), pfrag, oo, 0, 0, 0);
        }
      }
    }
  }
  lrun += __shfl_xor(lrun, 16);
  lrun += __shfl_xor(lrun, 32);
  const float linv = 1.f / lrun;
  const int tok = qtok0 + wid * 16 + fr;
#pragma unroll
  for (int dt = 0; dt < 4; ++dt) {
    const int dd = h * 64 + dt * 16 + fq * 4;
    const u32x2 gb = gbv[dt];
    float r0 = o[dt][0] * linv * bflo(gb.x);
    float r1 = o[dt][1] * linv * bfhi(gb.x);
    float r2 = o[dt][2] * linv * bflo(gb.y);
    float r3 = o[dt][3] * linv * bfhi(gb.y);
    u32x2 ov; ov.x = pack2(r0, r1); ov.y = pack2(r2, r3);
    *reinterpret_cast<u32x2*>(p.cat + (size_t)tok * D + 512 + dd) = ov;
  }
}

template <int G>
__device__ void pool_unit(const P& p, int tile, char* smem) {
  constexpr int HALF = 1 << G;
  constexpr int NR = 64 + 2 * HALF;
  int tid = threadIdx.x;
  asm volatile("" : "+v"(tid));
  const int wid = tid >> 6, lane = tid & 63, fr = lane & 15, fq = lane >> 4;
  char* U = smem;
  char* W = smem + 80 * 272;
  const int T0 = tile * 64;
  int sb, se;
  if (T0 < NP) { sb = T0 & ~255; se = sb + 256; } else { sb = NP + ((T0 - NP) & ~1023); se = sb + 1024; }
  __syncthreads();
  {
    constexpr int NIT = (NR * 16 + NTHR - 1) / NTHR;
    u32x4 sv[NIT];
#pragma unroll
    for (int i = 0; i < NIT; ++i) {
      const int c = tid + i * NTHR, rr = c >> 4, c16 = c & 15;
      int tt = T0 - HALF + rr; tt = tt < sb ? sb : (tt >= se ? se - 1 : tt);
      sv[i] = *reinterpret_cast<const u32x4*>(p.proj + (size_t)tt * IN_E + G * 128 + c16 * 8);
    }
#pragma unroll
    for (int i = 0; i < NIT; ++i) {
      const int c = tid + i * NTHR, rr = c >> 4, c16 = c & 15;
      if (c < NR * 16) *reinterpret_cast<u32x4*>(U + rr * 272 + c16 * 16) = sv[i];
    }
  }
#pragma unroll
  for (int i = 0; i < 8; ++i) {
    const int c = tid + i * NTHR, rr = c >> 4, c16 = c & 15;
    *reinterpret_cast<u32x4*>(W + rr * 272 + c16 * 16) = *reinterpret_cast<const u32x4*>(p.wpt + (size_t)G * 16384 + rr * 128 + c16 * 8);
  }
  __syncthreads();
  const int t = T0 + wid * 16 + fr;
  int lo = t - HALF; lo = lo < sb ? sb : lo;
  int hi = t + HALF; hi = hi > se ? se : hi;
  const float inv = 1.f / (float)(hi - lo);
  f32x4 acc[8] = {};
#pragma unroll 1
  for (int ks = 0; ks < 4; ++ks) {
    const char* ub = U + (wid * 16 + fr) * 272 + (ks * 4 + fq) * 16;
    float sum[8] = {};
#pragma unroll
    for (int i = 0; i < 2 * HALF; ++i) {
      const int tt = t - HALF + i;
      const float m = (tt >= lo && tt < hi) ? 1.f : 0.f;
      const u32x4 w2 = *reinterpret_cast<const u32x4*>(ub + i * 272);
      sum[0] += m * bflo(w2.x); sum[1] += m * bfhi(w2.x); sum[2] += m * bflo(w2.y); sum[3] += m * bfhi(w2.y);
      sum[4] += m * bflo(w2.z); sum[5] += m * bfhi(w2.z); sum[6] += m * bflo(w2.w); sum[7] += m * bfhi(w2.w);
    }
    const u32x4 w = *reinterpret_cast<const u32x4*>(ub + HALF * 272);
    const float uu[8] = {bflo(w.x), bfhi(w.x), bflo(w.y), bfhi(w.y), bflo(w.z), bfhi(w.z), bflo(w.w), bfhi(w.w)};
    u32x4 pk;
    pk.x = pack2(sum[0] * inv - uu[0], sum[1] * inv - uu[1]);
    pk.y = pack2(sum[2] * inv - uu[2], sum[3] * inv - uu[3]);
    pk.z = pack2(sum[4] * inv - uu[4], sum[5] * inv - uu[5]);
    pk.w = pack2(sum[6] * inv - uu[6], sum[7] * inv - uu[7]);
    const bf16x8 af = __builtin_bit_cast(bf16x8, pk);
#pragma unroll
    for (int n = 0; n < 8; ++n) {
      const bf16x8 bfr = *reinterpret_cast<const bf16x8*>(W + (n * 16 + fr) * 272 + (ks * 4 + fq) * 16);
      acc[n] = __builtin_amdgcn_mfma_f32_16x16x32_bf16(bfr, af, acc[n], 0, 0, 0);
    }
  }
#pragma unroll
  for (int n = 0; n < 8; ++n) {
    const int dd = G * 128 + n * 16 + fq * 4;
    const float4 ps = *reinterpret_cast<const float4*>(p.pool_scale + dd);
    const u32x2 ga = *reinterpret_cast<const u32x2*>(p.proj + (size_t)t * IN_E + 512 + dd);
    u32x2 ov;
    ov.x = pack2(acc[n][0] * ps.x * bflo(ga.x), acc[n][1] * ps.y * bfhi(ga.x));
    ov.y = pack2(acc[n][2] * ps.z * bflo(ga.y), acc[n][3] * ps.w * bfhi(ga.y));
    *reinterpret_cast<u32x2*>(p.cat + (size_t)t * D + dd) = ov;
  }
}

__device__ void phase_even_mix(const P& p, char* smem) {
  if (gridDim.x == 512) {
    const int bx = blockIdx.x;
    if (bx < 256) {
      attn_unit<1>(p, bx, smem);
      const int q = bx, g = q & 3, tile = q >> 2;
      if (g == 0) pool_unit<0>(p, tile, smem); else if (g == 1) pool_unit<1>(p, tile, smem); else if (g == 2) pool_unit<2>(p, tile, smem); else pool_unit<3>(p, tile, smem);
    } else {
      attn_unit<0>(p, (bx - 256) * 2, smem);
      attn_unit<0>(p, (bx - 256) * 2 + 1, smem);
      if (bx < 384) {
        const int q = bx, g = q & 3, tile = q >> 2;
        if (g == 0) pool_unit<0>(p, tile, smem); else if (g == 1) pool_unit<1>(p, tile, smem); else if (g == 2) pool_unit<2>(p, tile, smem); else pool_unit<3>(p, tile, smem);
      }
    }
    return;
  }
  constexpr int U_N = 256, U_C = 512, U_P = 384;
  for (int u = blockIdx.x; u < U_N + U_C + U_P; u += gridDim.x) {
    if (u < U_N) attn_unit<1>(p, u, smem);
    else if (u < U_N + U_C) attn_unit<0>(p, u - U_N, smem);
    else {
      const int q = u - U_N - U_C, g = q & 3, tile = q >> 2;
      if (g == 0) pool_unit<0>(p, tile, smem); else if (g == 1) pool_unit<1>(p, tile, smem); else if (g == 2) pool_unit<2>(p, tile, smem); else pool_unit<3>(p, tile, smem);
    }
  }
}

__device__ void odd_unit(const P& p, int u, char* smem) {
  int tid = threadIdx.x;
  asm volatile("" : "+v"(tid));
  const int lane = tid & 63, wid = tid >> 6;
  u16* G = reinterpret_cast<u16*>(smem);
  float* red = reinterpret_cast<float*>(smem + 46 * 1024);
  const int t0 = u * 16;
  int sb, se;
  if (t0 < NP) { sb = t0 & ~255; se = sb + 256; } else { sb = NP + ((t0 - NP) & ~1023); se = sb + 1024; }
  const int ch = tid * 2;
  u32x4 sv[12];
#pragma unroll
  for (int i = 0; i < 12; ++i) {
    const int c = tid + i * NTHR, rr = c >> 6, c16 = c & 63;
    const int tt = t0 - 15 + rr;
    sv[i] = u32x4{0u, 0u, 0u, 0u};
    if (c < 46 * 64 && tt >= sb && tt < se) sv[i] = *reinterpret_cast<const u32x4*>(p.proj + (size_t)tt * 2048 + 1024 + c16 * 8);
  }
  unsigned cxw[18], bww[16], gdw[16];
#pragma unroll
  for (int q = 0; q < 18; ++q) {
    const int tt = t0 + q - 1;
    cxw[q] = 0u;
    if (tt >= sb && tt < se) cxw[q] = *reinterpret_cast<const unsigned*>(p.proj + (size_t)tt * 2048 + 512 + ch);
  }
#pragma unroll
  for (int i = 0; i < 16; ++i) {
    bww[i] = *reinterpret_cast<const unsigned*>(p.proj + (size_t)(t0 + i) * 2048 + ch);
    gdw[i] = *reinterpret_cast<const unsigned*>(p.proj + (size_t)(t0 + i) * 2048 + 1536 + ch);
  }
  float2 w[31];
#pragma unroll
  for (int j = 0; j < 31; ++j) w[j] = *reinterpret_cast<const float2*>(p.conv_d + j * 512 + ch);
  const float2 bias = *reinterpret_cast<const float2*>(p.conv_d_b + ch);
  const float2 lg = *reinterpret_cast<const float2*>(p.ln_g + ch);
  const float2 lb = *reinterpret_cast<const float2*>(p.ln_b + ch);
  const float2 wc0 = *reinterpret_cast<const float2*>(p.conv_c + ch);
  const float2 wc1 = *reinterpret_cast<const float2*>(p.conv_c + 512 + ch);
  const float2 wc2 = *reinterpret_cast<const float2*>(p.conv_c + 1024 + ch);
  __syncthreads();
#pragma unroll
  for (int i = 0; i < 12; ++i) {
    const int c = tid + i * NTHR, rr = c >> 6, c16 = c & 63;
    if (c < 46 * 64) *reinterpret_cast<u32x4*>(G + rr * 512 + c16 * 8) = sv[i];
  }
#pragma unroll
  for (int i = 0; i < 16; ++i) {
    const int tok = t0 + i;
    const float c0 = bflo(bww[i]) * (wc0.x * bflo(cxw[i]) + wc1.x * bflo(cxw[i + 1]) + wc2.x * bflo(cxw[i + 2]));
    const float c1 = bfhi(bww[i]) * (wc0.y * bfhi(cxw[i]) + wc1.y * bfhi(cxw[i + 1]) + wc2.y * bfhi(cxw[i + 2]));
    *reinterpret_cast<unsigned*>(p.cat + (size_t)tok * D + ch) = pack2(c0, c1);
  }
  __syncthreads();
#pragma unroll
  for (int hf = 0; hf < 2; ++hf) {
    float2 z[8];
#pragma unroll
    for (int i = 0; i < 8; ++i) z[i] = bias;
    const u16* Gh = G + hf * 8 * 512 + ch;
#pragma unroll
    for (int r = 0; r < 38; ++r) {
      const unsigned gv = *reinterpret_cast<const unsigned*>(Gh + r * 512);
      const float g0 = bflo(gv), g1 = bfhi(gv);
#pragma unroll
      for (int i = 0; i < 8; ++i) {
        const int j = r - i;
        if (j >= 0 && j <= 30) { z[i].x += w[j].x * g0; z[i].y += w[j].y * g1; }
      }
    }
    float* rd = red + hf * 64;
#pragma unroll
    for (int i = 0; i < 8; ++i) {
      const float sv2 = wave_sum(z[i].x + z[i].y);
      if (lane == 0) rd[wid * 8 + i] = sv2;
    }
    __syncthreads();
    float mu[8];
#pragma unroll
    for (int i = 0; i < 8; ++i) mu[i] = (rd[i] + rd[8 + i] + rd[16 + i] + rd[24 + i]) * (1.f / 512.f);
#pragma unroll
    for (int i = 0; i < 8; ++i) {
      const float d0 = z[i].x - mu[i], d1 = z[i].y - mu[i];
      const float sv2 = wave_sum(d0 * d0 + d1 * d1);
      if (lane == 0) rd[32 + wid * 8 + i] = sv2;
    }
    __syncthreads();
#pragma unroll
    for (int i = 0; i < 8; ++i) {
      const float rstd = rsqrtf((rd[32 + i] + rd[40 + i] + rd[48 + i] + rd[56 + i]) * (1.f / 512.f) + 1e-6f);
      const int tok = t0 + hf * 8 + i;
      const unsigned gd = gdw[hf * 8 + i];
      const float l0 = (z[i].x - mu[i]) * rstd * lg.x + lb.x;
      const float l1 = (z[i].y - mu[i]) * rstd * lg.y + lb.y;
      *reinterpret_cast<unsigned*>(p.cat + (size_t)tok * D + 512 + ch) = pack2(silu_f(l0) * bflo(gd), silu_f(l1) * bfhi(gd));
    }
  }
}

__device__ void phase_odd_mix(const P& p, char* smem) {
  for (int u = blockIdx.x; u < NTOK / 16; u += gridDim.x) odd_unit(p, u, smem);
}

__device__ void phase_final(const P& p) {
  const int lane = threadIdx.x & 63, wid = threadIdx.x >> 6;
  for (int tok = blockIdx.x * 4 + wid; tok < NTOK; tok += gridDim.x * 4) {
    const float* x = p.x1 + (size_t)tok * D;
    float4 v[4];
    float ss = 0.f;
#pragma unroll
    for (int i = 0; i < 4; ++i) {
      v[i] = *reinterpret_cast<const float4*>(x + i * 256 + lane * 4);
      ss += v[i].x * v[i].x + v[i].y * v[i].y + v[i].z * v[i].z + v[i].w * v[i].w;
    }
    ss = wave_sum(ss);
    const float rinv = rsqrtf(ss * (1.f / 1024.f) + 1e-6f);
#pragma unroll
    for (int i = 0; i < 4; ++i) {
      const int k = i * 256 + lane * 4;
      float4 gg = *reinterpret_cast<const float4*>(p.final_g + k);
      float4 o = make_float4(v[i].x * rinv * gg.x, v[i].y * rinv * gg.y, v[i].z * rinv * gg.z, v[i].w * rinv * gg.w);
      *reinterpret_cast<float4*>(p.out + (size_t)tok * D + k) = o;
    }
  }
}

#define XB_TMO      128
#define XB_XCNT(j)  (256  + 64 * (j))
#define XB_XSUB(j)  (1280 + 64 * (j))
#define XB_XGEN(j)  (2304 + 64 * (j))
#define XB_TOP      3328
#define XB_TOPGEN   3392
#define XCD_BAR_WORDS 3456
#define XB_SPIN_CAP (1u << 18)
#define LAS __attribute__((address_space(3)))

__device__ __forceinline__ unsigned xb_ld(unsigned* p)              { return __hip_atomic_load(p, __ATOMIC_RELAXED, __HIP_MEMORY_SCOPE_AGENT); }
__device__ __forceinline__ unsigned xb_add(unsigned* p, unsigned v) { return __hip_atomic_fetch_add(p, v, __ATOMIC_RELAXED, __HIP_MEMORY_SCOPE_AGENT); }
__device__ __forceinline__ unsigned xb_xcc_id() { return (unsigned)__builtin_amdgcn_s_getreg((3 << 11) | 20) & 0xFu; }
#define XB_SPIN(cond, bar) do { unsigned _sp = 0; while (cond) { __builtin_amdgcn_s_sleep(1); \
    if ((++_sp & 255u) == 0u) { if (xb_ld(&(bar)[XB_TMO])) break; if (_sp > XB_SPIN_CAP) { atomicAdd(&(bar)[XB_TMO], 1u); break; } } } } while (0)

struct XcdBarrier {
    unsigned* bar; unsigned x;
    unsigned nloc, nx;
    volatile unsigned* st;
};

__device__ __forceinline__ XcdBarrier xcd_barrier_post(unsigned* bar, volatile unsigned* st) {
    XcdBarrier b; b.bar = bar; b.x = xb_xcc_id(); b.st = st; b.nloc = 0u; b.nx = 0u;
    if (threadIdx.x == 0) (void)xb_add(&bar[XB_XCNT(b.x)], 1u);
    return b;
}
__device__ __forceinline__ void xcd_barrier_complete(unsigned* bar, unsigned x, unsigned& nloc, unsigned& nx) {
    const unsigned G = gridDim.x * gridDim.y * gridDim.z;
    unsigned sum, cnt, mine, sp = 0u;
    for (;;) {
        sum = 0u; cnt = 0u; mine = 0u;
#pragma unroll
        for (unsigned j = 0; j < 16; ++j) { const unsigned c = xb_ld(&bar[XB_XCNT(j)]); sum += c; cnt += (c > 0u) ? 1u : 0u; mine = (j == x) ? c : mine; }
        if (sum == G) break;
        __builtin_amdgcn_s_sleep(1);
        if ((++sp & 255u) == 0u) { if (xb_ld(&bar[XB_TMO])) break; if (sp > XB_SPIN_CAP) { atomicAdd(&bar[XB_TMO], 1u); break; } }
    }
    nloc = mine > 0u ? mine : 1u; nx = cnt > 0u ? cnt : 1u;
}

__device__ __forceinline__ void xcd_barrier(XcdBarrier& b) {
    asm volatile("s_waitcnt vmcnt(0)" ::: "memory");
    __syncthreads();
    if (threadIdx.x == 0) {
        unsigned* bar = b.bar;
        __builtin_amdgcn_s_waitcnt(0);
        unsigned nloc = b.nloc, nx = b.nx;
        if (nloc == 0u) { xcd_barrier_complete(bar, b.x, nloc, nx); b.nloc = nloc; b.nx = nx; }
        const unsigned old = xb_add(&bar[XB_XSUB(b.x)], 1u);
        const unsigned gen = old / nloc;
        if (old + 1u == (gen + 1u) * nloc) {
            __builtin_amdgcn_fence(__ATOMIC_RELEASE, "agent");
            asm volatile("s_waitcnt vmcnt(0)" ::: "memory");
            const unsigned og = xb_add(&bar[XB_TOP], 1u);
            const unsigned tg = og / nx;
            if (og + 1u == (tg + 1u) * nx) xb_add(&bar[XB_TOPGEN], 1u);
            else XB_SPIN(xb_ld(&bar[XB_TOPGEN]) == tg, bar);
            __builtin_amdgcn_fence(__ATOMIC_ACQUIRE, "agent");
            xb_add(&bar[XB_XGEN(b.x)], 1u);
            asm volatile("s_waitcnt vmcnt(0)" ::: "memory");
        } else {
            XB_SPIN(xb_ld(&bar[XB_XGEN(b.x)]) == gen, bar);
            __builtin_amdgcn_fence(__ATOMIC_ACQUIRE, "agent");
            asm volatile("s_waitcnt vmcnt(0)" ::: "memory");
        }
    }
    __syncthreads();
}


template <int PH>
__device__ __forceinline__ void run_phase(const P& p, char* smem) {
  if (PH == 0) phase0(p, smem);
  if (PH == 1) phase_norm(p, 0, p.x_prompt, p.x_sample);
  if (PH == 2) gemm_phase<0, 128>(p, p.h, p.wt_in_even, IN_E, smem);
  if (PH == 3) phase_even_mix(p, smem);
  if (PH == 4) gemm_phase<1, 96>(p, p.cat, p.wt_out_even, D, smem);
  if (PH == 6) gemm_phase<2, 128>(p, p.h, p.wt_in_odd, IN_O, smem);
  if (PH == 7) phase_odd_mix(p, smem);
  if (PH == 8) gemm_phase<3, 96>(p, p.cat, p.wt_out_odd, D, smem);
  if (PH == 9) phase_final(p);
}

__global__ void __launch_bounds__(NTHR, 2) mega_kernel(P p) {
  __shared__ __attribute__((aligned(16))) char smem[SMEM_BYTES];
  cg::grid_group grid = cg::this_grid();
  XcdBarrier xb = xcd_barrier_post(p.bar, (volatile unsigned*)(p.bar + XCD_BAR_WORDS + 64 * blockIdx.x));
  if (p.use_cg) grid.sync();
#define RUNP(PH) do { run_phase<PH>(p, smem); if ((PROBE_REPEAT >> PH) & 1) { xcd_barrier(xb); run_phase<PH>(p, smem); } } while (0)
#define GSYNC() do { xcd_barrier(xb); if (PROBE_SYNC2) xcd_barrier(xb); } while (0)
  RUNP(0); GSYNC();
  RUNP(1); GSYNC();
  RUNP(2); GSYNC();
  RUNP(3); GSYNC();
  RUNP(4); GSYNC();
  RUNP(6); GSYNC();
  RUNP(7); GSYNC();
  run_phase<8>(p, smem); GSYNC();
  RUNP(9);
}

template <int PH>
__global__ void __launch_bounds__(NTHR, 2) phase_kernel(P p) {
  __shared__ __attribute__((aligned(16))) char smem[SMEM_BYTES];
  run_phase<PH>(p, smem);
}

constexpr int BAR_TOTAL_WORDS = XCD_BAR_WORDS + 64 * 2048;
static inline size_t align_up(size_t x) { return (x + 255) & ~(size_t)255; }

extern "C" void kernel_launch(void* const* d_in, const int* in_sizes, int n_in, void* d_out, int out_size, void* d_ws,
                              size_t ws_size, hipStream_t stream) {
  P p{};
  const float** f = reinterpret_cast<const float**>(&p);
  for (int i = 0; i < 22; ++i) f[i] = (const float*)d_in[i];
  p.out = (float*)d_out;
  char* w = (char*)d_ws;
  size_t off = 0;
  p.mod = (float*)(w + off); off = align_up(off + (size_t)2 * 3 * 3072 * 4);
  p.wt_in_even = (u16*)(w + off); off = align_up(off + (size_t)IN_E * D * 2);
  p.wt_out_even = (u16*)(w + off); off = align_up(off + (size_t)D * D * 2);
  p.wt_in_odd = (u16*)(w + off); off = align_up(off + (size_t)IN_O * D * 2);
  p.wt_out_odd = (u16*)(w + off); off = align_up(off + (size_t)D * D * 2);
  p.wpt = (u16*)(w + off); off = align_up(off + (size_t)4 * 128 * 128 * 2);
  p.h = (u16*)(w + off); off = align_up(off + (size_t)NTOK * D * 2);
  p.proj = (u16*)(w + off); off = align_up(off + (size_t)NTOK * IN_O * 2);
  p.cat = (u16*)(w + off); off = align_up(off + (size_t)NTOK * D * 2);
  p.x1 = (float*)(w + off); off = align_up(off + (size_t)NTOK * D * 4);
  p.kcb = (u16*)(w + off); off = align_up(off + (size_t)262144 * 2);
  p.vcb = (u16*)(w + off); off = align_up(off + (size_t)262144 * 2);
  p.rowss = (float*)(w + off); off = align_up(off + (size_t)NTOK * 16 * 4);
  p.bias1 = (float*)(w + off); off = align_up(off + (size_t)3 * IN_O * 4);
  p.bar = (unsigned*)(w + off); off = align_up(off + (size_t)BAR_TOTAL_WORDS * 4);
  p.use_cg = 0ull;

#if MULTI_LAUNCH
  const int G = 1024;
  phase_kernel<0><<<G, NTHR, 0, stream>>>(p);
  phase_kernel<1><<<G, NTHR, 0, stream>>>(p);
  phase_kernel<2><<<G, NTHR, 0, stream>>>(p);
  phase_kernel<3><<<G, NTHR, 0, stream>>>(p);
  phase_kernel<4><<<G, NTHR, 0, stream>>>(p);
  phase_kernel<6><<<G, NTHR, 0, stream>>>(p);
  phase_kernel<7><<<G, NTHR, 0, stream>>>(p);
  phase_kernel<8><<<G, NTHR, 0, stream>>>(p);
  phase_kernel<9><<<G, NTHR, 0, stream>>>(p);
#else
  static int grid_blocks = 0;
  if (!grid_blocks) {
    int dev = 0, cus = 0, per_cu = 0;
    hipGetDevice(&dev);
    hipDeviceGetAttribute(&cus, hipDeviceAttributeMultiprocessorCount, dev);
    hipOccupancyMaxActiveBlocksPerMultiprocessor(&per_cu, mega_kernel, NTHR, 0);
    if (per_cu < 1) per_cu = 1;
    grid_blocks = cus * per_cu;
  }
  (void)hipMemsetAsync(p.bar, 0, (size_t)BAR_TOTAL_WORDS * 4, stream);
  void* args[] = {&p};
  hipError_t e = hipLaunchCooperativeKernel((void*)mega_kernel, dim3(grid_blocks), dim3(NTHR), args, 0, stream);
  if (e != hipSuccess) fprintf(stderr, "cooperative launch failed: %s (grid %d)\n", hipGetErrorString(e), grid_blocks);
#endif
}
```

```cpp
#include <hip/hip_runtime.h>
#include <hip/hip_cooperative_groups.h>
#include <cstdio>
namespace cg = cooperative_groups;

#define PROBE_REPEAT 0x00
#define PROBE_SYNC2 0
#ifndef MULTI_LAUNCH
#define MULTI_LAUNCH 0
#endif

typedef unsigned short u16;
using bf16x8 = __attribute__((ext_vector_type(8))) short;
using f32x4 = __attribute__((ext_vector_type(4))) float;
using u32x4 = __attribute__((ext_vector_type(4))) unsigned;
using u32x2 = __attribute__((ext_vector_type(2))) unsigned;

constexpr int D = 1024;
constexpr int NP = 4096;
constexpr int NS = 2048;
constexpr int NTOK = NP + NS;
constexpr int IN_E = 3072;
constexpr int IN_O = 3584;
constexpr int NTHR = 256;
constexpr int SMEM_BYTES = 64 * 1024;

struct P {
  const float *x_prompt, *x_sample, *cache_k, *cache_v, *c, *c_ctx, *norm_g, *w_mod, *b_mod, *w_in_even, *w_pool,
      *pool_scale, *rpb, *w_out_even, *w_in_odd, *conv_c, *conv_d, *conv_d_b, *ln_g, *ln_b, *w_out_odd, *final_g;
  float* out;
  float* mod;
  u16 *wt_in_even, *wt_out_even, *wt_in_odd, *wt_out_odd, *wpt;
  u16 *h, *proj, *cat;
  u16 *kcb, *vcb;
  float *rowss;
  float *bias1;
  float* x1;
  unsigned* bar;
  unsigned long long use_cg;
};

typedef __bf16 hbf2 __attribute__((ext_vector_type(2)));
typedef float hf2 __attribute__((ext_vector_type(2)));
__device__ __forceinline__ unsigned pack2(float a, float b) {
  const hf2 v = {a, b};
  return __builtin_bit_cast(unsigned, __builtin_convertvector(v, hbf2));
}
__device__ __forceinline__ u16 f2bf(float f) { return (u16)(pack2(f, 0.f) & 0xffffu); }
__device__ __forceinline__ float bf2f(u16 h) { return __uint_as_float(((unsigned)h) << 16); }
__device__ __forceinline__ float bflo(unsigned u) { return __uint_as_float(u << 16); }
__device__ __forceinline__ float bfhi(unsigned u) { return __uint_as_float(u & 0xffff0000u); }
__device__ __forceinline__ float silu_f(float x) { return x * __builtin_amdgcn_rcpf(1.f + __expf(-x)); }
__device__ __forceinline__ float sigmoid_f(float x) { return __builtin_amdgcn_rcpf(1.f + __expf(-x)); }
__device__ __forceinline__ float wave_sum(float v) {
#pragma unroll
  for (int o = 32; o >= 1; o >>= 1) v += __shfl_xor(v, o);
  return v;
}
__device__ __forceinline__ int cond_of_token(int tok) { return tok < NP ? 0 : 1 + ((tok - NP) >> 10); }

__device__ void mod_unit(const P& p, int u, float* sm) {
  const int layer = u / 96, cg32 = u % 96;
  const int tid = threadIdx.x;
  float* sc = sm;
  float* red = sm + 3 * 1024;
  __syncthreads();
#pragma unroll
  for (int q = 0; q < 12; ++q) {
    const int i = tid + q * NTHR;
    const int cv = i >> 10, k = i & 1023;
    const float v = (cv == 0) ? p.c_ctx[k] : p.c[(cv - 1) * 1024 + k];
    sc[i] = silu_f(v);
  }
  __syncthreads();
  const int cq = tid & 7, ks = tid >> 3;
  const float* W = p.w_mod + (size_t)layer * 1024 * 3072 + cg32 * 32 + cq * 4;
  float a[3][4] = {};
#pragma unroll 8
  for (int i = 0; i < 32; ++i) {
    int k = ks * 32 + i;
    using nf4 = __attribute__((ext_vector_type(4))) float;
    const nf4 wq = __builtin_nontemporal_load(reinterpret_cast<const nf4*>(W + (size_t)k * 3072));
    float4 w = make_float4(wq.x, wq.y, wq.z, wq.w);
#pragma unroll
    for (int cv = 0; cv < 3; ++cv) {
      float s = sc[cv * 1024 + k];
      a[cv][0] += s * w.x; a[cv][1] += s * w.y; a[cv][2] += s * w.z; a[cv][3] += s * w.w;
    }
  }
#pragma unroll
  for (int cv = 0; cv < 3; ++cv)
#pragma unroll
    for (int j = 0; j < 4; ++j) {
      float v = a[cv][j];
      v += __shfl_xor(v, 8); v += __shfl_xor(v, 16); v += __shfl_xor(v, 32);
      a[cv][j] = v;
    }
  const int lane = tid & 63, wid = tid >> 6;
  if (lane < 8) {
#pragma unroll
    for (int cv = 0; cv < 3; ++cv)
#pragma unroll
      for (int j = 0; j < 4; ++j) red[wid * 96 + cv * 32 + lane * 4 + j] = a[cv][j];
  }
  __syncthreads();
  if (tid < 96) {
    int cv = tid >> 5, col = tid & 31;
    float v = red[tid] + red[96 + tid] + red[192 + tid] + red[288 + tid];
    int n = cg32 * 32 + col;
    v += p.b_mod[layer * 3072 + n];
    p.mod[(layer * 3 + cv) * 3072 + n] = v;
  }
}

__device__ __forceinline__ int perm_row_general(int s) {
  const int tile = s >> 7, c = s & 127, wc = c >> 6, q = c & 63;
  const int n = ((q >> 5) << 1) | ((q >> 2) & 1), i = (((q >> 3) & 3) << 2) | (q & 3);
  return tile * 128 + wc * 64 + n * 16 + i;
}
__device__ __forceinline__ int perm_row_odd(int s) {
  if (s >= 3072) return perm_row_general(s);
  const int region = s >> 9, ch = s & 511;
  const int type = (region == 0 || region == 3) ? 0 : (region <= 2 ? 1 : 2);
  const int member = (region == 0 || region == 1 || region == 4) ? 0 : 1;
  const int chunk = ch >> 6, wc = (ch >> 5) & 1, cw = ch & 31;
  const int n = member * 2 + ((cw >> 2) & 1), i = ((cw >> 3) << 2) | (cw & 3);
  return (type * 8 + chunk) * 128 + wc * 64 + n * 16 + i;
}
template <int MODE>
__device__ void transpose_tile(const float* __restrict__ src, u16* __restrict__ dst, int K, int N, int t, float* sm) {
  const int tid = threadIdx.x;
  const int ntn = N >> 6;
  const int k0 = (t / ntn) * 64, n0 = (t % ntn) * 64;
  __syncthreads();
  {
    const int r = tid >> 4, c4 = tid & 15;
#pragma unroll
    for (int i = 0; i < 4; ++i) {
      int k = r + 16 * i;
      using nf4 = __attribute__((ext_vector_type(4))) float;
      const nf4 vq = __builtin_nontemporal_load(reinterpret_cast<const nf4*>(src + (size_t)(k0 + k) * N + n0 + c4 * 4));
      float4 v = make_float4(vq.x, vq.y, vq.z, vq.w);
      float* d = sm + k * 65 + c4 * 4;
      d[0] = v.x; d[1] = v.y; d[2] = v.z; d[3] = v.w;
    }
  }
  __syncthreads();
  {
    const int kc = tid & 7, nl = tid >> 3;
#pragma unroll
    for (int i = 0; i < 2; ++i) {
      int n = nl + 32 * i;
      float v[8];
#pragma unroll
      for (int j = 0; j < 8; ++j) v[j] = sm[(kc * 8 + j) * 65 + n];
      u32x4 o;
      o.x = pack2(v[0], v[1]); o.y = pack2(v[2], v[3]); o.z = pack2(v[4], v[5]); o.w = pack2(v[6], v[7]);
      const int drow = MODE == 0 ? (n0 + n) : (MODE == 1 ? perm_row_general(n0 + n) : perm_row_odd(n0 + n));
      *reinterpret_cast<u32x4*>(dst + (size_t)drow * K + k0 + kc * 8) = o;
    }
  }
}

__device__ void phase0(const P& p, char* smem) {
  float* sm = reinterpret_cast<float*>(smem);
  constexpr int T0 = 192, T1 = T0 + 768, T2 = T1 + 256, T3 = T2 + 896, T4 = T3 + 256, T5 = T4 + 16;
  for (int u = blockIdx.x; u < T5; u += gridDim.x) {
    if (u < T0) mod_unit(p, u, sm);
    else if (u < T1) transpose_tile<1>(p.w_in_even, p.wt_in_even, 1024, 3072, u - T0, sm);
    else if (u < T2) transpose_tile<1>(p.w_out_even, p.wt_out_even, 1024, 1024, u - T1, sm);
    else if (u < T3) transpose_tile<2>(p.w_in_odd, p.wt_in_odd, 1024, 3584, u - T2, sm);
    else if (u < T4) transpose_tile<1>(p.w_out_odd, p.wt_out_odd, 1024, 1024, u - T3, sm);
    else { int t = u - T4; int g = t >> 2; transpose_tile<0>(p.w_pool + g * 16384, p.wpt + g * 16384, 128, 128, t & 3, sm); }
  }
}

__device__ void phase_norm(const P& p, int layer, const float* xa, const float* xb) {
  const int lane = threadIdx.x & 63, wid = threadIdx.x >> 6;
  if (layer == 0) {
    for (int prow = blockIdx.x * 4 + wid; prow < IN_O; prow += gridDim.x * 4) {
      const u16* wrow = p.wt_in_odd + (size_t)prow * D + lane * 16;
      const u32x4 w0 = *reinterpret_cast<const u32x4*>(wrow), w1 = *reinterpret_cast<const u32x4*>(wrow + 8);
      const float wf[16] = {bflo(w0.x), bfhi(w0.x), bflo(w0.y), bfhi(w0.y), bflo(w0.z), bfhi(w0.z), bflo(w0.w), bfhi(w0.w),
                            bflo(w1.x), bfhi(w1.x), bflo(w1.y), bfhi(w1.y), bflo(w1.z), bfhi(w1.z), bflo(w1.w), bfhi(w1.w)};
#pragma unroll
      for (int cv = 0; cv < 3; ++cv) {
        const float* sh = p.mod + (size_t)(3 + cv) * 3072 + lane * 16;
        float a = 0.f;
#pragma unroll
        for (int q = 0; q < 4; ++q) {
          const float4 s4 = *reinterpret_cast<const float4*>(sh + q * 4);
          a += s4.x * wf[q * 4] + s4.y * wf[q * 4 + 1] + s4.z * wf[q * 4 + 2] + s4.w * wf[q * 4 + 3];
        }
        a = wave_sum(a);
        if (lane == 0) p.bias1[cv * IN_O + prow] = a;
      }
    }
    for (int i = blockIdx.x * NTHR + threadIdx.x; i < 2 * 32768; i += gridDim.x * NTHR) {
      const float* src = (i < 32768 ? p.cache_k : p.cache_v) + (size_t)(i & 32767) * 8;
      u16* dst = (i < 32768 ? p.kcb : p.vcb) + (size_t)(i & 32767) * 8;
      const float4 a = *reinterpret_cast<const float4*>(src), c = *reinterpret_cast<const float4*>(src + 4);
      u32x4 o; o.x = pack2(a.x, a.y); o.y = pack2(a.z, a.w); o.z = pack2(c.x, c.y); o.w = pack2(c.z, c.w);
      *reinterpret_cast<u32x4*>(dst) = o;
    }
  }
  const float* g = p.norm_g + layer * 1024;
  const bool xpart = (gridDim.x & 7) == 0;
  const int nrow = xpart ? 768 : NTOK, rstep = xpart ? (int)(gridDim.x >> 3) * 4 : (int)gridDim.x * 4;
  for (int rr = (xpart ? (int)(blockIdx.x >> 3) : (int)blockIdx.x) * 4 + wid; rr < nrow; rr += rstep) {
    const int tok = xpart ? (int)(blockIdx.x & 7) * 768 + rr : rr;
    const float* x = tok < NP ? xa + (size_t)tok * D : xb + (size_t)(tok - NP) * D;
    const float* m = p.mod + (size_t)(layer * 3 + cond_of_token(tok)) * 3072;
    float4 v[4], ggv[4], shv[4], scv[4];
    float ss = 0.f;
#pragma unroll
    for (int i = 0; i < 4; ++i) {
      const int k = i * 256 + lane * 4;
      v[i] = *reinterpret_cast<const float4*>(x + k);
      ggv[i] = *reinterpret_cast<const float4*>(g + k);
      shv[i] = *reinterpret_cast<const float4*>(m + k);
      scv[i] = *reinterpret_cast<const float4*>(m + 1024 + k);
    }
#pragma unroll
    for (int i = 0; i < 4; ++i) ss += v[i].x * v[i].x + v[i].y * v[i].y + v[i].z * v[i].z + v[i].w * v[i].w;
    ss = wave_sum(ss);
    const float rinv = rsqrtf(ss * (1.f / 1024.f) + 1e-6f);
#pragma unroll
    for (int i = 0; i < 4; ++i) {
      const int k = i * 256 + lane * 4;
      const float4 gg = ggv[i], sh = shv[i], sc = scv[i];
      float h0 = v[i].x * rinv * gg.x * (1.f + sc.x) + sh.x;
      float h1 = v[i].y * rinv * gg.y * (1.f + sc.y) + sh.y;
      float h2 = v[i].z * rinv * gg.z * (1.f + sc.z) + sh.z;
      float h3 = v[i].w * rinv * gg.w * (1.f + sc.w) + sh.w;
      u32x2 o; o.x = pack2(h0, h1); o.y = pack2(h2, h3);
      *reinterpret_cast<u32x2*>(p.h + (size_t)tok * D + k) = o;
    }
  }
}

template <int EPI, int BM>
__device__ void gemm_phase(const P& p, const u16* __restrict__ A, const u16* __restrict__ Bt, int N, char* smem) {
  constexpr int K = 1024, BK = 64;
  const int tid = threadIdx.x, wid = tid >> 6, lane = tid & 63, wr = wid >> 1, wc = wid & 1, fr = lane & 15, fq = lane >> 4;
  const int NT = N >> 7;
  constexpr int MI = BM / 32;
  constexpr int NAL = BM / 32;
  const int ntiles = (NTOK / BM) * NT;
  const int srow = tid >> 3;
  const int schunk = (tid & 7) ^ ((tid >> 4) & 7);
  const bool xpart = (gridDim.x & 7) == 0;
  constexpr int MPX = 768 / BM;
  const int xcd = blockIdx.x & 7;
  const int jfirst = xpart ? (int)(blockIdx.x >> 3) : (int)blockIdx.x;
  const int jstep = xpart ? (int)(gridDim.x >> 3) : (int)gridDim.x;
  const int jend = xpart ? MPX * NT : ntiles;
  const u16* ga = nullptr; const u16* gb = nullptr;
  if (jfirst < jend) {
    const int mt0 = xpart ? xcd * MPX + jfirst % MPX : jfirst / NT, nt0 = xpart ? jfirst / MPX : jfirst % NT;
    ga = A + (size_t)(mt0 * BM + srow) * K + schunk * 8;
    gb = Bt + (size_t)(nt0 * 128 + srow) * K + schunk * 8;
    __syncthreads();
#pragma unroll
    for (int i = 0; i < NAL; ++i)
      __builtin_amdgcn_global_load_lds((const unsigned*)(ga + (size_t)(32 * i) * K), (unsigned*)(smem + i * 4096 + tid * 16), 16, 0, 0);
#pragma unroll
    for (int i = 0; i < 4; ++i)
      __builtin_amdgcn_global_load_lds((const unsigned*)(gb + (size_t)(32 * i) * K), (unsigned*)(smem + 16384 + i * 4096 + tid * 16), 16, 0, 0);
  }
  for (int tile = jfirst; tile < jend; tile += jstep) {
    const int mt = xpart ? xcd * MPX + tile % MPX : tile / NT, nt = xpart ? tile / MPX : tile % NT;
    const int brow = mt * BM, bcol = nt * 128;
    f32x4 acc[MI][4] = {};
    for (int t = 0; t < K / BK; ++t) {
      char* SA = smem + (t & 1) * 32768;
      char* SB = SA + 16384;
      asm volatile("s_waitcnt vmcnt(0)" ::: "memory");
      __syncthreads();
      if (t + 1 < K / BK) {
        char* NA = smem + ((t + 1) & 1) * 32768;
#pragma unroll
        for (int i = 0; i < NAL; ++i)
          __builtin_amdgcn_global_load_lds((const unsigned*)(ga + (size_t)(32 * i) * K + (t + 1) * BK), (unsigned*)(NA + i * 4096 + tid * 16), 16, 0, 0);
#pragma unroll
        for (int i = 0; i < 4; ++i)
          __builtin_amdgcn_global_load_lds((const unsigned*)(gb + (size_t)(32 * i) * K + (t + 1) * BK), (unsigned*)(NA + 16384 + i * 4096 + tid * 16), 16, 0, 0);
      } else {
        const int tn = tile + jstep;
        if (tn < jend) {
          const int mtn = xpart ? xcd * MPX + tn % MPX : tn / NT, ntn = xpart ? tn / MPX : tn % NT;
          ga = A + (size_t)(mtn * BM + srow) * K + schunk * 8;
          gb = Bt + (size_t)(ntn * 128 + srow) * K + schunk * 8;
#pragma unroll
          for (int i = 0; i < NAL; ++i)
            __builtin_amdgcn_global_load_lds((const unsigned*)(ga + (size_t)(32 * i) * K), (unsigned*)(smem + i * 4096 + tid * 16), 16, 0, 0);
#pragma unroll
          for (int i = 0; i < 4; ++i)
            __builtin_amdgcn_global_load_lds((const unsigned*)(gb + (size_t)(32 * i) * K), (unsigned*)(smem + 16384 + i * 4096 + tid * 16), 16, 0, 0);
        }
      }
      {
        bf16x8 af[2][MI], bfr[2][4];
#pragma unroll
        for (int kk = 0; kk < 2; ++kk) {
#pragma unroll
          for (int n = 0; n < 4; ++n) {
            const int r = wc * 64 + n * 16 + fr;
            bfr[kk][n] = *reinterpret_cast<const bf16x8*>(SB + r * 128 + (((kk * 4 + fq) ^ ((r >> 1) & 7)) << 4));
          }
#pragma unroll
          for (int m = 0; m < MI; ++m) {
            const int r = wr * (BM / 2) + m * 16 + fr;
            af[kk][m] = *reinterpret_cast<const bf16x8*>(SA + r * 128 + (((kk * 4 + fq) ^ ((r >> 1) & 7)) << 4));
          }
        }
#pragma unroll
        for (int kk = 0; kk < 2; ++kk)
#pragma unroll
          for (int m = 0; m < MI; ++m)
#pragma unroll
            for (int n = 0; n < 4; ++n) acc[m][n] = __builtin_amdgcn_mfma_f32_16x16x32_bf16(bfr[kk][n], af[kk][m], acc[m][n], 0, 0, 0);
        __builtin_amdgcn_sched_group_barrier(0x100, MI + 4, 0);
#pragma unroll
        for (int i = 0; i < MI + 4; ++i) {
          __builtin_amdgcn_sched_group_barrier(0x008, 2, 0);
          __builtin_amdgcn_sched_group_barrier(0x100, 1, 0);
        }
        __builtin_amdgcn_sched_group_barrier(0x008, 8 * MI - 2 * (MI + 4), 0);
      }
    }
    if (EPI == 0) {
      const bool gate_tile = (nt >= 4 && nt < 8) || nt >= 20;
#pragma unroll
      for (int m = 0; m < MI; ++m) {
        const int row = brow + wr * (BM / 2) + m * 16 + fr;
#pragma unroll
        for (int np = 0; np < 2; ++np) {
          const int col = bcol + wc * 64 + np * 32 + fq * 8;
          float v[8];
#pragma unroll
          for (int j = 0; j < 4; ++j) { v[j] = acc[m][np * 2][j]; v[4 + j] = acc[m][np * 2 + 1][j]; }
          if (gate_tile) {
#pragma unroll
            for (int j = 0; j < 8; ++j) v[j] = silu_f(v[j]);
          }
          u32x4 o; o.x = pack2(v[0], v[1]); o.y = pack2(v[2], v[3]); o.z = pack2(v[4], v[5]); o.w = pack2(v[6], v[7]);
          *reinterpret_cast<u32x4*>(p.proj + (size_t)row * IN_E + col) = o;
          if (brow < NP && nt >= 12 && nt < 20) {
            const bool isv = nt >= 16;
            float* dst = p.out + (size_t)NTOK * D + (isv ? (size_t)16 * 8 * 256 * 64 : 0);
            const int cc = col - (isv ? 2048 : 1536);
            const int b = row >> 8, tt = row & 255, hh = cc >> 6, dd = cc & 63;
            float* d2 = dst + (((size_t)b * 8 + hh) * 256 + tt) * 64 + dd;
            *reinterpret_cast<float4*>(d2) = make_float4(v[0], v[1], v[2], v[3]);
            *reinterpret_cast<float4*>(d2 + 4) = make_float4(v[4], v[5], v[6], v[7]);
          }
        }
      }
    } else if (EPI == 2) {
      {
        const int cv = cond_of_token(brow);
        float rinv[MI];
#pragma unroll
        for (int m = 0; m < MI; ++m) {
          const float* rs = p.rowss + (size_t)(brow + wr * (BM / 2) + m * 16 + fr) * 16;
          const float4 a = *reinterpret_cast<const float4*>(rs), b2 = *reinterpret_cast<const float4*>(rs + 4);
          const float4 c2 = *reinterpret_cast<const float4*>(rs + 8), d2 = *reinterpret_cast<const float4*>(rs + 12);
          const float tot = (a.x + a.y + a.z + a.w) + (b2.x + b2.y + b2.z + b2.w) + (c2.x + c2.y + c2.z + c2.w) + (d2.x + d2.y + d2.z + d2.w);
          rinv[m] = rsqrtf(tot * (1.f / 1024.f) + 1e-6f);
        }
#pragma unroll
        for (int n = 0; n < 4; ++n) {
          const float4 bz = *reinterpret_cast<const float4*>(p.bias1 + (size_t)cv * IN_O + bcol + wc * 64 + n * 16 + fq * 4);
#pragma unroll
          for (int m = 0; m < MI; ++m) {
            acc[m][n][0] = acc[m][n][0] * rinv[m] + bz.x; acc[m][n][1] = acc[m][n][1] * rinv[m] + bz.y;
            acc[m][n][2] = acc[m][n][2] * rinv[m] + bz.z; acc[m][n][3] = acc[m][n][3] * rinv[m] + bz.w;
          }
        }
      }
      if (nt < 24) {
        const int type = nt >> 3, chunk = nt & 7;
#pragma unroll
        for (int m = 0; m < MI; ++m) {
          const int row = brow + wr * (BM / 2) + m * 16 + fr;
          float v[8];
#pragma unroll
          for (int nl = 0; nl < 2; ++nl)
#pragma unroll
            for (int j = 0; j < 4; ++j) {
              const float a = acc[m][nl][j], b = acc[m][2 + nl][j];
              v[nl * 4 + j] = type == 0 ? a * silu_f(b) : (type == 1 ? a * b : a * sigmoid_f(b));
            }
          u32x4 o; o.x = pack2(v[0], v[1]); o.y = pack2(v[2], v[3]); o.z = pack2(v[4], v[5]); o.w = pack2(v[6], v[7]);
          *reinterpret_cast<u32x4*>(p.proj + (size_t)row * 2048 + type * 512 + chunk * 64 + wc * 32 + fq * 8) = o;
        }
      } else {
#pragma unroll
        for (int m = 0; m < MI; ++m) {
          const int row = brow + wr * (BM / 2) + m * 16 + fr;
#pragma unroll
          for (int np = 0; np < 2; ++np) {
            float v[8];
#pragma unroll
            for (int j = 0; j < 4; ++j) { v[j] = silu_f(acc[m][np * 2][j]); v[4 + j] = silu_f(acc[m][np * 2 + 1][j]); }
            u32x4 o; o.x = pack2(v[0], v[1]); o.y = pack2(v[2], v[3]); o.z = pack2(v[4], v[5]); o.w = pack2(v[6], v[7]);
            *reinterpret_cast<u32x4*>(p.proj + (size_t)row * 2048 + 1536 + (nt - 24) * 128 + wc * 64 + np * 32 + fq * 8) = o;
          }
        }
      }
    } else {
      const int layer = (EPI == 1) ? 0 : 1;
      float ssq[MI] = {};
#pragma unroll
      for (int np = 0; np < 2; ++np) {
        const int col = bcol + wc * 64 + np * 32 + fq * 8;
        float4 n0 = {}, n1 = {};
        if (EPI == 1) { n0 = *reinterpret_cast<const float4*>(p.norm_g + 1024 + col); n1 = *reinterpret_cast<const float4*>(p.norm_g + 1024 + col + 4); }
#pragma unroll
        for (int m = 0; m < MI; ++m) {
          const int row = brow + wr * (BM / 2) + m * 16 + fr;
          const int cv = cond_of_token(row);
          const float* gate = p.mod + (size_t)(layer * 3 + cv) * 3072 + 2048 + col;
          const float4 g0 = *reinterpret_cast<const float4*>(gate);
          const float4 g1 = *reinterpret_cast<const float4*>(gate + 4);
          const float* xin = (EPI == 1) ? (row < NP ? p.x_prompt + (size_t)row * D + col : p.x_sample + (size_t)(row - NP) * D + col)
                                        : p.x1 + (size_t)row * D + col;
          const float4 x0 = *reinterpret_cast<const float4*>(xin);
          const float4 x1v = *reinterpret_cast<const float4*>(xin + 4);
          float4 o0, o1;
          o0.x = x0.x + g0.x * acc[m][np * 2][0]; o0.y = x0.y + g0.y * acc[m][np * 2][1];
          o0.z = x0.z + g0.z * acc[m][np * 2][2]; o0.w = x0.w + g0.w * acc[m][np * 2][3];
          o1.x = x1v.x + g1.x * acc[m][np * 2 + 1][0]; o1.y = x1v.y + g1.y * acc[m][np * 2 + 1][1];
          o1.z = x1v.z + g1.z * acc[m][np * 2 + 1][2]; o1.w = x1v.w + g1.w * acc[m][np * 2 + 1][3];
          float* xo = p.x1 + (size_t)row * D + col;
          *reinterpret_cast<float4*>(xo) = o0;
          *reinterpret_cast<float4*>(xo + 4) = o1;
          if (EPI == 1) {
            const float* sc = p.mod + (size_t)(3 + cv) * 3072 + 1024 + col;
            const float4 s0 = *reinterpret_cast<const float4*>(sc), s1 = *reinterpret_cast<const float4*>(sc + 4);
            ssq[m] += o0.x * o0.x + o0.y * o0.y + o0.z * o0.z + o0.w * o0.w + o1.x * o1.x + o1.y * o1.y + o1.z * o1.z + o1.w * o1.w;
            u32x4 hv;
            hv.x = pack2(o0.x * n0.x * (1.f + s0.x), o0.y * n0.y * (1.f + s0.y)); hv.y = pack2(o0.z * n0.z * (1.f + s0.z), o0.w * n0.w * (1.f + s0.w));
            hv.z = pack2(o1.x * n1.x * (1.f + s1.x), o1.y * n1.y * (1.f + s1.y)); hv.w = pack2(o1.z * n1.z * (1.f + s1.z), o1.w * n1.w * (1.f + s1.w));
            *reinterpret_cast<u32x4*>(p.h + (size_t)row * D + col) = hv;
          }
        }
      }
      if (EPI == 1) {
#pragma unroll
        for (int m = 0; m < MI; ++m) {
          float v = ssq[m];
          v += __shfl_xor(v, 16); v += __shfl_xor(v, 32);
          if (fq == 0) p.rowss[(size_t)(brow + wr * (BM / 2) + m * 16 + fr) * 16 + nt * 2 + wc] = v;
        }
      }
    }
  }
}

template <int MODE>
__device__ void attn_unit(const P& p, int u, char* smem) {
  const int tid = threadIdx.x, wid = tid >> 6, lane = tid & 63, fr = lane & 15, fq = lane >> 4;
  char* Ks = smem;
  u16* Vt = reinterpret_cast<u16*>(smem + 16384);
  float* rpl = reinterpret_cast<float*>(smem + 16384 + 18432);
  int h, qtok0, b, r = 0;
  if (MODE == 0) { b = u >> 5; h = (u >> 2) & 7; qtok0 = b * 256 + (u & 3) * 64; }
  else { b = u >> 7; r = (u >> 3) & 15; h = u & 7; qtok0 = NP + b * 1024 + r * 64; }
  constexpr int NSS = MODE == 0 ? 2 : 6;
  const int c0 = wid * 16;
  int ksc = c0 - 8; ksc = ksc < 0 ? 0 : (ksc > 32 ? 32 : ksc);
  const int rs = (r - 4) < 0 ? 0 : ((r - 4) > 8 ? 8 : (r - 4));
  bf16x8 qf[2];
  {
    const u16* q = p.proj + (size_t)(qtok0 + wid * 16 + fr) * IN_E + 1024 + h * 64 + fq * 8;
    qf[0] = *reinterpret_cast<const bf16x8*>(q);
    qf[1] = *reinterpret_cast<const bf16x8*>(q + 32);
  }
  u32x2 gbv[4];
#pragma unroll
  for (int dt = 0; dt < 4; ++dt)
    gbv[dt] = *reinterpret_cast<const u32x2*>(p.proj + (size_t)(qtok0 + wid * 16 + fr) * IN_E + 2560 + h * 64 + dt * 16 + fq * 4);
  const int cq = c0 + fr;
  int cstart = cq - 8; cstart = cstart < 0 ? 0 : (cstart > 48 ? 48 : cstart);
  float mrun = -1e30f, lrun = 0.f;
  f32x4 o[4] = {};
  const float scale = 0.125f;
  const int krow = tid >> 3, kchunk = tid & 7;
  const int vkey = tid & 127, vdh = tid >> 7;
  u32x4 kr[4], vr[4];
  auto prefetch = [&](int ss) {
    const u16* kb; const u16* vb; int ld;
    if (MODE == 0) { kb = p.proj + (size_t)(b * 256 + ss * 128) * IN_E + 1536 + h * 64; vb = kb + 512; ld = IN_E; }
    else if (ss < 4) { kb = p.proj + (size_t)(NP + b * 1024 + (rs + ss * 2) * 64) * IN_E + 1536 + h * 64; vb = kb + 512; ld = IN_E; }
    else { kb = p.kcb + ((size_t)(b * 8 + h) * 256 + (ss - 4) * 128) * 64; vb = p.vcb + ((size_t)(b * 8 + h) * 256 + (ss - 4) * 128) * 64; ld = 64; }
#pragma unroll
    for (int i = 0; i < 4; ++i) kr[i] = *reinterpret_cast<const u32x4*>(kb + (size_t)(krow + 32 * i) * ld + kchunk * 8);
#pragma unroll
    for (int i = 0; i < 4; ++i) vr[i] = *reinterpret_cast<const u32x4*>(vb + (size_t)vkey * ld + vdh * 32 + i * 8);
  };
  prefetch(0);
  if (MODE == 1) {
    __syncthreads();
    for (int i = tid; i < 15 * 31; i += NTHR) rpl[i] = p.rpb[h * 465 + i];
  }
#pragma unroll 1
  for (int ss = 0; ss < NSS; ++ss) {
    const bool local = (MODE == 1 && ss < 4);
    __syncthreads();
#pragma unroll
    for (int i = 0; i < 4; ++i) {
      const int row = krow + 32 * i;
      *reinterpret_cast<u32x4*>(Ks + row * 128 + ((kchunk ^ ((row >> 1) & 7)) << 4)) = kr[i];
    }
    {
      u16* vt = Vt + (vkey >> 6) * 4608 + (vdh * 32) * 72 + (vkey & 63);
#pragma unroll
      for (int i = 0; i < 4; ++i) {
        const unsigned w[4] = {vr[i].x, vr[i].y, vr[i].z, vr[i].w};
#pragma unroll
        for (int j = 0; j < 4; ++j) {
          vt[(i * 8 + 2 * j) * 72] = (u16)(w[j] & 0xffff);
          vt[(i * 8 + 2 * j + 1) * 72] = (u16)(w[j] >> 16);
        }
      }
    }
    if (ss + 1 < NSS) prefetch(ss + 1);
    __syncthreads();
#pragma unroll
    for (int s2 = 0; s2 < 2; ++s2) {
      const u16* Vs = Vt + s2 * 4608;
      const int nchunk = local ? 1 : 2;
      const int kbase = local ? ksc : 0;
      const float* rp = rpl + (rs + ss * 2 + s2 - r + 7) * 31 + 15 - cq;
      for (int ch = 0; ch < nchunk; ++ch) {
        f32x4 sv[2];
#pragma unroll
        for (int t2 = 0; t2 < 2; ++t2) {
          const int koff = kbase + ch * 32 + t2 * 16;
          const int row = s2 * 64 + koff + fr;
          const int sw = (row >> 1) & 7;
          const bf16x8 kf0 = *reinterpret_cast<const bf16x8*>(Ks + row * 128 + ((fq ^ sw) << 4));
          const bf16x8 kf1 = *reinterpret_cast<const bf16x8*>(Ks + row * 128 + (((4 + fq) ^ sw) << 4));
          f32x4 z = {0.f, 0.f, 0.f, 0.f};
          z = __builtin_amdgcn_mfma_f32_16x16x32_bf16(kf0, qf[0], z, 0, 0, 0);
          z = __builtin_amdgcn_mfma_f32_16x16x32_bf16(kf1, qf[1], z, 0, 0, 0);
          if (local) {
#pragma unroll
            for (int j = 0; j < 4; ++j) {
              const int ck = koff + fq * 4 + j;
              int dcl = ck - cq; dcl = dcl < -15 ? -15 : (dcl > 15 ? 15 : dcl);
              const float bias = rp[dcl + cq];
              const bool ok = (ck >= cstart) && (ck < cstart + 16);
              z[j] = ok ? z[j] * scale + bias : -1e30f;
            }
          } else {
#pragma unroll
            for (int j = 0; j < 4; ++j) z[j] *= scale;
          }
          sv[t2] = z;
        }
        float mx = fmaxf(fmaxf(fmaxf(sv[0][0], sv[0][1]), fmaxf(sv[0][2], sv[0][3])), fmaxf(fmaxf(sv[1][0], sv[1][1]), fmaxf(sv[1][2], sv[1][3])));
        mx = fmaxf(mx, __shfl_xor(mx, 16));
        mx = fmaxf(mx, __shfl_xor(mx, 32));
        const float mnew = fmaxf(mrun, mx);
        const float corr = __expf(mrun - mnew);
        mrun = mnew;
        float pv[8];
        float psum = 0.f;
#pragma unroll
        for (int j = 0; j < 4; ++j) { pv[j] = __expf(sv[0][j] - mnew); pv[4 + j] = __expf(sv[1][j] - mnew); }
#pragma unroll
        for (int j = 0; j < 8; ++j) psum += pv[j];
        lrun = lrun * corr + psum;
        u32x4 pk;
        pk.x = pack2(pv[0], pv[1]); pk.y = pack2(pv[2], pv[3]); pk.z = pack2(pv[4], pv[5]); pk.w = pack2(pv[6], pv[7]);
        const bf16x8 pfrag = __builtin_bit_cast(bf16x8, pk);
        const int k0 = kbase + ch * 32;
#pragma unroll
        for (int dt = 0; dt < 4; ++dt) {
          const u16* vp = Vs + (dt * 16 + fr) * 72 + k0 + fq * 4;
          u32x2 v0 = *reinterpret_cast<const u32x2*>(vp);
          u32x2 v1 = *reinterpret_cast<const u32x2*>(vp + 16);
          u32x4 vv; vv.x = v0.x; vv.y = v0.y; vv.z = v1.x; vv.w = v1.y;
          f32x4 oo = o[dt];
          oo[0] *= corr; oo[1] *= corr; oo[2] *= corr; oo[3] *= corr;
          o[dt] = __builtin_amdgcn_mfma_f32_16x16x32_bf16(__builtin_bit_cast(bf16x8, vv), pfrag, oo, 0, 0, 0);
        }
      }
    }
  }
  lrun += __shfl_xor(lrun, 16);
  lrun += __shfl_xor(lrun, 32);
  const float linv = 1.f / lrun;
  const int tok = qtok0 + wid * 16 + fr;
#pragma unroll
  for (int dt = 0; dt < 4; ++dt) {
    const int dd = h * 64 + dt * 16 + fq * 4;
    const u32x2 gb = gbv[dt];
    float r0 = o[dt][0] * linv * bflo(gb.x);
    float r1 = o[dt][1] * linv * bfhi(gb.x);
    float r2 = o[dt][2] * linv * bflo(gb.y);
    float r3 = o[dt][3] * linv * bfhi(gb.y);
    u32x2 ov; ov.x = pack2(r0, r1); ov.y = pack2(r2, r3);
    *reinterpret_cast<u32x2*>(p.cat + (size_t)tok * D + 512 + dd) = ov;
  }
}

template <int G>
__device__ void pool_unit(const P& p, int tile, char* smem) {
  constexpr int HALF = 1 << G;
  constexpr int NR = 64 + 2 * HALF;
  int tid = threadIdx.x;
  asm volatile("" : "+v"(tid));
  const int wid = tid >> 6, lane = tid & 63, fr = lane & 15, fq = lane >> 4;
  char* U = smem;
  char* W = smem + 80 * 272;
  const int T0 = tile * 64;
  int sb, se;
  if (T0 < NP) { sb = T0 & ~255; se = sb + 256; } else { sb = NP + ((T0 - NP) & ~1023); se = sb + 1024; }
  __syncthreads();
  {
    constexpr int NIT = (NR * 16 + NTHR - 1) / NTHR;
    u32x4 sv[NIT];
#pragma unroll
    for (int i = 0; i < NIT; ++i) {
      const int c = tid + i * NTHR, rr = c >> 4, c16 = c & 15;
      int tt = T0 - HALF + rr; tt = tt < sb ? sb : (tt >= se ? se - 1 : tt);
      sv[i] = *reinterpret_cast<const u32x4*>(p.proj + (size_t)tt * IN_E + G * 128 + c16 * 8);
    }
#pragma unroll
    for (int i = 0; i < NIT; ++i) {
      const int c = tid + i * NTHR, rr = c >> 4, c16 = c & 15;
      if (c < NR * 16) *reinterpret_cast<u32x4*>(U + rr * 272 + c16 * 16) = sv[i];
    }
  }
#pragma unroll
  for (int i = 0; i < 8; ++i) {
    const int c = tid + i * NTHR, rr = c >> 4, c16 = c & 15;
    *reinterpret_cast<u32x4*>(W + rr * 272 + c16 * 16) = *reinterpret_cast<const u32x4*>(p.wpt + (size_t)G * 16384 + rr * 128 + c16 * 8);
  }
  __syncthreads();
  const int t = T0 + wid * 16 + fr;
  int lo = t - HALF; lo = lo < sb ? sb : lo;
  int hi = t + HALF; hi = hi > se ? se : hi;
  const float inv = 1.f / (float)(hi - lo);
  f32x4 acc[8] = {};
#pragma unroll 1
  for (int ks = 0; ks < 4; ++ks) {
    const char* ub = U + (wid * 16 + fr) * 272 + (ks * 4 + fq) * 16;
    float sum[8] = {};
#pragma unroll
    for (int i = 0; i < 2 * HALF; ++i) {
      const int tt = t - HALF + i;
      const float m = (tt >= lo && tt < hi) ? 1.f : 0.f;
      const u32x4 w2 = *reinterpret_cast<const u32x4*>(ub + i * 272);
      sum[0] += m * bflo(w2.x); sum[1] += m * bfhi(w2.x); sum[2] += m * bflo(w2.y); sum[3] += m * bfhi(w2.y);
      sum[4] += m * bflo(w2.z); sum[5] += m * bfhi(w2.z); sum[6] += m * bflo(w2.w); sum[7] += m * bfhi(w2.w);
    }
    const u32x4 w = *reinterpret_cast<const u32x4*>(ub + HALF * 272);
    const float uu[8] = {bflo(w.x), bfhi(w.x), bflo(w.y), bfhi(w.y), bflo(w.z), bfhi(w.z), bflo(w.w), bfhi(w.w)};
    u32x4 pk;
    pk.x = pack2(sum[0] * inv - uu[0], sum[1] * inv - uu[1]);
    pk.y = pack2(sum[2] * inv - uu[2], sum[3] * inv - uu[3]);
    pk.z = pack2(sum[4] * inv - uu[4], sum[5] * inv - uu[5]);
    pk.w = pack2(sum[6] * inv - uu[6], sum[7] * inv - uu[7]);
    const bf16x8 af = __builtin_bit_cast(bf16x8, pk);
#pragma unroll
    for (int n = 0; n < 8; ++n) {
      const bf16x8 bfr = *reinterpret_cast<const bf16x8*>(W + (n * 16 + fr) * 272 + (ks * 4 + fq) * 16);
      acc[n] = __builtin_amdgcn_mfma_f32_16x16x32_bf16(bfr, af, acc[n], 0, 0, 0);
    }
  }
#pragma unroll
  for (int n = 0; n < 8; ++n) {
    const int dd = G * 128 + n * 16 + fq * 4;
    const float4 ps = *reinterpret_cast<const float4*>(p.pool_scale + dd);
    const u32x2 ga = *reinterpret_cast<const u32x2*>(p.proj + (size_t)t * IN_E + 512 + dd);
    u32x2 ov;
    ov.x = pack2(acc[n][0] * ps.x * bflo(ga.x), acc[n][1] * ps.y * bfhi(ga.x));
    ov.y = pack2(acc[n][2] * ps.z * bflo(ga.y), acc[n][3] * ps.w * bfhi(ga.y));
    *reinterpret_cast<u32x2*>(p.cat + (size_t)t * D + dd) = ov;
  }
}

__device__ void phase_even_mix(const P& p, char* smem) {
  if (gridDim.x == 512) {
    const int bx = blockIdx.x;
    if (bx < 256) {
      attn_unit<1>(p, bx, smem);
      const int q = bx, g = q & 3, tile = q >> 2;
      if (g == 0) pool_unit<0>(p, tile, smem); else if (g == 1) pool_unit<1>(p, tile, smem); else if (g == 2) pool_unit<2>(p, tile, smem); else pool_unit<3>(p, tile, smem);
    } else {
      attn_unit<0>(p, (bx - 256) * 2, smem);
      attn_unit<0>(p, (bx - 256) * 2 + 1, smem);
      if (bx < 384) {
        const int q = bx, g = q & 3, tile = q >> 2;
        if (g == 0) pool_unit<0>(p, tile, smem); else if (g == 1) pool_unit<1>(p, tile, smem); else if (g == 2) pool_unit<2>(p, tile, smem); else pool_unit<3>(p, tile, smem);
      }
    }
    return;
  }
  constexpr int U_N = 256, U_C = 512, U_P = 384;
  for (int u = blockIdx.x; u < U_N + U_C + U_P; u += gridDim.x) {
    if (u < U_N) attn_unit<1>(p, u, smem);
    else if (u < U_N + U_C) attn_unit<0>(p, u - U_N, smem);
    else {
      const int q = u - U_N - U_C, g = q & 3, tile = q >> 2;
      if (g == 0) pool_unit<0>(p, tile, smem); else if (g == 1) pool_unit<1>(p, tile, smem); else if (g == 2) pool_unit<2>(p, tile, smem); else pool_unit<3>(p, tile, smem);
    }
  }
}

__device__ void odd_unit(const P& p, int u, char* smem) {
  int tid = threadIdx.x;
  asm volatile("" : "+v"(tid));
  const int lane = tid & 63, wid = tid >> 6;
  u16* G = reinterpret_cast<u16*>(smem);
  float* red = reinterpret_cast<float*>(smem + 46 * 1024);
  const int t0 = u * 16;
  int sb, se;
  if (t0 < NP) { sb = t0 & ~255; se = sb + 256; } else { sb = NP + ((t0 - NP) & ~1023); se = sb + 1024; }
  const int ch = tid * 2;
  u32x4 sv[12];
#pragma unroll
  for (int i = 0; i < 12; ++i) {
    const int c = tid + i * NTHR, rr = c >> 6, c16 = c & 63;
    const int tt = t0 - 15 + rr;
    sv[i] = u32x4{0u, 0u, 0u, 0u};
    if (c < 46 * 64 && tt >= sb && tt < se) sv[i] = *reinterpret_cast<const u32x4*>(p.proj + (size_t)tt * 2048 + 1024 + c16 * 8);
  }
  unsigned cxw[18], bww[16], gdw[16];
#pragma unroll
  for (int q = 0; q < 18; ++q) {
    const int tt = t0 + q - 1;
    cxw[q] = 0u;
    if (tt >= sb && tt < se) cxw[q] = *reinterpret_cast<const unsigned*>(p.proj + (size_t)tt * 2048 + 512 + ch);
  }
#pragma unroll
  for (int i = 0; i < 16; ++i) {
    bww[i] = *reinterpret_cast<const unsigned*>(p.proj + (size_t)(t0 + i) * 2048 + ch);
    gdw[i] = *reinterpret_cast<const unsigned*>(p.proj + (size_t)(t0 + i) * 2048 + 1536 + ch);
  }
  float2 w[31];
#pragma unroll
  for (int j = 0; j < 31; ++j) w[j] = *reinterpret_cast<const float2*>(p.conv_d + j * 512 + ch);
  const float2 bias = *reinterpret_cast<const float2*>(p.conv_d_b + ch);
  const float2 lg = *reinterpret_cast<const float2*>(p.ln_g + ch);
  const float2 lb = *reinterpret_cast<const float2*>(p.ln_b + ch);
  const float2 wc0 = *reinterpret_cast<const float2*>(p.conv_c + ch);
  const float2 wc1 = *reinterpret_cast<const float2*>(p.conv_c + 512 + ch);
  const float2 wc2 = *reinterpret_cast<const float2*>(p.conv_c + 1024 + ch);
  __syncthreads();
#pragma unroll
  for (int i = 0; i < 12; ++i) {
    const int c = tid + i * NTHR, rr = c >> 6, c16 = c & 63;
    if (c < 46 * 64) *reinterpret_cast<u32x4*>(G + rr * 512 + c16 * 8) = sv[i];
  }
#pragma unroll
  for (int i = 0; i < 16; ++i) {
    const int tok = t0 + i;
    const float c0 = bflo(bww[i]) * (wc0.x * bflo(cxw[i]) + wc1.x * bflo(cxw[i + 1]) + wc2.x * bflo(cxw[i + 2]));
    const float c1 = bfhi(bww[i]) * (wc0.y * bfhi(cxw[i]) + wc1.y * bfhi(cxw[i + 1]) + wc2.y * bfhi(cxw[i + 2]));
    *reinterpret_cast<unsigned*>(p.cat + (size_t)tok * D + ch) = pack2(c0, c1);
  }
  __syncthreads();
#pragma unroll
  for (int hf = 0; hf < 2; ++hf) {
    float2 z[8];
#pragma unroll
    for (int i = 0; i < 8; ++i) z[i] = bias;
    const u16* Gh = G + hf * 8 * 512 + ch;
#pragma unroll
    for (int r = 0; r < 38; ++r) {
      const unsigned gv = *reinterpret_cast<const unsigned*>(Gh + r * 512);
      const float g0 = bflo(gv), g1 = bfhi(gv);
#pragma unroll
      for (int i = 0; i < 8; ++i) {
        const int j = r - i;
        if (j >= 0 && j <= 30) { z[i].x += w[j].x * g0; z[i].y += w[j].y * g1; }
      }
    }
    float* rd = red + hf * 64;
#pragma unroll
    for (int i = 0; i < 8; ++i) {
      const float sv2 = wave_sum(z[i].x + z[i].y);
      if (lane == 0) rd[wid * 8 + i] = sv2;
    }
    __syncthreads();
    float mu[8];
#pragma unroll
    for (int i = 0; i < 8; ++i) mu[i] = (rd[i] + rd[8 + i] + rd[16 + i] + rd[24 + i]) * (1.f / 512.f);
#pragma unroll
    for (int i = 0; i < 8; ++i) {
      const float d0 = z[i].x - mu[i], d1 = z[i].y - mu[i];
      const float sv2 = wave_sum(d0 * d0 + d1 * d1);
      if (lane == 0) rd[32 + wid * 8 + i] = sv2;
    }
    __syncthreads();
#pragma unroll
    for (int i = 0; i < 8; ++i) {
      const float rstd = rsqrtf((rd[32 + i] + rd[40 + i] + rd[48 + i] + rd[56 + i]) * (1.f / 512.f) + 1e-6f);
      const int tok = t0 + hf * 8 + i;
      const unsigned gd = gdw[hf * 8 + i];
      const float l0 = (z[i].x - mu[i]) * rstd * lg.x + lb.x;
      const float l1 = (z[i].y - mu[i]) * rstd * lg.y + lb.y;
      *reinterpret_cast<unsigned*>(p.cat + (size_t)tok * D + 512 + ch) = pack2(silu_f(l0) * bflo(gd), silu_f(l1) * bfhi(gd));
    }
  }
}

__device__ void phase_odd_mix(const P& p, char* smem) {
  for (int u = blockIdx.x; u < NTOK / 16; u += gridDim.x) odd_unit(p, u, smem);
}

__device__ void phase_final(const P& p) {
  const int lane = threadIdx.x & 63, wid = threadIdx.x >> 6;
  const bool xpart = (gridDim.x & 7) == 0;
  const int nrow = xpart ? 768 : NTOK, rstep = xpart ? (int)(gridDim.x >> 3) * 4 : (int)gridDim.x * 4;
  for (int rr = (xpart ? (int)(blockIdx.x >> 3) : (int)blockIdx.x) * 4 + wid; rr < nrow; rr += rstep) {
    const int tok = xpart ? (int)(blockIdx.x & 7) * 768 + rr : rr;
    const float* x = p.x1 + (size_t)tok * D;
    float4 v[4];
    float ss = 0.f;
#pragma unroll
    for (int i = 0; i < 4; ++i) {
      v[i] = *reinterpret_cast<const float4*>(x + i * 256 + lane * 4);
      ss += v[i].x * v[i].x + v[i].y * v[i].y + v[i].z * v[i].z + v[i].w * v[i].w;
    }
    ss = wave_sum(ss);
    const float rinv = rsqrtf(ss * (1.f / 1024.f) + 1e-6f);
#pragma unroll
    for (int i = 0; i < 4; ++i) {
      const int k = i * 256 + lane * 4;
      float4 gg = *reinterpret_cast<const float4*>(p.final_g + k);
      float4 o = make_float4(v[i].x * rinv * gg.x, v[i].y * rinv * gg.y, v[i].z * rinv * gg.z, v[i].w * rinv * gg.w);
      *reinterpret_cast<float4*>(p.out + (size_t)tok * D + k) = o;
    }
  }
}

#define XB_TMO      128
#define XB_XCNT(j)  (256  + 64 * (j))
#define XB_XSUB(j)  (1280 + 64 * (j))
#define XB_XGEN(j)  (2304 + 64 * (j))
#define XB_TOP      3328
#define XB_TOPGEN   3392
#define XCD_BAR_WORDS 3456
#define XB_SPIN_CAP (1u << 18)
#define LAS __attribute__((address_space(3)))

__device__ __forceinline__ unsigned xb_ld(unsigned* p)              { return __hip_atomic_load(p, __ATOMIC_RELAXED, __HIP_MEMORY_SCOPE_AGENT); }
__device__ __forceinline__ unsigned xb_add(unsigned* p, unsigned v) { return __hip_atomic_fetch_add(p, v, __ATOMIC_RELAXED, __HIP_MEMORY_SCOPE_AGENT); }
__device__ __forceinline__ unsigned xb_xcc_id() { return (unsigned)__builtin_amdgcn_s_getreg((3 << 11) | 20) & 0xFu; }
#define XB_SPIN(cond, bar) do { unsigned _sp = 0; while (cond) { __builtin_amdgcn_s_sleep(1); \
    if ((++_sp & 255u) == 0u) { if (xb_ld(&(bar)[XB_TMO])) break; if (_sp > XB_SPIN_CAP) { atomicAdd(&(bar)[XB_TMO], 1u); break; } } } } while (0)

struct XcdBarrier {
    unsigned* bar; unsigned x;
    unsigned nloc, nx;
    volatile unsigned* st;
};

__device__ __forceinline__ XcdBarrier xcd_barrier_post(unsigned* bar, volatile unsigned* st) {
    XcdBarrier b; b.bar = bar; b.x = xb_xcc_id(); b.st = st; b.nloc = 0u; b.nx = 0u;
    if (threadIdx.x == 0) (void)xb_add(&bar[XB_XCNT(b.x)], 1u);
    return b;
}
__device__ __forceinline__ void xcd_barrier_complete(unsigned* bar, unsigned x, unsigned& nloc, unsigned& nx) {
    const unsigned G = gridDim.x * gridDim.y * gridDim.z;
    unsigned sum, cnt, mine, sp = 0u;
    for (;;) {
        sum = 0u; cnt = 0u; mine = 0u;
#pragma unroll
        for (unsigned j = 0; j < 16; ++j) { const unsigned c = xb_ld(&bar[XB_XCNT(j)]); sum += c; cnt += (c > 0u) ? 1u : 0u; mine = (j == x) ? c : mine; }
        if (sum == G) break;
        __builtin_amdgcn_s_sleep(1);
        if ((++sp & 255u) == 0u) { if (xb_ld(&bar[XB_TMO])) break; if (sp > XB_SPIN_CAP) { atomicAdd(&bar[XB_TMO], 1u); break; } }
    }
    nloc = mine > 0u ? mine : 1u; nx = cnt > 0u ? cnt : 1u;
}

__device__ __forceinline__ void xcd_barrier(XcdBarrier& b) {
    asm volatile("s_waitcnt vmcnt(0)" ::: "memory");
    __syncthreads();
    if (threadIdx.x == 0) {
        unsigned* bar = b.bar;
        __builtin_amdgcn_s_waitcnt(0);
        unsigned nloc = b.nloc, nx = b.nx;
        if (nloc == 0u) { xcd_barrier_complete(bar, b.x, nloc, nx); b.nloc = nloc; b.nx = nx; }
        const unsigned old = xb_add(&bar[XB_XSUB(b.x)], 1u);
        const unsigned gen = old / nloc;
        if (old + 1u == (gen + 1u) * nloc) {
            __builtin_amdgcn_fence(__ATOMIC_RELEASE, "agent");
            asm volatile("s_waitcnt vmcnt(0)" ::: "memory");
            const unsigned og = xb_add(&bar[XB_TOP], 1u);
            const unsigned tg = og / nx;
            if (og + 1u == (tg + 1u) * nx) xb_add(&bar[XB_TOPGEN], 1u);
            else XB_SPIN(xb_ld(&bar[XB_TOPGEN]) == tg, bar);
            __builtin_amdgcn_fence(__ATOMIC_ACQUIRE, "agent");
            xb_add(&bar[XB_XGEN(b.x)], 1u);
            asm volatile("s_waitcnt vmcnt(0)" ::: "memory");
        } else {
            XB_SPIN(xb_ld(&bar[XB_XGEN(b.x)]) == gen, bar);
            __builtin_amdgcn_fence(__ATOMIC_ACQUIRE, "agent");
            asm volatile("s_waitcnt vmcnt(0)" ::: "memory");
        }
    }
    __syncthreads();
}


template <int PH>
__device__ __forceinline__ void run_phase(const P& p, char* smem) {
  if (PH == 0) phase0(p, smem);
  if (PH == 1) phase_norm(p, 0, p.x_prompt, p.x_sample);
  if (PH == 2) gemm_phase<0, 128>(p, p.h, p.wt_in_even, IN_E, smem);
  if (PH == 3) phase_even_mix(p, smem);
  if (PH == 4) gemm_phase<1, 96>(p, p.cat, p.wt_out_even, D, smem);
  if (PH == 6) gemm_phase<2, 128>(p, p.h, p.wt_in_odd, IN_O, smem);
  if (PH == 7) phase_odd_mix(p, smem);
  if (PH == 8) gemm_phase<3, 96>(p, p.cat, p.wt_out_odd, D, smem);
  if (PH == 9) phase_final(p);
}

__global__ void __launch_bounds__(NTHR, 2) mega_kernel(P p) {
  __shared__ __attribute__((aligned(16))) char smem[SMEM_BYTES];
  cg::grid_group grid = cg::this_grid();
  XcdBarrier xb = xcd_barrier_post(p.bar, (volatile unsigned*)(p.bar + XCD_BAR_WORDS + 64 * blockIdx.x));
  if (p.use_cg) grid.sync();
#define RUNP(PH) do { run_phase<PH>(p, smem); if ((PROBE_REPEAT >> PH) & 1) { xcd_barrier(xb); run_phase<PH>(p, smem); } } while (0)
#define GSYNC() do { xcd_barrier(xb); if (PROBE_SYNC2) xcd_barrier(xb); } while (0)
  RUNP(0); GSYNC();
  RUNP(1); GSYNC();
  RUNP(2); GSYNC();
  RUNP(3); GSYNC();
  RUNP(4); GSYNC();
  RUNP(6); GSYNC();
  RUNP(7); GSYNC();
  run_phase<8>(p, smem); GSYNC();
  RUNP(9);
}

template <int PH>
__global__ void __launch_bounds__(NTHR, 2) phase_kernel(P p) {
  __shared__ __attribute__((aligned(16))) char smem[SMEM_BYTES];
  run_phase<PH>(p, smem);
}

constexpr int BAR_TOTAL_WORDS = XCD_BAR_WORDS + 64 * 2048;
static inline size_t align_up(size_t x) { return (x + 255) & ~(size_t)255; }

extern "C" void kernel_launch(void* const* d_in, const int* in_sizes, int n_in, void* d_out, int out_size, void* d_ws,
                              size_t ws_size, hipStream_t stream) {
  P p{};
  const float** f = reinterpret_cast<const float**>(&p);
  for (int i = 0; i < 22; ++i) f[i] = (const float*)d_in[i];
  p.out = (float*)d_out;
  char* w = (char*)d_ws;
  size_t off = 0;
  p.mod = (float*)(w + off); off = align_up(off + (size_t)2 * 3 * 3072 * 4);
  p.wt_in_even = (u16*)(w + off); off = align_up(off + (size_t)IN_E * D * 2);
  p.wt_out_even = (u16*)(w + off); off = align_up(off + (size_t)D * D * 2);
  p.wt_in_odd = (u16*)(w + off); off = align_up(off + (size_t)IN_O * D * 2);
  p.wt_out_odd = (u16*)(w + off); off = align_up(off + (size_t)D * D * 2);
  p.wpt = (u16*)(w + off); off = align_up(off + (size_t)4 * 128 * 128 * 2);
  p.h = (u16*)(w + off); off = align_up(off + (size_t)NTOK * D * 2);
  p.proj = (u16*)(w + off); off = align_up(off + (size_t)NTOK * IN_O * 2);
  p.cat = (u16*)(w + off); off = align_up(off + (size_t)NTOK * D * 2);
  p.x1 = (float*)(w + off); off = align_up(off + (size_t)NTOK * D * 4);
  p.kcb = (u16*)(w + off); off = align_up(off + (size_t)262144 * 2);
  p.vcb = (u16*)(w + off); off = align_up(off + (size_t)262144 * 2);
  p.rowss = (float*)(w + off); off = align_up(off + (size_t)NTOK * 16 * 4);
  p.bias1 = (float*)(w + off); off = align_up(off + (size_t)3 * IN_O * 4);
  p.bar = (unsigned*)(w + off); off = align_up(off + (size_t)BAR_TOTAL_WORDS * 4);
  p.use_cg = 0ull;

#if MULTI_LAUNCH
  const int G = 1024;
  phase_kernel<0><<<G, NTHR, 0, stream>>>(p);
  phase_kernel<1><<<G, NTHR, 0, stream>>>(p);
  phase_kernel<2><<<G, NTHR, 0, stream>>>(p);
  phase_kernel<3><<<G, NTHR, 0, stream>>>(p);
  phase_kernel<4><<<G, NTHR, 0, stream>>>(p);
  phase_kernel<6><<<G, NTHR, 0, stream>>>(p);
  phase_kernel<7><<<G, NTHR, 0, stream>>>(p);
  phase_kernel<8><<<G, NTHR, 0, stream>>>(p);
  phase_kernel<9><<<G, NTHR, 0, stream>>>(p);
#else
  static int grid_blocks = 0;
  if (!grid_blocks) {
    int dev = 0, cus = 0, per_cu = 0;
    hipGetDevice(&dev);
    hipDeviceGetAttribute(&cus, hipDeviceAttributeMultiprocessorCount, dev);
    hipOccupancyMaxActiveBlocksPerMultiprocessor(&per_cu, mega_kernel, NTHR, 0);
    if (per_cu < 1) per_cu = 1;
    grid_blocks = cus * per_cu;
  }
  (void)hipMemsetAsync(p.bar, 0, (size_t)BAR_TOTAL_WORDS * 4, stream);
  void* args[] = {&p};
  hipError_t e = hipLaunchCooperativeKernel((void*)mega_kernel, dim3(grid_blocks), dim3(NTHR), args, 0, stream);
  if (e != hipSuccess) fprintf(stderr, "cooperative launch failed: %s (grid %d)\n", hipGetErrorString(e), grid_blocks);
#endif
}
```

```cpp
#include <hip/hip_runtime.h>
#include <hip/hip_cooperative_groups.h>
#include <cstdio>
namespace cg = cooperative_groups;

#define PROBE_REPEAT 0x00
#define PROBE_SYNC2 0
#ifndef MULTI_LAUNCH
#define MULTI_LAUNCH 0
#endif

typedef unsigned short u16;
using bf16x8 = __attribute__((ext_vector_type(8))) short;
using f32x4 = __attribute__((ext_vector_type(4))) float;
using u32x4 = __attribute__((ext_vector_type(4))) unsigned;
using u32x2 = __attribute__((ext_vector_type(2))) unsigned;

constexpr int D = 1024;
constexpr int NP = 4096;
constexpr int NS = 2048;
constexpr int NTOK = NP + NS;
constexpr int IN_E = 3072;
constexpr int IN_O = 3584;
constexpr int NTHR = 256;
constexpr int SMEM_BYTES = 64 * 1024;

struct P {
  const float *x_prompt, *x_sample, *cache_k, *cache_v, *c, *c_ctx, *norm_g, *w_mod, *b_mod, *w_in_even, *w_pool,
      *pool_scale, *rpb, *w_out_even, *w_in_odd, *conv_c, *conv_d, *conv_d_b, *ln_g, *ln_b, *w_out_odd, *final_g;
  float* out;
  float* mod;
  u16 *wt_in_even, *wt_out_even, *wt_in_odd, *wt_out_odd, *wpt;
  u16 *h, *proj, *cat;
  u16 *kcb, *vcb;
  float *rowss;
  float *bias1;
  float* x1;
  unsigned* bar;
  unsigned long long use_cg;
};

typedef __bf16 hbf2 __attribute__((ext_vector_type(2)));
typedef float hf2 __attribute__((ext_vector_type(2)));
__device__ __forceinline__ unsigned pack2(float a, float b) {
  const hf2 v = {a, b};
  return __builtin_bit_cast(unsigned, __builtin_convertvector(v, hbf2));
}
__device__ __forceinline__ u16 f2bf(float f) { return (u16)(pack2(f, 0.f) & 0xffffu); }
__device__ __forceinline__ float bf2f(u16 h) { return __uint_as_float(((unsigned)h) << 16); }
__device__ __forceinline__ float bflo(unsigned u) { return __uint_as_float(u << 16); }
__device__ __forceinline__ float bfhi(unsigned u) { return __uint_as_float(u & 0xffff0000u); }
__device__ __forceinline__ float silu_f(float x) { return x * __builtin_amdgcn_rcpf(1.f + __expf(-x)); }
__device__ __forceinline__ float sigmoid_f(float x) { return __builtin_amdgcn_rcpf(1.f + __expf(-x)); }
__device__ __forceinline__ float wave_sum(float v) {
#pragma unroll
  for (int o = 32; o >= 1; o >>= 1) v += __shfl_xor(v, o);
  return v;
}
__device__ __forceinline__ int cond_of_token(int tok) { return tok < NP ? 0 : 1 + ((tok - NP) >> 10); }

__device__ void mod_unit(const P& p, int u, float* sm) {
  const int layer = u / 96, cg32 = u % 96;
  const int tid = threadIdx.x;
  float* sc = sm;
  float* red = sm + 3 * 1024;
  __syncthreads();
#pragma unroll
  for (int q = 0; q < 12; ++q) {
    const int i = tid + q * NTHR;
    const int cv = i >> 10, k = i & 1023;
    const float v = (cv == 0) ? p.c_ctx[k] : p.c[(cv - 1) * 1024 + k];
    sc[i] = silu_f(v);
  }
  __syncthreads();
  const int cq = tid & 7, ks = tid >> 3;
  const float* W = p.w_mod + (size_t)layer * 1024 * 3072 + cg32 * 32 + cq * 4;
  float a[3][4] = {};
#pragma unroll 8
  for (int i = 0; i < 32; ++i) {
    int k = ks * 32 + i;
    using nf4 = __attribute__((ext_vector_type(4))) float;
    const nf4 wq = __builtin_nontemporal_load(reinterpret_cast<const nf4*>(W + (size_t)k * 3072));
    float4 w = make_float4(wq.x, wq.y, wq.z, wq.w);
#pragma unroll
    for (int cv = 0; cv < 3; ++cv) {
      float s = sc[cv * 1024 + k];
      a[cv][0] += s * w.x; a[cv][1] += s * w.y; a[cv][2] += s * w.z; a[cv][3] += s * w.w;
    }
  }
#pragma unroll
  for (int cv = 0; cv < 3; ++cv)
#pragma unroll
    for (int j = 0; j < 4; ++j) {
      float v = a[cv][j];
      v += __shfl_xor(v, 8); v += __shfl_xor(v, 16); v += __shfl_xor(v, 32);
      a[cv][j] = v;
    }
  const int lane = tid & 63, wid = tid >> 6;
  if (lane < 8) {
#pragma unroll
    for (int cv = 0; cv < 3; ++cv)
#pragma unroll
      for (int j = 0; j < 4; ++j) red[wid * 96 + cv * 32 + lane * 4 + j] = a[cv][j];
  }
  __syncthreads();
  if (tid < 96) {
    int cv = tid >> 5, col = tid & 31;
    float v = red[tid] + red[96 + tid] + red[192 + tid] + red[288 + tid];
    int n = cg32 * 32 + col;
    v += p.b_mod[layer * 3072 + n];
    p.mod[(layer * 3 + cv) * 3072 + n] = v;
  }
}

__device__ __forceinline__ int perm_row_general(int s) {
  const int tile = s >> 7, c = s & 127, wc = c >> 6, q = c & 63;
  const int n = ((q >> 5) << 1) | ((q >> 2) & 1), i = (((q >> 3) & 3) << 2) | (q & 3);
  return tile * 128 + wc * 64 + n * 16 + i;
}
__device__ __forceinline__ int perm_row_odd(int s) {
  if (s >= 3072) return perm_row_general(s);
  const int region = s >> 9, ch = s & 511;
  const int type = (region == 0 || region == 3) ? 0 : (region <= 2 ? 1 : 2);
  const int member = (region == 0 || region == 1 || region == 4) ? 0 : 1;
  const int chunk = ch >> 6, wc = (ch >> 5) & 1, cw = ch & 31;
  const int n = member * 2 + ((cw >> 2) & 1), i = ((cw >> 3) << 2) | (cw & 3);
  return (type * 8 + chunk) * 128 + wc * 64 + n * 16 + i;
}
template <int MODE>
__device__ void transpose_tile(const float* __restrict__ src, u16* __restrict__ dst, int K, int N, int t, float* sm) {
  const int tid = threadIdx.x;
  const int ntn = N >> 6;
  const int k0 = (t / ntn) * 64, n0 = (t % ntn) * 64;
  __syncthreads();
  {
    const int r = tid >> 4, c4 = tid & 15;
#pragma unroll
    for (int i = 0; i < 4; ++i) {
      int k = r + 16 * i;
      using nf4 = __attribute__((ext_vector_type(4))) float;
      const nf4 vq = __builtin_nontemporal_load(reinterpret_cast<const nf4*>(src + (size_t)(k0 + k) * N + n0 + c4 * 4));
      float4 v = make_float4(vq.x, vq.y, vq.z, vq.w);
      float* d = sm + k * 65 + c4 * 4;
      d[0] = v.x; d[1] = v.y; d[2] = v.z; d[3] = v.w;
    }
  }
  __syncthreads();
  {
    const int kc = tid & 7, nl = tid >> 3;
#pragma unroll
    for (int i = 0; i < 2; ++i) {
      int n = nl + 32 * i;
      float v[8];
#pragma unroll
      for (int j = 0; j < 8; ++j) v[j] = sm[(kc * 8 + j) * 65 + n];
      u32x4 o;
      o.x = pack2(v[0], v[1]); o.y = pack2(v[2], v[3]); o.z = pack2(v[4], v[5]); o.w = pack2(v[6], v[7]);
      const int drow = MODE == 0 ? (n0 + n) : (MODE == 1 ? perm_row_general(n0 + n) : perm_row_odd(n0 + n));
      *reinterpret_cast<u32x4*>(dst + (size_t)drow * K + k0 + kc * 8) = o;
    }
  }
}

__device__ void phase0(const P& p, char* smem) {
  float* sm = reinterpret_cast<float*>(smem);
  constexpr int T0 = 192, T1 = T0 + 768, T2 = T1 + 256, T3 = T2 + 896, T4 = T3 + 256, T5 = T4 + 16;
  for (int u = blockIdx.x; u < T5; u += gridDim.x) {
    if (u < T0) mod_unit(p, u, sm);
    else if (u < T1) transpose_tile<1>(p.w_in_even, p.wt_in_even, 1024, 3072, u - T0, sm);
    else if (u < T2) transpose_tile<1>(p.w_out_even, p.wt_out_even, 1024, 1024, u - T1, sm);
    else if (u < T3) transpose_tile<2>(p.w_in_odd, p.wt_in_odd, 1024, 3584, u - T2, sm);
    else if (u < T4) transpose_tile<1>(p.w_out_odd, p.wt_out_odd, 1024, 1024, u - T3, sm);
    else { int t = u - T4; int g = t >> 2; transpose_tile<0>(p.w_pool + g * 16384, p.wpt + g * 16384, 128, 128, t & 3, sm); }
  }
}

__device__ void phase_norm(const P& p, int layer, const float* xa, const float* xb) {
  const int lane = threadIdx.x & 63, wid = threadIdx.x >> 6;
  if (layer == 0) {
    for (int prow = blockIdx.x * 4 + wid; prow < IN_O; prow += gridDim.x * 4) {
      const u16* wrow = p.wt_in_odd + (size_t)prow * D + lane * 16;
      const u32x4 w0 = *reinterpret_cast<const u32x4*>(wrow), w1 = *reinterpret_cast<const u32x4*>(wrow + 8);
      const float wf[16] = {bflo(w0.x), bfhi(w0.x), bflo(w0.y), bfhi(w0.y), bflo(w0.z), bfhi(w0.z), bflo(w0.w), bfhi(w0.w),
                            bflo(w1.x), bfhi(w1.x), bflo(w1.y), bfhi(w1.y), bflo(w1.z), bfhi(w1.z), bflo(w1.w), bfhi(w1.w)};
#pragma unroll
      for (int cv = 0; cv < 3; ++cv) {
        const float* sh = p.mod + (size_t)(3 + cv) * 3072 + lane * 16;
        float a = 0.f;
#pragma unroll
        for (int q = 0; q < 4; ++q) {
          const float4 s4 = *reinterpret_cast<const float4*>(sh + q * 4);
          a += s4.x * wf[q * 4] + s4.y * wf[q * 4 + 1] + s4.z * wf[q * 4 + 2] + s4.w * wf[q * 4 + 3];
        }
        a = wave_sum(a);
        if (lane == 0) p.bias1[cv * IN_O + prow] = a;
      }
    }
    for (int i = blockIdx.x * NTHR + threadIdx.x; i < 2 * 32768; i += gridDim.x * NTHR) {
      const float* src = (i < 32768 ? p.cache_k : p.cache_v) + (size_t)(i & 32767) * 8;
      u16* dst = (i < 32768 ? p.kcb : p.vcb) + (size_t)(i & 32767) * 8;
      const float4 a = *reinterpret_cast<const float4*>(src), c = *reinterpret_cast<const float4*>(src + 4);
      u32x4 o; o.x = pack2(a.x, a.y); o.y = pack2(a.z, a.w); o.z = pack2(c.x, c.y); o.w = pack2(c.z, c.w);
      *reinterpret_cast<u32x4*>(dst) = o;
    }
  }
  const float* g = p.norm_g + layer * 1024;
  const bool xpart = (gridDim.x & 7) == 0;
  const int nrow = xpart ? 768 : NTOK, rstep = xpart ? (int)(gridDim.x >> 3) * 4 : (int)gridDim.x * 4;
  for (int rr = (xpart ? (int)(blockIdx.x >> 3) : (int)blockIdx.x) * 4 + wid; rr < nrow; rr += rstep) {
    const int tok = xpart ? (int)(blockIdx.x & 7) * 768 + rr : rr;
    const float* x = tok < NP ? xa + (size_t)tok * D : xb + (size_t)(tok - NP) * D;
    const float* m = p.mod + (size_t)(layer * 3 + cond_of_token(tok)) * 3072;
    float4 v[4], ggv[4], shv[4], scv[4];
    float ss = 0.f;
#pragma unroll
    for (int i = 0; i < 4; ++i) {
      const int k = i * 256 + lane * 4;
      v[i] = *reinterpret_cast<const float4*>(x + k);
      ggv[i] = *reinterpret_cast<const float4*>(g + k);
      shv[i] = *reinterpret_cast<const float4*>(m + k);
      scv[i] = *reinterpret_cast<const float4*>(m + 1024 + k);
    }
#pragma unroll
    for (int i = 0; i < 4; ++i) ss += v[i].x * v[i].x + v[i].y * v[i].y + v[i].z * v[i].z + v[i].w * v[i].w;
    ss = wave_sum(ss);
    const float rinv = rsqrtf(ss * (1.f / 1024.f) + 1e-6f);
#pragma unroll
    for (int i = 0; i < 4; ++i) {
      const int k = i * 256 + lane * 4;
      const float4 gg = ggv[i], sh = shv[i], sc = scv[i];
      float h0 = v[i].x * rinv * gg.x * (1.f + sc.x) + sh.x;
      float h1 = v[i].y * rinv * gg.y * (1.f + sc.y) + sh.y;
      float h2 = v[i].z * rinv * gg.z * (1.f + sc.z) + sh.z;
      float h3 = v[i].w * rinv * gg.w * (1.f + sc.w) + sh.w;
      u32x2 o; o.x = pack2(h0, h1); o.y = pack2(h2, h3);
      *reinterpret_cast<u32x2*>(p.h + (size_t)tok * D + k) = o;
    }
  }
}

template <int EPI, int BM>
__device__ void gemm_phase(const P& p, const u16* __restrict__ A, const u16* __restrict__ Bt, int N, char* smem) {
  constexpr int K = 1024, BK = 64;
  const int tid = threadIdx.x, wid = tid >> 6, lane = tid & 63, wr = wid >> 1, wc = wid & 1, fr = lane & 15, fq = lane >> 4;
  const int NT = N >> 7;
  constexpr int MI = BM / 32;
  constexpr int NAL = BM / 32;
  const int ntiles = (NTOK / BM) * NT;
  const int srow = tid >> 3;
  const int schunk = (tid & 7) ^ ((tid >> 4) & 7);
  const bool xpart = (gridDim.x & 7) == 0;
  constexpr int MPX = 768 / BM;
  const int xcd = blockIdx.x & 7;
  const int jfirst = xpart ? (int)(blockIdx.x >> 3) : (int)blockIdx.x;
  const int jstep = xpart ? (int)(gridDim.x >> 3) : (int)gridDim.x;
  const int jend = xpart ? MPX * NT : ntiles;
  const u16* ga = nullptr; const u16* gb = nullptr;
  if (jfirst < jend) {
    const int mt0 = xpart ? xcd * MPX + jfirst % MPX : jfirst / NT, nt0 = xpart ? jfirst / MPX : jfirst % NT;
    ga = A + (size_t)(mt0 * BM + srow) * K + schunk * 8;
    gb = Bt + (size_t)(nt0 * 128 + srow) * K + schunk * 8;
    __syncthreads();
#pragma unroll
    for (int i = 0; i < NAL; ++i)
      __builtin_amdgcn_global_load_lds((const unsigned*)(ga + (size_t)(32 * i) * K), (unsigned*)(smem + i * 4096 + tid * 16), 16, 0, 0);
#pragma unroll
    for (int i = 0; i < 4; ++i)
      __builtin_amdgcn_global_load_lds((const unsigned*)(gb + (size_t)(32 * i) * K), (unsigned*)(smem + 16384 + i * 4096 + tid * 16), 16, 0, 0);
  }
  for (int tile = jfirst; tile < jend; tile += jstep) {
    const int mt = xpart ? xcd * MPX + tile % MPX : tile / NT, nt = xpart ? tile / MPX : tile % NT;
    const int brow = mt * BM, bcol = nt * 128;
    f32x4 acc[MI][4] = {};
    for (int t = 0; t < K / BK; ++t) {
      char* SA = smem + (t & 1) * 32768;
      char* SB = SA + 16384;
      asm volatile("s_waitcnt vmcnt(0)" ::: "memory");
      __syncthreads();
      if (t + 1 < K / BK) {
        char* NA = smem + ((t + 1) & 1) * 32768;
#pragma unroll
        for (int i = 0; i < NAL; ++i)
          __builtin_amdgcn_global_load_lds((const unsigned*)(ga + (size_t)(32 * i) * K + (t + 1) * BK), (unsigned*)(NA + i * 4096 + tid * 16), 16, 0, 0);
#pragma unroll
        for (int i = 0; i < 4; ++i)
          __builtin_amdgcn_global_load_lds((const unsigned*)(gb + (size_t)(32 * i) * K + (t + 1) * BK), (unsigned*)(NA + 16384 + i * 4096 + tid * 16), 16, 0, 0);
      } else {
        const int tn = tile + jstep;
        if (tn < jend) {
          const int mtn = xpart ? xcd * MPX + tn % MPX : tn / NT, ntn = xpart ? tn / MPX : tn % NT;
          ga = A + (size_t)(mtn * BM + srow) * K + schunk * 8;
          gb = Bt + (size_t)(ntn * 128 + srow) * K + schunk * 8;
#pragma unroll
          for (int i = 0; i < NAL; ++i)
            __builtin_amdgcn_global_load_lds((const unsigned*)(ga + (size_t)(32 * i) * K), (unsigned*)(smem + i * 4096 + tid * 16), 16, 0, 0);
#pragma unroll
          for (int i = 0; i < 4; ++i)
            __builtin_amdgcn_global_load_lds((const unsigned*)(gb + (size_t)(32 * i) * K), (unsigned*)(smem + 16384 + i * 4096 + tid * 16), 16, 0, 0);
        }
      }
      {
        bf16x8 af[2][MI], bfr[2][4];
#pragma unroll
        for (int kk = 0; kk < 2; ++kk) {
#pragma unroll
          for (int n = 0; n < 4; ++n) {
            const int r = wc * 64 + n * 16 + fr;
            bfr[kk][n] = *reinterpret_cast<const bf16x8*>(SB + r * 128 + (((kk * 4 + fq) ^ ((r >> 1) & 7)) << 4));
          }
#pragma unroll
          for (int m = 0; m < MI; ++m) {
            const int r = wr * (BM / 2) + m * 16 + fr;
            af[kk][m] = *reinterpret_cast<const bf16x8*>(SA + r * 128 + (((kk * 4 + fq) ^ ((r >> 1) & 7)) << 4));
          }
        }
#pragma unroll
        for (int kk = 0; kk < 2; ++kk)
#pragma unroll
          for (int m = 0; m < MI; ++m)
#pragma unroll
            for (int n = 0; n < 4; ++n) acc[m][n] = __builtin_amdgcn_mfma_f32_16x16x32_bf16(bfr[kk][n], af[kk][m], acc[m][n], 0, 0, 0);
        __builtin_amdgcn_sched_group_barrier(0x100, MI + 4, 0);
#pragma unroll
        for (int i = 0; i < MI + 4; ++i) {
          __builtin_amdgcn_sched_group_barrier(0x008, 2, 0);
          __builtin_amdgcn_sched_group_barrier(0x100, 1, 0);
        }
        __builtin_amdgcn_sched_group_barrier(0x008, 8 * MI - 2 * (MI + 4), 0);
      }
    }
    if (EPI == 0) {
      const bool gate_tile = (nt >= 4 && nt < 8) || nt >= 20;
#pragma unroll
      for (int m = 0; m < MI; ++m) {
        const int row = brow + wr * (BM / 2) + m * 16 + fr;
#pragma unroll
        for (int np = 0; np < 2; ++np) {
          const int col = bcol + wc * 64 + np * 32 + fq * 8;
          float v[8];
#pragma unroll
          for (int j = 0; j < 4; ++j) { v[j] = acc[m][np * 2][j]; v[4 + j] = acc[m][np * 2 + 1][j]; }
          if (gate_tile) {
#pragma unroll
            for (int j = 0; j < 8; ++j) v[j] = silu_f(v[j]);
          }
          u32x4 o; o.x = pack2(v[0], v[1]); o.y = pack2(v[2], v[3]); o.z = pack2(v[4], v[5]); o.w = pack2(v[6], v[7]);
          *reinterpret_cast<u32x4*>(p.proj + (size_t)row * IN_E + col) = o;
          if (brow < NP && nt >= 12 && nt < 20) {
            const bool isv = nt >= 16;
            float* dst = p.out + (size_t)NTOK * D + (isv ? (size_t)16 * 8 * 256 * 64 : 0);
            const int cc = col - (isv ? 2048 : 1536);
            const int b = row >> 8, tt = row & 255, hh = cc >> 6, dd = cc & 63;
            float* d2 = dst + (((size_t)b * 8 + hh) * 256 + tt) * 64 + dd;
            *reinterpret_cast<float4*>(d2) = make_float4(v[0], v[1], v[2], v[3]);
            *reinterpret_cast<float4*>(d2 + 4) = make_float4(v[4], v[5], v[6], v[7]);
          }
        }
      }
    } else if (EPI == 2) {
      {
        const int cv = cond_of_token(brow);
        float rinv[MI];
#pragma unroll
        for (int m = 0; m < MI; ++m) {
          const float* rs = p.rowss + (size_t)(brow + wr * (BM / 2) + m * 16 + fr) * 16;
          const float4 a = *reinterpret_cast<const float4*>(rs), b2 = *reinterpret_cast<const float4*>(rs + 4);
          const float4 c2 = *reinterpret_cast<const float4*>(rs + 8), d2 = *reinterpret_cast<const float4*>(rs + 12);
          const float tot = (a.x + a.y + a.z + a.w) + (b2.x + b2.y + b2.z + b2.w) + (c2.x + c2.y + c2.z + c2.w) + (d2.x + d2.y + d2.z + d2.w);
          rinv[m] = rsqrtf(tot * (1.f / 1024.f) + 1e-6f);
        }
#pragma unroll
        for (int n = 0; n < 4; ++n) {
          const float4 bz = *reinterpret_cast<const float4*>(p.bias1 + (size_t)cv * IN_O + bcol + wc * 64 + n * 16 + fq * 4);
#pragma unroll
          for (int m = 0; m < MI; ++m) {
            acc[m][n][0] = acc[m][n][0] * rinv[m] + bz.x; acc[m][n][1] = acc[m][n][1] * rinv[m] + bz.y;
            acc[m][n][2] = acc[m][n][2] * rinv[m] + bz.z; acc[m][n][3] = acc[m][n][3] * rinv[m] + bz.w;
          }
        }
      }
      if (nt < 24) {
        const int type = nt >> 3, chunk = nt & 7;
#pragma unroll
        for (int m = 0; m < MI; ++m) {
          const int row = brow + wr * (BM / 2) + m * 16 + fr;
          float v[8];
#pragma unroll
          for (int nl = 0; nl < 2; ++nl)
#pragma unroll
            for (int j = 0; j < 4; ++j) {
              const float a = acc[m][nl][j], b = acc[m][2 + nl][j];
              v[nl * 4 + j] = type == 0 ? a * silu_f(b) : (type == 1 ? a * b : a * sigmoid_f(b));
            }
          u32x4 o; o.x = pack2(v[0], v[1]); o.y = pack2(v[2], v[3]); o.z = pack2(v[4], v[5]); o.w = pack2(v[6], v[7]);
          *reinterpret_cast<u32x4*>(p.proj + (size_t)row * 2048 + type * 512 + chunk * 64 + wc * 32 + fq * 8) = o;
        }
      } else {
#pragma unroll
        for (int m = 0; m < MI; ++m) {
          const int row = brow + wr * (BM / 2) + m * 16 + fr;
#pragma unroll
          for (int np = 0; np < 2; ++np) {
            float v[8];
#pragma unroll
            for (int j = 0; j < 4; ++j) { v[j] = silu_f(acc[m][np * 2][j]); v[4 + j] = silu_f(acc[m][np * 2 + 1][j]); }
            u32x4 o; o.x = pack2(v[0], v[1]); o.y = pack2(v[2], v[3]); o.z = pack2(v[4], v[5]); o.w = pack2(v[6], v[7]);
            *reinterpret_cast<u32x4*>(p.proj + (size_t)row * 2048 + 1536 + (nt - 24) * 128 + wc * 64 + np * 32 + fq * 8) = o;
          }
        }
      }
    } else {
      const int layer = (EPI == 1) ? 0 : 1;
      float ssq[MI] = {};
#pragma unroll
      for (int np = 0; np < 2; ++np) {
        const int col = bcol + wc * 64 + np * 32 + fq * 8;
        float4 n0 = {}, n1 = {};
        if (EPI == 1) { n0 = *reinterpret_cast<const float4*>(p.norm_g + 1024 + col); n1 = *reinterpret_cast<const float4*>(p.norm_g + 1024 + col + 4); }
#pragma unroll
        for (int m = 0; m < MI; ++m) {
          const int row = brow + wr * (BM / 2) + m * 16 + fr;
          const int cv = cond_of_token(row);
          const float* gate = p.mod + (size_t)(layer * 3 + cv) * 3072 + 2048 + col;
          const float4 g0 = *reinterpret_cast<const float4*>(gate);
          const float4 g1 = *reinterpret_cast<const float4*>(gate + 4);
          const float* xin = (EPI == 1) ? (row < NP ? p.x_prompt + (size_t)row * D + col : p.x_sample + (size_t)(row - NP) * D + col)
                                        : p.x1 + (size_t)row * D + col;
          const float4 x0 = *reinterpret_cast<const float4*>(xin);
          const float4 x1v = *reinterpret_cast<const float4*>(xin + 4);
          float4 o0, o1;
          o0.x = x0.x + g0.x * acc[m][np * 2][0]; o0.y = x0.y + g0.y * acc[m][np * 2][1];
          o0.z = x0.z + g0.z * acc[m][np * 2][2]; o0.w = x0.w + g0.w * acc[m][np * 2][3];
          o1.x = x1v.x + g1.x * acc[m][np * 2 + 1][0]; o1.y = x1v.y + g1.y * acc[m][np * 2 + 1][1];
          o1.z = x1v.z + g1.z * acc[m][np * 2 + 1][2]; o1.w = x1v.w + g1.w * acc[m][np * 2 + 1][3];
          float* xo = p.x1 + (size_t)row * D + col;
          *reinterpret_cast<float4*>(xo) = o0;
          *reinterpret_cast<float4*>(xo + 4) = o1;
          if (EPI == 1) {
            const float* sc = p.mod + (size_t)(3 + cv) * 3072 + 1024 + col;
            const float4 s0 = *reinterpret_cast<const float4*>(sc), s1 = *reinterpret_cast<const float4*>(sc + 4);
            ssq[m] += o0.x * o0.x + o0.y * o0.y + o0.z * o0.z + o0.w * o0.w + o1.x * o1.x + o1.y * o1.y + o1.z * o1.z + o1.w * o1.w;
            u32x4 hv;
            hv.x = pack2(o0.x * n0.x * (1.f + s0.x), o0.y * n0.y * (1.f + s0.y)); hv.y = pack2(o0.z * n0.z * (1.f + s0.z), o0.w * n0.w * (1.f + s0.w));
            hv.z = pack2(o1.x * n1.x * (1.f + s1.x), o1.y * n1.y * (1.f + s1.y)); hv.w = pack2(o1.z * n1.z * (1.f + s1.z), o1.w * n1.w * (1.f + s1.w));
            *reinterpret_cast<u32x4*>(p.h + (size_t)row * D + col) = hv;
          }
        }
      }
      if (EPI == 1) {
#pragma unroll
        for (int m = 0; m < MI; ++m) {
          float v = ssq[m];
          v += __shfl_xor(v, 16); v += __shfl_xor(v, 32);
          if (fq == 0) p.rowss[(size_t)(brow + wr * (BM / 2) + m * 16 + fr) * 16 + nt * 2 + wc] = v;
        }
      }
    }
  }
}

template <int MODE>
__device__ void attn_unit(const P& p, int u, char* smem) {
  const int tid = threadIdx.x, wid = tid >> 6, lane = tid & 63, fr = lane & 15, fq = lane >> 4;
  char* Ks = smem;
  u16* Vt = reinterpret_cast<u16*>(smem + 16384);
  float* rpl = reinterpret_cast<float*>(smem + 16384 + 18432);
  int h, qtok0, b, r = 0;
  if (MODE == 0) { b = u >> 5; h = (u >> 2) & 7; qtok0 = b * 256 + (u & 3) * 64; }
  else { b = u >> 7; r = (u >> 3) & 15; h = u & 7; qtok0 = NP + b * 1024 + r * 64; }
  constexpr int NSS = MODE == 0 ? 2 : 6;
  const int c0 = wid * 16;
  int ksc = c0 - 8; ksc = ksc < 0 ? 0 : (ksc > 32 ? 32 : ksc);
  const int rs = (r - 4) < 0 ? 0 : ((r - 4) > 8 ? 8 : (r - 4));
  bf16x8 qf[2];
  {
    const u16* q = p.proj + (size_t)(qtok0 + wid * 16 + fr) * IN_E + 1024 + h * 64 + fq * 8;
    qf[0] = *reinterpret_cast<const bf16x8*>(q);
    qf[1] = *reinterpret_cast<const bf16x8*>(q + 32);
  }
  u32x2 gbv[4];
#pragma unroll
  for (int dt = 0; dt < 4; ++dt)
    gbv[dt] = *reinterpret_cast<const u32x2*>(p.proj + (size_t)(qtok0 + wid * 16 + fr) * IN_E + 2560 + h * 64 + dt * 16 + fq * 4);
  const int cq = c0 + fr;
  int cstart = cq - 8; cstart = cstart < 0 ? 0 : (cstart > 48 ? 48 : cstart);
  float mrun = -1e30f, lrun = 0.f;
  f32x4 o[4] = {};
  const float scale = 0.125f;
  const int krow = tid >> 3, kchunk = tid & 7;
  const int vkey = tid & 127, vdh = tid >> 7;
  u32x4 kr[4], vr[4];
  auto prefetch = [&](int ss) {
    const u16* kb; const u16* vb; int ld;
    if (MODE == 0) { kb = p.proj + (size_t)(b * 256 + ss * 128) * IN_E + 1536 + h * 64; vb = kb + 512; ld = IN_E; }
    else if (ss < 4) { kb = p.proj + (size_t)(NP + b * 1024 + (rs + ss * 2) * 64) * IN_E + 1536 + h * 64; vb = kb + 512; ld = IN_E; }
    else { kb = p.kcb + ((size_t)(b * 8 + h) * 256 + (ss - 4) * 128) * 64; vb = p.vcb + ((size_t)(b * 8 + h) * 256 + (ss - 4) * 128) * 64; ld = 64; }
#pragma unroll
    for (int i = 0; i < 4; ++i) kr[i] = *reinterpret_cast<const u32x4*>(kb + (size_t)(krow + 32 * i) * ld + kchunk * 8);
#pragma unroll
    for (int i = 0; i < 4; ++i) vr[i] = *reinterpret_cast<const u32x4*>(vb + (size_t)vkey * ld + vdh * 32 + i * 8);
  };
  prefetch(0);
  if (MODE == 1) {
    __syncthreads();
    for (int i = tid; i < 15 * 31; i += NTHR) rpl[i] = p.rpb[h * 465 + i];
  }
#pragma unroll 1
  for (int ss = 0; ss < NSS; ++ss) {
    const bool local = (MODE == 1 && ss < 4);
    __syncthreads();
#pragma unroll
    for (int i = 0; i < 4; ++i) {
      const int row = krow + 32 * i;
      *reinterpret_cast<u32x4*>(Ks + row * 128 + ((kchunk ^ ((row >> 1) & 7)) << 4)) = kr[i];
    }
    {
      u16* vt = Vt + (vkey >> 6) * 4608 + (vdh * 32) * 72 + (vkey & 63);
#pragma unroll
      for (int i = 0; i < 4; ++i) {
        const unsigned w[4] = {vr[i].x, vr[i].y, vr[i].z, vr[i].w};
#pragma unroll
        for (int j = 0; j < 4; ++j) {
          vt[(i * 8 + 2 * j) * 72] = (u16)(w[j] & 0xffff);
          vt[(i * 8 + 2 * j + 1) * 72] = (u16)(w[j] >> 16);
        }
      }
    }
    if (ss + 1 < NSS) prefetch(ss + 1);
    __syncthreads();
#pragma unroll
    for (int s2 = 0; s2 < 2; ++s2) {
      const u16* Vs = Vt + s2 * 4608;
      const int nchunk = local ? 1 : 2;
      const int kbase = local ? ksc : 0;
      const float* rp = rpl + (rs + ss * 2 + s2 - r + 7) * 31 + 15 - cq;
      for (int ch = 0; ch < nchunk; ++ch) {
        f32x4 sv[2];
#pragma unroll
        for (int t2 = 0; t2 < 2; ++t2) {
          const int koff = kbase + ch * 32 + t2 * 16;
          const int row = s2 * 64 + koff + fr;
          const int sw = (row >> 1) & 7;
          const bf16x8 kf0 = *reinterpret_cast<const bf16x8*>(Ks + row * 128 + ((fq ^ sw) << 4));
          const bf16x8 kf1 = *reinterpret_cast<const bf16x8*>(Ks + row * 128 + (((4 + fq) ^ sw) << 4));
          f32x4 z = {0.f, 0.f, 0.f, 0.f};
          z = __builtin_amdgcn_mfma_f32_16x16x32_bf16(kf0, qf[0], z, 0, 0, 0);
          z = __builtin_amdgcn_mfma_f32_16x16x32_bf16(kf1, qf[1], z, 0, 0, 0);
          if (local) {
#pragma unroll
            for (int j = 0; j < 4; ++j) {
              const int ck = koff + fq * 4 + j;
              int dcl = ck - cq; dcl = dcl < -15 ? -15 : (dcl > 15 ? 15 : dcl);
              const float bias = rp[dcl + cq];
              const bool ok = (ck >= cstart) && (ck < cstart + 16);
              z[j] = ok ? z[j] * scale + bias : -1e30f;
            }
          } else {
#pragma unroll
            for (int j = 0; j < 4; ++j) z[j] *= scale;
          }
          sv[t2] = z;
        }
        float mx = fmaxf(fmaxf(fmaxf(sv[0][0], sv[0][1]), fmaxf(sv[0][2], sv[0][3])), fmaxf(fmaxf(sv[1][0], sv[1][1]), fmaxf(sv[1][2], sv[1][3])));
        mx = fmaxf(mx, __shfl_xor(mx, 16));
        mx = fmaxf(mx, __shfl_xor(mx, 32));
        const float mnew = fmaxf(mrun, mx);
        const float corr = __expf(mrun - mnew);
        mrun = mnew;
        float pv[8];
        float psum = 0.f;
#pragma unroll
        for (int j = 0; j < 4; ++j) { pv[j] = __expf(sv[0][j] - mnew); pv[4 + j] = __expf(sv[1][j] - mnew); }
#pragma unroll
        for (int j = 0; j < 8; ++j) psum += pv[j];
        lrun = lrun * corr + psum;
        u32x4 pk;
        pk.x = pack2(pv[0], pv[1]); pk.y = pack2(pv[2], pv[3]); pk.z = pack2(pv[4], pv[5]); pk.w = pack2(pv[6], pv[7]);
        const bf16x8 pfrag = __builtin_bit_cast(bf16x8, pk);
        const int k0 = kbase + ch * 32;
#pragma unroll
        for (int dt = 0; dt < 4; ++dt) {
          const u16* vp = Vs + (dt * 16 + fr) * 72 + k0 + fq * 4;
          u32x2 v0 = *reinterpret_cast<const u32x2*>(vp);
          u32x2 v1 = *reinterpret_cast<const u32x2*>(vp + 16);
          u32x4 vv; vv.x = v0.x; vv.y = v0.y; vv.z = v1.x; vv.w = v1.y;
          f32x4 oo = o[dt];
          oo[0] *= corr; oo[1] *= corr; oo[2] *= corr; oo[3] *= corr;
          o[dt] = __builtin_amdgcn_mfma_f32_16x16x32_bf16(__builtin_bit_cast(bf16x8, vv), pfrag, oo, 0, 0, 0);
        }
      }
    }
  }
  lrun += __shfl_xor(lrun, 16);
  lrun += __shfl_xor(lrun, 32);
  const float linv = 1.f / lrun;
  const int tok = qtok0 + wid * 16 + fr;
#pragma unroll
  for (int dt = 0; dt < 4; ++dt) {
    const int dd = h * 64 + dt * 16 + fq * 4;
    const u32x2 gb = gbv[dt];
    float r0 = o[dt][0] * linv * bflo(gb.x);
    float r1 = o[dt][1] * linv * bfhi(gb.x);
    float r2 = o[dt][2] * linv * bflo(gb.y);
    float r3 = o[dt][3] * linv * bfhi(gb.y);
    u32x2 ov; ov.x = pack2(r0, r1); ov.y = pack2(r2, r3);
    *reinterpret_cast<u32x2*>(p.cat + (size_t)tok * D + 512 + dd) = ov;
  }
}

template <int G>
__device__ void pool_unit(const P& p, int tile, char* smem) {
  constexpr int HALF = 1 << G;
  constexpr int NR = 64 + 2 * HALF;
  int tid = threadIdx.x;
  asm volatile("" : "+v"(tid));
  const int wid = tid >> 6, lane = tid & 63, fr = lane & 15, fq = lane >> 4;
  char* U = smem;
  char* W = smem + 80 * 272;
  const int T0 = tile * 64;
  int sb, se;
  if (T0 < NP) { sb = T0 & ~255; se = sb + 256; } else { sb = NP + ((T0 - NP) & ~1023); se = sb + 1024; }
  __syncthreads();
  {
    constexpr int NIT = (NR * 16 + NTHR - 1) / NTHR;
    u32x4 sv[NIT];
#pragma unroll
    for (int i = 0; i < NIT; ++i) {
      const int c = tid + i * NTHR, rr = c >> 4, c16 = c & 15;
      int tt = T0 - HALF + rr; tt = tt < sb ? sb : (tt >= se ? se - 1 : tt);
      sv[i] = *reinterpret_cast<const u32x4*>(p.proj + (size_t)tt * IN_E + G * 128 + c16 * 8);
    }
#pragma unroll
    for (int i = 0; i < NIT; ++i) {
      const int c = tid + i * NTHR, rr = c >> 4, c16 = c & 15;
      if (c < NR * 16) *reinterpret_cast<u32x4*>(U + rr * 272 + c16 * 16) = sv[i];
    }
  }
#pragma unroll
  for (int i = 0; i < 8; ++i) {
    const int c = tid + i * NTHR, rr = c >> 4, c16 = c & 15;
    *reinterpret_cast<u32x4*>(W + rr * 272 + c16 * 16) = *reinterpret_cast<const u32x4*>(p.wpt + (size_t)G * 16384 + rr * 128 + c16 * 8);
  }
  __syncthreads();
  const int t = T0 + wid * 16 + fr;
  int lo = t - HALF; lo = lo < sb ? sb : lo;
  int hi = t + HALF; hi = hi > se ? se : hi;
  const float inv = 1.f / (float)(hi - lo);
  f32x4 acc[8] = {};
#pragma unroll 1
  for (int ks = 0; ks < 4; ++ks) {
    const char* ub = U + (wid * 16 + fr) * 272 + (ks * 4 + fq) * 16;
    float sum[8] = {};
#pragma unroll
    for (int i = 0; i < 2 * HALF; ++i) {
      const int tt = t - HALF + i;
      const float m = (tt >= lo && tt < hi) ? 1.f : 0.f;
      const u32x4 w2 = *reinterpret_cast<const u32x4*>(ub + i * 272);
      sum[0] += m * bflo(w2.x); sum[1] += m * bfhi(w2.x); sum[2] += m * bflo(w2.y); sum[3] += m * bfhi(w2.y);
      sum[4] += m * bflo(w2.z); sum[5] += m * bfhi(w2.z); sum[6] += m * bflo(w2.w); sum[7] += m * bfhi(w2.w);
    }
    const u32x4 w = *reinterpret_cast<const u32x4*>(ub + HALF * 272);
    const float uu[8] = {bflo(w.x), bfhi(w.x), bflo(w.y), bfhi(w.y), bflo(w.z), bfhi(w.z), bflo(w.w), bfhi(w.w)};
    u32x4 pk;
    pk.x = pack2(sum[0] * inv - uu[0], sum[1] * inv - uu[1]);
    pk.y = pack2(sum[2] * inv - uu[2], sum[3] * inv - uu[3]);
    pk.z = pack2(sum[4] * inv - uu[4], sum[5] * inv - uu[5]);
    pk.w = pack2(sum[6] * inv - uu[6], sum[7] * inv - uu[7]);
    const bf16x8 af = __builtin_bit_cast(bf16x8, pk);
#pragma unroll
    for (int n = 0; n < 8; ++n) {
      const bf16x8 bfr = *reinterpret_cast<const bf16x8*>(W + (n * 16 + fr) * 272 + (ks * 4 + fq) * 16);
      acc[n] = __builtin_amdgcn_mfma_f32_16x16x32_bf16(bfr, af, acc[n], 0, 0, 0);
    }
  }
#pragma unroll
  for (int n = 0; n < 8; ++n) {
    const int dd = G * 128 + n * 16 + fq * 4;
    const float4 ps = *reinterpret_cast<const float4*>(p.pool_scale + dd);
    const u32x2 ga = *reinterpret_cast<const u32x2*>(p.proj + (size_t)t * IN_E + 512 + dd);
    u32x2 ov;
    ov.x = pack2(acc[n][0] * ps.x * bflo(ga.x), acc[n][1] * ps.y * bfhi(ga.x));
    ov.y = pack2(acc[n][2] * ps.z * bflo(ga.y), acc[n][3] * ps.w * bfhi(ga.y));
    *reinterpret_cast<u32x2*>(p.cat + (size_t)t * D + dd) = ov;
  }
}

__device__ void phase_even_mix(const P& p, char* smem) {
  if (gridDim.x == 512) {
    const int bx = blockIdx.x;
    if (bx < 256) {
      attn_unit<1>(p, bx, smem);
      const int q = bx, g = q & 3, tile = q >> 2;
      if (g == 0) pool_unit<0>(p, tile, smem); else if (g == 1) pool_unit<1>(p, tile, smem); else if (g == 2) pool_unit<2>(p, tile, smem); else pool_unit<3>(p, tile, smem);
    } else {
      attn_unit<0>(p, (bx - 256) * 2, smem);
      attn_unit<0>(p, (bx - 256) * 2 + 1, smem);
      if (bx < 384) {
        const int q = bx, g = q & 3, tile = q >> 2;
        if (g == 0) pool_unit<0>(p, tile, smem); else if (g == 1) pool_unit<1>(p, tile, smem); else if (g == 2) pool_unit<2>(p, tile, smem); else pool_unit<3>(p, tile, smem);
      }
    }
    return;
  }
  constexpr int U_N = 256, U_C = 512, U_P = 384;
  for (int u = blockIdx.x; u < U_N + U_C + U_P; u += gridDim.x) {
    if (u < U_N) attn_unit<1>(p, u, smem);
    else if (u < U_N + U_C) attn_unit<0>(p, u - U_N, smem);
    else {
      const int q = u - U_N - U_C, g = q & 3, tile = q >> 2;
      if (g == 0) pool_unit<0>(p, tile, smem); else if (g == 1) pool_unit<1>(p, tile, smem); else if (g == 2) pool_unit<2>(p, tile, smem); else pool_unit<3>(p, tile, smem);
    }
  }
}

__device__ void odd_unit(const P& p, int u, char* smem) {
  int tid = threadIdx.x;
  asm volatile("" : "+v"(tid));
  const int lane = tid & 63, wid = tid >> 6;
  u16* G = reinterpret_cast<u16*>(smem);
  float* red = reinterpret_cast<float*>(smem + 46 * 1024);
  const int t0 = u * 16;
  int sb, se;
  if (t0 < NP) { sb = t0 & ~255; se = sb + 256; } else { sb = NP + ((t0 - NP) & ~1023); se = sb + 1024; }
  const int ch = tid * 2;
  u32x4 sv[12];
#pragma unroll
  for (int i = 0; i < 12; ++i) {
    const int c = tid + i * NTHR, rr = c >> 6, c16 = c & 63;
    const int tt = t0 - 15 + rr;
    sv[i] = u32x4{0u, 0u, 0u, 0u};
    if (c < 46 * 64 && tt >= sb && tt < se) sv[i] = *reinterpret_cast<const u32x4*>(p.proj + (size_t)tt * 2048 + 1024 + c16 * 8);
  }
  unsigned cxw[18], bww[16], gdw[16];
#pragma unroll
  for (int q = 0; q < 18; ++q) {
    const int tt = t0 + q - 1;
    cxw[q] = 0u;
    if (tt >= sb && tt < se) cxw[q] = *reinterpret_cast<const unsigned*>(p.proj + (size_t)tt * 2048 + 512 + ch);
  }
#pragma unroll
  for (int i = 0; i < 16; ++i) {
    bww[i] = *reinterpret_cast<const unsigned*>(p.proj + (size_t)(t0 + i) * 2048 + ch);
    gdw[i] = *reinterpret_cast<const unsigned*>(p.proj + (size_t)(t0 + i) * 2048 + 1536 + ch);
  }
  float2 w[31];
#pragma unroll
  for (int j = 0; j < 31; ++j) w[j] = *reinterpret_cast<const float2*>(p.conv_d + j * 512 + ch);
  const float2 bias = *reinterpret_cast<const float2*>(p.conv_d_b + ch);
  const float2 lg = *reinterpret_cast<const float2*>(p.ln_g + ch);
  const float2 lb = *reinterpret_cast<const float2*>(p.ln_b + ch);
  const float2 wc0 = *reinterpret_cast<const float2*>(p.conv_c + ch);
  const float2 wc1 = *reinterpret_cast<const float2*>(p.conv_c + 512 + ch);
  const float2 wc2 = *reinterpret_cast<const float2*>(p.conv_c + 1024 + ch);
  __syncthreads();
#pragma unroll
  for (int i = 0; i < 12; ++i) {
    const int c = tid + i * NTHR, rr = c >> 6, c16 = c & 63;
    if (c < 46 * 64) *reinterpret_cast<u32x4*>(G + rr * 512 + c16 * 8) = sv[i];
  }
#pragma unroll
  for (int i = 0; i < 16; ++i) {
    const int tok = t0 + i;
    const float c0 = bflo(bww[i]) * (wc0.x * bflo(cxw[i]) + wc1.x * bflo(cxw[i + 1]) + wc2.x * bflo(cxw[i + 2]));
    const float c1 = bfhi(bww[i]) * (wc0.y * bfhi(cxw[i]) + wc1.y * bfhi(cxw[i + 1]) + wc2.y * bfhi(cxw[i + 2]));
    *reinterpret_cast<unsigned*>(p.cat + (size_t)tok * D + ch) = pack2(c0, c1);
  }
  __syncthreads();
#pragma unroll
  for (int hf = 0; hf < 2; ++hf) {
    float2 z[8];
#pragma unroll
    for (int i = 0; i < 8; ++i) z[i] = bias;
    const u16* Gh = G + hf * 8 * 512 + ch;
#pragma unroll
    for (int r = 0; r < 38; ++r) {
      const unsigned gv = *reinterpret_cast<const unsigned*>(Gh + r * 512);
      const float g0 = bflo(gv), g1 = bfhi(gv);
#pragma unroll
      for (int i = 0; i < 8; ++i) {
        const int j = r - i;
        if (j >= 0 && j <= 30) { z[i].x += w[j].x * g0; z[i].y += w[j].y * g1; }
      }
    }
    float* rd = red + hf * 64;
#pragma unroll
    for (int i = 0; i < 8; ++i) {
      const float sv2 = wave_sum(z[i].x + z[i].y);
      if (lane == 0) rd[wid * 8 + i] = sv2;
    }
    __syncthreads();
    float mu[8];
#pragma unroll
    for (int i = 0; i < 8; ++i) mu[i] = (rd[i] + rd[8 + i] + rd[16 + i] + rd[24 + i]) * (1.f / 512.f);
#pragma unroll
    for (int i = 0; i < 8; ++i) {
      const float d0 = z[i].x - mu[i], d1 = z[i].y - mu[i];
      const float sv2 = wave_sum(d0 * d0 + d1 * d1);
      if (lane == 0) rd[32 + wid * 8 + i] = sv2;
    }
    __syncthreads();
#pragma unroll
    for (int i = 0; i < 8; ++i) {
      const float rstd = rsqrtf((rd[32 + i] + rd[40 + i] + rd[48 + i] + rd[56 + i]) * (1.f / 512.f) + 1e-6f);
      const int tok = t0 + hf * 8 + i;
      const unsigned gd = gdw[hf * 8 + i];
      const float l0 = (z[i].x - mu[i]) * rstd * lg.x + lb.x;
      const float l1 = (z[i].y - mu[i]) * rstd * lg.y + lb.y;
      *reinterpret_cast<unsigned*>(p.cat + (size_t)tok * D + 512 + ch) = pack2(silu_f(l0) * bflo(gd), silu_f(l1) * bfhi(gd));
    }
  }
}

__device__ void phase_odd_mix(const P& p, char* smem) {
  if ((gridDim.x & 7) == 0) {
    const int xcd = blockIdx.x & 7, gl = gridDim.x >> 3;
    for (int j = blockIdx.x >> 3; j < 48; j += gl) odd_unit(p, xcd * 48 + j, smem);
    return;
  }
  for (int u = blockIdx.x; u < NTOK / 16; u += gridDim.x) odd_unit(p, u, smem);
}

__device__ void phase_final(const P& p) {
  const int lane = threadIdx.x & 63, wid = threadIdx.x >> 6;
  const bool xpart = (gridDim.x & 7) == 0;
  const int nrow = xpart ? 768 : NTOK, rstep = xpart ? (int)(gridDim.x >> 3) * 4 : (int)gridDim.x * 4;
  for (int rr = (xpart ? (int)(blockIdx.x >> 3) : (int)blockIdx.x) * 4 + wid; rr < nrow; rr += rstep) {
    const int tok = xpart ? (int)(blockIdx.x & 7) * 768 + rr : rr;
    const float* x = p.x1 + (size_t)tok * D;
    float4 v[4];
    float ss = 0.f;
#pragma unroll
    for (int i = 0; i < 4; ++i) {
      v[i] = *reinterpret_cast<const float4*>(x + i * 256 + lane * 4);
      ss += v[i].x * v[i].x + v[i].y * v[i].y + v[i].z * v[i].z + v[i].w * v[i].w;
    }
    ss = wave_sum(ss);
    const float rinv = rsqrtf(ss * (1.f / 1024.f) + 1e-6f);
#pragma unroll
    for (int i = 0; i < 4; ++i) {
      const int k = i * 256 + lane * 4;
      float4 gg = *reinterpret_cast<const float4*>(p.final_g + k);
      float4 o = make_float4(v[i].x * rinv * gg.x, v[i].y * rinv * gg.y, v[i].z * rinv * gg.z, v[i].w * rinv * gg.w);
      *reinterpret_cast<float4*>(p.out + (size_t)tok * D + k) = o;
    }
  }
}

#define XB_TMO      128
#define XB_XCNT(j)  (256  + 64 * (j))
#define XB_XSUB(j)  (1280 + 64 * (j))
#define XB_XGEN(j)  (2304 + 64 * (j))
#define XB_TOP      3328
#define XB_TOPGEN   3392
#define XCD_BAR_WORDS 3456
#define XB_SPIN_CAP (1u << 18)
#define LAS __attribute__((address_space(3)))

__device__ __forceinline__ unsigned xb_ld(unsigned* p)              { return __hip_atomic_load(p, __ATOMIC_RELAXED, __HIP_MEMORY_SCOPE_AGENT); }
__device__ __forceinline__ unsigned xb_add(unsigned* p, unsigned v) { return __hip_atomic_fetch_add(p, v, __ATOMIC_RELAXED, __HIP_MEMORY_SCOPE_AGENT); }
__device__ __forceinline__ unsigned xb_xcc_id() { return (unsigned)__builtin_amdgcn_s_getreg((3 << 11) | 20) & 0xFu; }
#define XB_SPIN(cond, bar) do { unsigned _sp = 0; while (cond) { __builtin_amdgcn_s_sleep(1); \
    if ((++_sp & 255u) == 0u) { if (xb_ld(&(bar)[XB_TMO])) break; if (_sp > XB_SPIN_CAP) { atomicAdd(&(bar)[XB_TMO], 1u); break; } } } } while (0)

struct XcdBarrier {
    unsigned* bar; unsigned x;
    unsigned nloc, nx;
    volatile unsigned* st;
};

__device__ __forceinline__ XcdBarrier xcd_barrier_post(unsigned* bar, volatile unsigned* st) {
    XcdBarrier b; b.bar = bar; b.x = xb_xcc_id(); b.st = st; b.nloc = 0u; b.nx = 0u;
    if (threadIdx.x == 0) (void)xb_add(&bar[XB_XCNT(b.x)], 1u);
    return b;
}
__device__ __forceinline__ void xcd_barrier_complete(unsigned* bar, unsigned x, unsigned& nloc, unsigned& nx) {
    const unsigned G = gridDim.x * gridDim.y * gridDim.z;
    unsigned sum, cnt, mine, sp = 0u;
    for (;;) {
        sum = 0u; cnt = 0u; mine = 0u;
#pragma unroll
        for (unsigned j = 0; j < 16; ++j) { const unsigned c = xb_ld(&bar[XB_XCNT(j)]); sum += c; cnt += (c > 0u) ? 1u : 0u; mine = (j == x) ? c : mine; }
        if (sum == G) break;
        __builtin_amdgcn_s_sleep(1);
        if ((++sp & 255u) == 0u) { if (xb_ld(&bar[XB_TMO])) break; if (sp > XB_SPIN_CAP) { atomicAdd(&bar[XB_TMO], 1u); break; } }
    }
    nloc = mine > 0u ? mine : 1u; nx = cnt > 0u ? cnt : 1u;
}

__device__ __forceinline__ void xcd_barrier(XcdBarrier& b) {
    asm volatile("s_waitcnt vmcnt(0)" ::: "memory");
    __syncthreads();
    if (threadIdx.x == 0) {
        unsigned* bar = b.bar;
        __builtin_amdgcn_s_waitcnt(0);
        unsigned nloc = b.nloc, nx = b.nx;
        if (nloc == 0u) { xcd_barrier_complete(bar, b.x, nloc, nx); b.nloc = nloc; b.nx = nx; }
        const unsigned old = xb_add(&bar[XB_XSUB(b.x)], 1u);
        const unsigned gen = old / nloc;
        if (old + 1u == (gen + 1u) * nloc) {
            __builtin_amdgcn_fence(__ATOMIC_RELEASE, "agent");
            asm volatile("s_waitcnt vmcnt(0)" ::: "memory");
            const unsigned og = xb_add(&bar[XB_TOP], 1u);
            const unsigned tg = og / nx;
            if (og + 1u == (tg + 1u) * nx) xb_add(&bar[XB_TOPGEN], 1u);
            else XB_SPIN(xb_ld(&bar[XB_TOPGEN]) == tg, bar);
            __builtin_amdgcn_fence(__ATOMIC_ACQUIRE, "agent");
            xb_add(&bar[XB_XGEN(b.x)], 1u);
            asm volatile("s_waitcnt vmcnt(0)" ::: "memory");
        } else {
            XB_SPIN(xb_ld(&bar[XB_XGEN(b.x)]) == gen, bar);
            __builtin_amdgcn_fence(__ATOMIC_ACQUIRE, "agent");
            asm volatile("s_waitcnt vmcnt(0)" ::: "memory");
        }
    }
    __syncthreads();
}


template <int PH>
__device__ __forceinline__ void run_phase(const P& p, char* smem) {
  if (PH == 0) phase0(p, smem);
  if (PH == 1) phase_norm(p, 0, p.x_prompt, p.x_sample);
  if (PH == 2) gemm_phase<0, 128>(p, p.h, p.wt_in_even, IN_E, smem);
  if (PH == 3) phase_even_mix(p, smem);
  if (PH == 4) gemm_phase<1, 96>(p, p.cat, p.wt_out_even, D, smem);
  if (PH == 6) gemm_phase<2, 128>(p, p.h, p.wt_in_odd, IN_O, smem);
  if (PH == 7) phase_odd_mix(p, smem);
  if (PH == 8) gemm_phase<3, 96>(p, p.cat, p.wt_out_odd, D, smem);
  if (PH == 9) phase_final(p);
}

__global__ void __launch_bounds__(NTHR, 2) mega_kernel(P p) {
  __shared__ __attribute__((aligned(16))) char smem[SMEM_BYTES];
  cg::grid_group grid = cg::this_grid();
  XcdBarrier xb = xcd_barrier_post(p.bar, (volatile unsigned*)(p.bar + XCD_BAR_WORDS + 64 * blockIdx.x));
  if (p.use_cg) grid.sync();
#define RUNP(PH) do { run_phase<PH>(p, smem); if ((PROBE_REPEAT >> PH) & 1) { xcd_barrier(xb); run_phase<PH>(p, smem); } } while (0)
#define GSYNC() do { xcd_barrier(xb); if (PROBE_SYNC2) xcd_barrier(xb); } while (0)
  RUNP(0); GSYNC();
  RUNP(1); GSYNC();
  RUNP(2); GSYNC();
  RUNP(3); GSYNC();
  RUNP(4); GSYNC();
  RUNP(6); GSYNC();
  RUNP(7); GSYNC();
  run_phase<8>(p, smem); GSYNC();
  RUNP(9);
}

template <int PH>
__global__ void __launch_bounds__(NTHR, 2) phase_kernel(P p) {
  __shared__ __attribute__((aligned(16))) char smem[SMEM_BYTES];
  run_phase<PH>(p, smem);
}

constexpr int BAR_TOTAL_WORDS = XCD_BAR_WORDS + 64 * 2048;
static inline size_t align_up(size_t x) { return (x + 255) & ~(size_t)255; }

extern "C" void kernel_launch(void* const* d_in, const int* in_sizes, int n_in, void* d_out, int out_size, void* d_ws,
                              size_t ws_size, hipStream_t stream) {
  P p{};
  const float** f = reinterpret_cast<const float**>(&p);
  for (int i = 0; i < 22; ++i) f[i] = (const float*)d_in[i];
  p.out = (float*)d_out;
  char* w = (char*)d_ws;
  size_t off = 0;
  p.mod = (float*)(w + off); off = align_up(off + (size_t)2 * 3 * 3072 * 4);
  p.wt_in_even = (u16*)(w + off); off = align_up(off + (size_t)IN_E * D * 2);
  p.wt_out_even = (u16*)(w + off); off = align_up(off + (size_t)D * D * 2);
  p.wt_in_odd = (u16*)(w + off); off = align_up(off + (size_t)IN_O * D * 2);
  p.wt_out_odd = (u16*)(w + off); off = align_up(off + (size_t)D * D * 2);
  p.wpt = (u16*)(w + off); off = align_up(off + (size_t)4 * 128 * 128 * 2);
  p.h = (u16*)(w + off); off = align_up(off + (size_t)NTOK * D * 2);
  p.proj = (u16*)(w + off); off = align_up(off + (size_t)NTOK * IN_O * 2);
  p.cat = (u16*)(w + off); off = align_up(off + (size_t)NTOK * D * 2);
  p.x1 = (float*)(w + off); off = align_up(off + (size_t)NTOK * D * 4);
  p.kcb = (u16*)(w + off); off = align_up(off + (size_t)262144 * 2);
  p.vcb = (u16*)(w + off); off = align_up(off + (size_t)262144 * 2);
  p.rowss = (float*)(w + off); off = align_up(off + (size_t)NTOK * 16 * 4);
  p.bias1 = (float*)(w + off); off = align_up(off + (size_t)3 * IN_O * 4);
  p.bar = (unsigned*)(w + off); off = align_up(off + (size_t)BAR_TOTAL_WORDS * 4);
  p.use_cg = 0ull;

#if MULTI_LAUNCH
  const int G = 1024;
  phase_kernel<0><<<G, NTHR, 0, stream>>>(p);
  phase_kernel<1><<<G, NTHR, 0, stream>>>(p);
  phase_kernel<2><<<G, NTHR, 0, stream>>>(p);
  phase_kernel<3><<<G, NTHR, 0, stream>>>(p);
  phase_kernel<4><<<G, NTHR, 0, stream>>>(p);
  phase_kernel<6><<<G, NTHR, 0, stream>>>(p);
  phase_kernel<7><<<G, NTHR, 0, stream>>>(p);
  phase_kernel<8><<<G, NTHR, 0, stream>>>(p);
  phase_kernel<9><<<G, NTHR, 0, stream>>>(p);
#else
  static int grid_blocks = 0;
  if (!grid_blocks) {
    int dev = 0, cus = 0, per_cu = 0;
    hipGetDevice(&dev);
    hipDeviceGetAttribute(&cus, hipDeviceAttributeMultiprocessorCount, dev);
    hipOccupancyMaxActiveBlocksPerMultiprocessor(&per_cu, mega_kernel, NTHR, 0);
    if (per_cu < 1) per_cu = 1;
    grid_blocks = cus * per_cu;
  }
  (void)hipMemsetAsync(p.bar, 0, (size_t)BAR_TOTAL_WORDS * 4, stream);
  void* args[] = {&p};
  hipError_t e = hipLaunchCooperativeKernel((void*)mega_kernel, dim3(grid_blocks), dim3(NTHR), args, 0, stream);
  if (e != hipSuccess) fprintf(stderr, "cooperative launch failed: %s (grid %d)\n", hipGetErrorString(e), grid_blocks);
#endif
}
```

```cpp
#include <hip/hip_runtime.h>
#include <hip/hip_cooperative_groups.h>
#include <cstdio>
namespace cg = cooperative_groups;

#define PROBE_REPEAT 0x00
#define PROBE_SYNC2 0
#ifndef MULTI_LAUNCH
#define MULTI_LAUNCH 0
#endif

typedef unsigned short u16;
using bf16x8 = __attribute__((ext_vector_type(8))) short;
using f32x4 = __attribute__((ext_vector_type(4))) float;
using u32x4 = __attribute__((ext_vector_type(4))) unsigned;
using u32x2 = __attribute__((ext_vector_type(2))) unsigned;

constexpr int D = 1024;
constexpr int NP = 4096;
constexpr int NS = 2048;
constexpr int NTOK = NP + NS;
constexpr int IN_E = 3072;
constexpr int IN_O = 3584;
constexpr int NTHR = 256;
constexpr int SMEM_BYTES = 64 * 1024;

struct P {
  const float *x_prompt, *x_sample, *cache_k, *cache_v, *c, *c_ctx, *norm_g, *w_mod, *b_mod, *w_in_even, *w_pool,
      *pool_scale, *rpb, *w_out_even, *w_in_odd, *conv_c, *conv_d, *conv_d_b, *ln_g, *ln_b, *w_out_odd, *final_g;
  float* out;
  float* mod;
  u16 *wt_in_even, *wt_out_even, *wt_in_odd, *wt_out_odd, *wpt;
  u16 *h, *proj, *cat;
  u16 *kcb, *vcb;
  float *rowss;
  float *bias1;
  float* x1;
  unsigned* bar;
  unsigned long long use_cg;
};

typedef __bf16 hbf2 __attribute__((ext_vector_type(2)));
typedef float hf2 __attribute__((ext_vector_type(2)));
__device__ __forceinline__ unsigned pack2(float a, float b) {
  const hf2 v = {a, b};
  return __builtin_bit_cast(unsigned, __builtin_convertvector(v, hbf2));
}
__device__ __forceinline__ u16 f2bf(float f) { return (u16)(pack2(f, 0.f) & 0xffffu); }
__device__ __forceinline__ float bf2f(u16 h) { return __uint_as_float(((unsigned)h) << 16); }
__device__ __forceinline__ float bflo(unsigned u) { return __uint_as_float(u << 16); }
__device__ __forceinline__ float bfhi(unsigned u) { return __uint_as_float(u & 0xffff0000u); }
__device__ __forceinline__ float silu_f(float x) { return x * __builtin_amdgcn_rcpf(1.f + __expf(-x)); }
__device__ __forceinline__ float sigmoid_f(float x) { return __builtin_amdgcn_rcpf(1.f + __expf(-x)); }
__device__ __forceinline__ float wave_sum(float v) {
#pragma unroll
  for (int o = 32; o >= 1; o >>= 1) v += __shfl_xor(v, o);
  return v;
}
__device__ __forceinline__ int cond_of_token(int tok) { return tok < NP ? 0 : 1 + ((tok - NP) >> 10); }

__device__ void mod_unit(const P& p, int u, float* sm) {
  const int layer = u / 96, cg32 = u % 96;
  const int tid = threadIdx.x;
  float* sc = sm;
  float* red = sm + 3 * 1024;
  __syncthreads();
#pragma unroll
  for (int q = 0; q < 12; ++q) {
    const int i = tid + q * NTHR;
    const int cv = i >> 10, k = i & 1023;
    const float v = (cv == 0) ? p.c_ctx[k] : p.c[(cv - 1) * 1024 + k];
    sc[i] = silu_f(v);
  }
  __syncthreads();
  const int cq = tid & 7, ks = tid >> 3;
  const float* W = p.w_mod + (size_t)layer * 1024 * 3072 + cg32 * 32 + cq * 4;
  float a[3][4] = {};
#pragma unroll 8
  for (int i = 0; i < 32; ++i) {
    int k = ks * 32 + i;
    using nf4 = __attribute__((ext_vector_type(4))) float;
    const nf4 wq = __builtin_nontemporal_load(reinterpret_cast<const nf4*>(W + (size_t)k * 3072));
    float4 w = make_float4(wq.x, wq.y, wq.z, wq.w);
#pragma unroll
    for (int cv = 0; cv < 3; ++cv) {
      float s = sc[cv * 1024 + k];
      a[cv][0] += s * w.x; a[cv][1] += s * w.y; a[cv][2] += s * w.z; a[cv][3] += s * w.w;
    }
  }
#pragma unroll
  for (int cv = 0; cv < 3; ++cv)
#pragma unroll
    for (int j = 0; j < 4; ++j) {
      float v = a[cv][j];
      v += __shfl_xor(v, 8); v += __shfl_xor(v, 16); v += __shfl_xor(v, 32);
      a[cv][j] = v;
    }
  const int lane = tid & 63, wid = tid >> 6;
  if (lane < 8) {
#pragma unroll
    for (int cv = 0; cv < 3; ++cv)
#pragma unroll
      for (int j = 0; j < 4; ++j) red[wid * 96 + cv * 32 + lane * 4 + j] = a[cv][j];
  }
  __syncthreads();
  if (tid < 96) {
    int cv = tid >> 5, col = tid & 31;
    float v = red[tid] + red[96 + tid] + red[192 + tid] + red[288 + tid];
    int n = cg32 * 32 + col;
    v += p.b_mod[layer * 3072 + n];
    p.mod[(layer * 3 + cv) * 3072 + n] = v;
  }
}

__device__ __forceinline__ int perm_row_general(int s) {
  const int tile = s >> 7, c = s & 127, wc = c >> 6, q = c & 63;
  const int n = ((q >> 5) << 1) | ((q >> 2) & 1), i = (((q >> 3) & 3) << 2) | (q & 3);
  return tile * 128 + wc * 64 + n * 16 + i;
}
__device__ __forceinline__ int perm_row_odd(int s) {
  if (s >= 3072) return perm_row_general(s);
  const int region = s >> 9, ch = s & 511;
  const int type = (region == 0 || region == 3) ? 0 : (region <= 2 ? 1 : 2);
  const int member = (region == 0 || region == 1 || region == 4) ? 0 : 1;
  const int chunk = ch >> 6, wc = (ch >> 5) & 1, cw = ch & 31;
  const int n = member * 2 + ((cw >> 2) & 1), i = ((cw >> 3) << 2) | (cw & 3);
  return (type * 8 + chunk) * 128 + wc * 64 + n * 16 + i;
}
template <int MODE>
__device__ void transpose_tile(const float* __restrict__ src, u16* __restrict__ dst, int K, int N, int t, float* sm) {
  const int tid = threadIdx.x;
  const int ntn = N >> 6;
  const int k0 = (t / ntn) * 64, n0 = (t % ntn) * 64;
  __syncthreads();
  {
    const int r = tid >> 4, c4 = tid & 15;
#pragma unroll
    for (int i = 0; i < 4; ++i) {
      int k = r + 16 * i;
      using nf4 = __attribute__((ext_vector_type(4))) float;
      const nf4 vq = __builtin_nontemporal_load(reinterpret_cast<const nf4*>(src + (size_t)(k0 + k) * N + n0 + c4 * 4));
      float4 v = make_float4(vq.x, vq.y, vq.z, vq.w);
      float* d = sm + k * 65 + c4 * 4;
      d[0] = v.x; d[1] = v.y; d[2] = v.z; d[3] = v.w;
    }
  }
  __syncthreads();
  {
    const int kc = tid & 7, nl = tid >> 3;
#pragma unroll
    for (int i = 0; i < 2; ++i) {
      int n = nl + 32 * i;
      float v[8];
#pragma unroll
      for (int j = 0; j < 8; ++j) v[j] = sm[(kc * 8 + j) * 65 + n];
      u32x4 o;
      o.x = pack2(v[0], v[1]); o.y = pack2(v[2], v[3]); o.z = pack2(v[4], v[5]); o.w = pack2(v[6], v[7]);
      const int drow = MODE == 0 ? (n0 + n) : (MODE == 1 ? perm_row_general(n0 + n) : perm_row_odd(n0 + n));
      *reinterpret_cast<u32x4*>(dst + (size_t)drow * K + k0 + kc * 8) = o;
    }
  }
}

__device__ void phase0(const P& p, char* smem) {
  float* sm = reinterpret_cast<float*>(smem);
  constexpr int T0 = 192, T1 = T0 + 768, T2 = T1 + 256, T3 = T2 + 896, T4 = T3 + 256, T5 = T4 + 16;
  for (int u = blockIdx.x; u < T5; u += gridDim.x) {
    if (u < T0) mod_unit(p, u, sm);
    else if (u < T1) transpose_tile<1>(p.w_in_even, p.wt_in_even, 1024, 3072, u - T0, sm);
    else if (u < T2) transpose_tile<1>(p.w_out_even, p.wt_out_even, 1024, 1024, u - T1, sm);
    else if (u < T3) transpose_tile<2>(p.w_in_odd, p.wt_in_odd, 1024, 3584, u - T2, sm);
    else if (u < T4) transpose_tile<1>(p.w_out_odd, p.wt_out_odd, 1024, 1024, u - T3, sm);
    else { int t = u - T4; int g = t >> 2; transpose_tile<0>(p.w_pool + g * 16384, p.wpt + g * 16384, 128, 128, t & 3, sm); }
  }
}

__device__ void phase_norm(const P& p, int layer, const float* xa, const float* xb) {
  const int lane = threadIdx.x & 63, wid = threadIdx.x >> 6;
  if (layer == 0) {
    for (int prow = blockIdx.x * 4 + wid; prow < IN_O; prow += gridDim.x * 4) {
      const u16* wrow = p.wt_in_odd + (size_t)prow * D + lane * 16;
      const u32x4 w0 = *reinterpret_cast<const u32x4*>(wrow), w1 = *reinterpret_cast<const u32x4*>(wrow + 8);
      const float wf[16] = {bflo(w0.x), bfhi(w0.x), bflo(w0.y), bfhi(w0.y), bflo(w0.z), bfhi(w0.z), bflo(w0.w), bfhi(w0.w),
                            bflo(w1.x), bfhi(w1.x), bflo(w1.y), bfhi(w1.y), bflo(w1.z), bfhi(w1.z), bflo(w1.w), bfhi(w1.w)};
#pragma unroll
      for (int cv = 0; cv < 3; ++cv) {
        const float* sh = p.mod + (size_t)(3 + cv) * 3072 + lane * 16;
        float a = 0.f;
#pragma unroll
        for (int q = 0; q < 4; ++q) {
          const float4 s4 = *reinterpret_cast<const float4*>(sh + q * 4);
          a += s4.x * wf[q * 4] + s4.y * wf[q * 4 + 1] + s4.z * wf[q * 4 + 2] + s4.w * wf[q * 4 + 3];
        }
        a = wave_sum(a);
        if (lane == 0) p.bias1[cv * IN_O + prow] = a;
      }
    }
    for (int i = blockIdx.x * NTHR + threadIdx.x; i < 2 * 32768; i += gridDim.x * NTHR) {
      const float* src = (i < 32768 ? p.cache_k : p.cache_v) + (size_t)(i & 32767) * 8;
      u16* dst = (i < 32768 ? p.kcb : p.vcb) + (size_t)(i & 32767) * 8;
      const float4 a = *reinterpret_cast<const float4*>(src), c = *reinterpret_cast<const float4*>(src + 4);
      u32x4 o; o.x = pack2(a.x, a.y); o.y = pack2(a.z, a.w); o.z = pack2(c.x, c.y); o.w = pack2(c.z, c.w);
      *reinterpret_cast<u32x4*>(dst) = o;
    }
  }
  const float* g = p.norm_g + layer * 1024;
  const bool xpart = (gridDim.x & 7) == 0;
  const int nrow = xpart ? 768 : NTOK, rstep = xpart ? (int)(gridDim.x >> 3) * 4 : (int)gridDim.x * 4;
  for (int rr = (xpart ? (int)(blockIdx.x >> 3) : (int)blockIdx.x) * 4 + wid; rr < nrow; rr += rstep) {
    const int tok = xpart ? (int)(blockIdx.x & 7) * 768 + rr : rr;
    const float* x = tok < NP ? xa + (size_t)tok * D : xb + (size_t)(tok - NP) * D;
    const float* m = p.mod + (size_t)(layer * 3 + cond_of_token(tok)) * 3072;
    float4 v[4], ggv[4], shv[4], scv[4];
    float ss = 0.f;
#pragma unroll
    for (int i = 0; i < 4; ++i) {
      const int k = i * 256 + lane * 4;
      v[i] = *reinterpret_cast<const float4*>(x + k);
      ggv[i] = *reinterpret_cast<const float4*>(g + k);
      shv[i] = *reinterpret_cast<const float4*>(m + k);
      scv[i] = *reinterpret_cast<const float4*>(m + 1024 + k);
    }
#pragma unroll
    for (int i = 0; i < 4; ++i) ss += v[i].x * v[i].x + v[i].y * v[i].y + v[i].z * v[i].z + v[i].w * v[i].w;
    ss = wave_sum(ss);
    const float rinv = rsqrtf(ss * (1.f / 1024.f) + 1e-6f);
#pragma unroll
    for (int i = 0; i < 4; ++i) {
      const int k = i * 256 + lane * 4;
      const float4 gg = ggv[i], sh = shv[i], sc = scv[i];
      float h0 = v[i].x * rinv * gg.x * (1.f + sc.x) + sh.x;
      float h1 = v[i].y * rinv * gg.y * (1.f + sc.y) + sh.y;
      float h2 = v[i].z * rinv * gg.z * (1.f + sc.z) + sh.z;
      float h3 = v[i].w * rinv * gg.w * (1.f + sc.w) + sh.w;
      u32x2 o; o.x = pack2(h0, h1); o.y = pack2(h2, h3);
      *reinterpret_cast<u32x2*>(p.h + (size_t)tok * D + k) = o;
    }
  }
}

template <int EPI, int BM>
__device__ void gemm_phase(const P& p, const u16* __restrict__ A, const u16* __restrict__ Bt, int N, char* smem) {
  constexpr int K = 1024, BK = 64;
  const int tid = threadIdx.x, wid = tid >> 6, lane = tid & 63, wr = wid >> 1, wc = wid & 1, fr = lane & 15, fq = lane >> 4;
  const int NT = N >> 7;
  constexpr int MI = BM / 32;
  constexpr int NAL = BM / 32;
  const int ntiles = (NTOK / BM) * NT;
  const int srow = tid >> 3;
  const int schunk = (tid & 7) ^ ((tid >> 4) & 7);
  const bool xpart = (gridDim.x & 7) == 0;
  constexpr int MPX = 768 / BM;
  const int xcd = blockIdx.x & 7;
  const int jfirst = xpart ? (int)(blockIdx.x >> 3) : (int)blockIdx.x;
  const int jstep = xpart ? (int)(gridDim.x >> 3) : (int)gridDim.x;
  const int jend = xpart ? MPX * NT : ntiles;
  const u16* ga = nullptr; const u16* gb = nullptr;
  if (jfirst < jend) {
    const int mt0 = xpart ? xcd * MPX + jfirst % MPX : jfirst / NT, nt0 = xpart ? jfirst / MPX : jfirst % NT;
    ga = A + (size_t)(mt0 * BM + srow) * K + schunk * 8;
    gb = Bt + (size_t)(nt0 * 128 + srow) * K + schunk * 8;
    __syncthreads();
#pragma unroll
    for (int i = 0; i < NAL; ++i)
      __builtin_amdgcn_global_load_lds((const unsigned*)(ga + (size_t)(32 * i) * K), (unsigned*)(smem + i * 4096 + tid * 16), 16, 0, 0);
#pragma unroll
    for (int i = 0; i < 4; ++i)
      __builtin_amdgcn_global_load_lds((const unsigned*)(gb + (size_t)(32 * i) * K), (unsigned*)(smem + 16384 + i * 4096 + tid * 16), 16, 0, 0);
  }
  for (int tile = jfirst; tile < jend; tile += jstep) {
    const int mt = xpart ? xcd * MPX + tile % MPX : tile / NT, nt = xpart ? tile / MPX : tile % NT;
    const int brow = mt * BM, bcol = nt * 128;
    f32x4 acc[MI][4] = {};
    for (int t = 0; t < K / BK; ++t) {
      char* SA = smem + (t & 1) * 32768;
      char* SB = SA + 16384;
      asm volatile("s_waitcnt vmcnt(0)" ::: "memory");
      __syncthreads();
      if (t + 1 < K / BK) {
        char* NA = smem + ((t + 1) & 1) * 32768;
#pragma unroll
        for (int i = 0; i < NAL; ++i)
          __builtin_amdgcn_global_load_lds((const unsigned*)(ga + (size_t)(32 * i) * K + (t + 1) * BK), (unsigned*)(NA + i * 4096 + tid * 16), 16, 0, 0);
#pragma unroll
        for (int i = 0; i < 4; ++i)
          __builtin_amdgcn_global_load_lds((const unsigned*)(gb + (size_t)(32 * i) * K + (t + 1) * BK), (unsigned*)(NA + 16384 + i * 4096 + tid * 16), 16, 0, 0);
      } else {
        const int tn = tile + jstep;
        if (tn < jend) {
          const int mtn = xpart ? xcd * MPX + tn % MPX : tn / NT, ntn = xpart ? tn / MPX : tn % NT;
          ga = A + (size_t)(mtn * BM + srow) * K + schunk * 8;
          gb = Bt + (size_t)(ntn * 128 + srow) * K + schunk * 8;
#pragma unroll
          for (int i = 0; i < NAL; ++i)
            __builtin_amdgcn_global_load_lds((const unsigned*)(ga + (size_t)(32 * i) * K), (unsigned*)(smem + i * 4096 + tid * 16), 16, 0, 0);
#pragma unroll
          for (int i = 0; i < 4; ++i)
            __builtin_amdgcn_global_load_lds((const unsigned*)(gb + (size_t)(32 * i) * K), (unsigned*)(smem + 16384 + i * 4096 + tid * 16), 16, 0, 0);
        }
      }
      {
        bf16x8 af[2][MI], bfr[2][4];
#pragma unroll
        for (int kk = 0; kk < 2; ++kk) {
#pragma unroll
          for (int n = 0; n < 4; ++n) {
            const int r = wc * 64 + n * 16 + fr;
            bfr[kk][n] = *reinterpret_cast<const bf16x8*>(SB + r * 128 + (((kk * 4 + fq) ^ ((r >> 1) & 7)) << 4));
          }
#pragma unroll
          for (int m = 0; m < MI; ++m) {
            const int r = wr * (BM / 2) + m * 16 + fr;
            af[kk][m] = *reinterpret_cast<const bf16x8*>(SA + r * 128 + (((kk * 4 + fq) ^ ((r >> 1) & 7)) << 4));
          }
        }
#pragma unroll
        for (int kk = 0; kk < 2; ++kk)
#pragma unroll
          for (int m = 0; m < MI; ++m)
#pragma unroll
            for (int n = 0; n < 4; ++n) acc[m][n] = __builtin_amdgcn_mfma_f32_16x16x32_bf16(bfr[kk][n], af[kk][m], acc[m][n], 0, 0, 0);
        __builtin_amdgcn_sched_group_barrier(0x100, MI + 4, 0);
#pragma unroll
        for (int i = 0; i < MI + 4; ++i) {
          __builtin_amdgcn_sched_group_barrier(0x008, 2, 0);
          __builtin_amdgcn_sched_group_barrier(0x100, 1, 0);
        }
        __builtin_amdgcn_sched_group_barrier(0x008, 8 * MI - 2 * (MI + 4), 0);
      }
    }
    if (EPI == 0) {
      const bool gate_tile = (nt >= 4 && nt < 8) || nt >= 20;
#pragma unroll
      for (int m = 0; m < MI; ++m) {
        const int row = brow + wr * (BM / 2) + m * 16 + fr;
#pragma unroll
        for (int np = 0; np < 2; ++np) {
          const int col = bcol + wc * 64 + np * 32 + fq * 8;
          float v[8];
#pragma unroll
          for (int j = 0; j < 4; ++j) { v[j] = acc[m][np * 2][j]; v[4 + j] = acc[m][np * 2 + 1][j]; }
          if (gate_tile) {
#pragma unroll
            for (int j = 0; j < 8; ++j) v[j] = silu_f(v[j]);
          }
          u32x4 o; o.x = pack2(v[0], v[1]); o.y = pack2(v[2], v[3]); o.z = pack2(v[4], v[5]); o.w = pack2(v[6], v[7]);
          *reinterpret_cast<u32x4*>(p.proj + (size_t)row * IN_E + col) = o;
          if (brow < NP && nt >= 12 && nt < 20) {
            const bool isv = nt >= 16;
            float* dst = p.out + (size_t)NTOK * D + (isv ? (size_t)16 * 8 * 256 * 64 : 0);
            const int cc = col - (isv ? 2048 : 1536);
            const int b = row >> 8, tt = row & 255, hh = cc >> 6, dd = cc & 63;
            float* d2 = dst + (((size_t)b * 8 + hh) * 256 + tt) * 64 + dd;
            *reinterpret_cast<float4*>(d2) = make_float4(v[0], v[1], v[2], v[3]);
            *reinterpret_cast<float4*>(d2 + 4) = make_float4(v[4], v[5], v[6], v[7]);
          }
        }
      }
    } else if (EPI == 2) {
      {
        const int cv = cond_of_token(brow);
        float rinv[MI];
#pragma unroll
        for (int m = 0; m < MI; ++m) {
          const float* rs = p.rowss + (size_t)(brow + wr * (BM / 2) + m * 16 + fr) * 16;
          const float4 a = *reinterpret_cast<const float4*>(rs), b2 = *reinterpret_cast<const float4*>(rs + 4);
          const float4 c2 = *reinterpret_cast<const float4*>(rs + 8), d2 = *reinterpret_cast<const float4*>(rs + 12);
          const float tot = (a.x + a.y + a.z + a.w) + (b2.x + b2.y + b2.z + b2.w) + (c2.x + c2.y + c2.z + c2.w) + (d2.x + d2.y + d2.z + d2.w);
          rinv[m] = rsqrtf(tot * (1.f / 1024.f) + 1e-6f);
        }
#pragma unroll
        for (int n = 0; n < 4; ++n) {
          const float4 bz = *reinterpret_cast<const float4*>(p.bias1 + (size_t)cv * IN_O + bcol + wc * 64 + n * 16 + fq * 4);
#pragma unroll
          for (int m = 0; m < MI; ++m) {
            acc[m][n][0] = acc[m][n][0] * rinv[m] + bz.x; acc[m][n][1] = acc[m][n][1] * rinv[m] + bz.y;
            acc[m][n][2] = acc[m][n][2] * rinv[m] + bz.z; acc[m][n][3] = acc[m][n][3] * rinv[m] + bz.w;
          }
        }
      }
      if (nt < 24) {
        const int type = nt >> 3, chunk = nt & 7;
#pragma unroll
        for (int m = 0; m < MI; ++m) {
          const int row = brow + wr * (BM / 2) + m * 16 + fr;
          float v[8];
#pragma unroll
          for (int nl = 0; nl < 2; ++nl)
#pragma unroll
            for (int j = 0; j < 4; ++j) {
              const float a = acc[m][nl][j], b = acc[m][2 + nl][j];
              v[nl * 4 + j] = type == 0 ? a * silu_f(b) : (type == 1 ? a * b : a * sigmoid_f(b));
            }
          u32x4 o; o.x = pack2(v[0], v[1]); o.y = pack2(v[2], v[3]); o.z = pack2(v[4], v[5]); o.w = pack2(v[6], v[7]);
          *reinterpret_cast<u32x4*>(p.proj + (size_t)row * 2048 + type * 512 + chunk * 64 + wc * 32 + fq * 8) = o;
        }
      } else {
#pragma unroll
        for (int m = 0; m < MI; ++m) {
          const int row = brow + wr * (BM / 2) + m * 16 + fr;
#pragma unroll
          for (int np = 0; np < 2; ++np) {
            float v[8];
#pragma unroll
            for (int j = 0; j < 4; ++j) { v[j] = silu_f(acc[m][np * 2][j]); v[4 + j] = silu_f(acc[m][np * 2 + 1][j]); }
            u32x4 o; o.x = pack2(v[0], v[1]); o.y = pack2(v[2], v[3]); o.z = pack2(v[4], v[5]); o.w = pack2(v[6], v[7]);
            *reinterpret_cast<u32x4*>(p.proj + (size_t)row * 2048 + 1536 + (nt - 24) * 128 + wc * 64 + np * 32 + fq * 8) = o;
          }
        }
      }
    } else {
      const int layer = (EPI == 1) ? 0 : 1;
      float ssq[MI] = {};
#pragma unroll
      for (int np = 0; np < 2; ++np) {
        const int col = bcol + wc * 64 + np * 32 + fq * 8;
        float4 n0 = {}, n1 = {};
        if (EPI == 1) { n0 = *reinterpret_cast<const float4*>(p.norm_g + 1024 + col); n1 = *reinterpret_cast<const float4*>(p.norm_g + 1024 + col + 4); }
#pragma unroll
        for (int m = 0; m < MI; ++m) {
          const int row = brow + wr * (BM / 2) + m * 16 + fr;
          const int cv = cond_of_token(row);
          const float* gate = p.mod + (size_t)(layer * 3 + cv) * 3072 + 2048 + col;
          const float4 g0 = *reinterpret_cast<const float4*>(gate);
          const float4 g1 = *reinterpret_cast<const float4*>(gate + 4);
          const float* xin = (EPI == 1) ? (row < NP ? p.x_prompt + (size_t)row * D + col : p.x_sample + (size_t)(row - NP) * D + col)
                                        : p.x1 + (size_t)row * D + col;
          const float4 x0 = *reinterpret_cast<const float4*>(xin);
          const float4 x1v = *reinterpret_cast<const float4*>(xin + 4);
          float4 o0, o1;
          o0.x = x0.x + g0.x * acc[m][np * 2][0]; o0.y = x0.y + g0.y * acc[m][np * 2][1];
          o0.z = x0.z + g0.z * acc[m][np * 2][2]; o0.w = x0.w + g0.w * acc[m][np * 2][3];
          o1.x = x1v.x + g1.x * acc[m][np * 2 + 1][0]; o1.y = x1v.y + g1.y * acc[m][np * 2 + 1][1];
          o1.z = x1v.z + g1.z * acc[m][np * 2 + 1][2]; o1.w = x1v.w + g1.w * acc[m][np * 2 + 1][3];
          float* xo = p.x1 + (size_t)row * D + col;
          *reinterpret_cast<float4*>(xo) = o0;
          *reinterpret_cast<float4*>(xo + 4) = o1;
          if (EPI == 1) {
            const float* sc = p.mod + (size_t)(3 + cv) * 3072 + 1024 + col;
            const float4 s0 = *reinterpret_cast<const float4*>(sc), s1 = *reinterpret_cast<const float4*>(sc + 4);
            ssq[m] += o0.x * o0.x + o0.y * o0.y + o0.z * o0.z + o0.w * o0.w + o1.x * o1.x + o1.y * o1.y + o1.z * o1.z + o1.w * o1.w;
            u32x4 hv;
            hv.x = pack2(o0.x * n0.x * (1.f + s0.x), o0.y * n0.y * (1.f + s0.y)); hv.y = pack2(o0.z * n0.z * (1.f + s0.z), o0.w * n0.w * (1.f + s0.w));
            hv.z = pack2(o1.x * n1.x * (1.f + s1.x), o1.y * n1.y * (1.f + s1.y)); hv.w = pack2(o1.z * n1.z * (1.f + s1.z), o1.w * n1.w * (1.f + s1.w));
            *reinterpret_cast<u32x4*>(p.h + (size_t)row * D + col) = hv;
          }
        }
      }
      if (EPI == 1) {
#pragma unroll
        for (int m = 0; m < MI; ++m) {
          float v = ssq[m];
          v += __shfl_xor(v, 16); v += __shfl_xor(v, 32);
          if (fq == 0) p.rowss[(size_t)(brow + wr * (BM / 2) + m * 16 + fr) * 16 + nt * 2 + wc] = v;
        }
      }
    }
  }
}

template <int MODE>
__device__ void attn_unit(const P& p, int u, char* smem) {
  const int tid = threadIdx.x, wid = tid >> 6, lane = tid & 63, fr = lane & 15, fq = lane >> 4;
  char* Ks = smem;
  u16* Vt = reinterpret_cast<u16*>(smem + 16384);
  float* rpl = reinterpret_cast<float*>(smem + 16384 + 18432);
  int h, qtok0, b, r = 0;
  if (MODE == 0) { b = u >> 5; h = (u >> 2) & 7; qtok0 = b * 256 + (u & 3) * 64; }
  else { b = u >> 7; r = (u >> 3) & 15; h = u & 7; qtok0 = NP + b * 1024 + r * 64; }
  constexpr int NSS = MODE == 0 ? 2 : 6;
  const int c0 = wid * 16;
  int ksc = c0 - 8; ksc = ksc < 0 ? 0 : (ksc > 32 ? 32 : ksc);
  const int rs = (r - 4) < 0 ? 0 : ((r - 4) > 8 ? 8 : (r - 4));
  bf16x8 qf[2];
  {
    const u16* q = p.proj + (size_t)(qtok0 + wid * 16 + fr) * IN_E + 1024 + h * 64 + fq * 8;
    qf[0] = *reinterpret_cast<const bf16x8*>(q);
    qf[1] = *reinterpret_cast<const bf16x8*>(q + 32);
  }
  u32x2 gbv[4];
#pragma unroll
  for (int dt = 0; dt < 4; ++dt)
    gbv[dt] = *reinterpret_cast<const u32x2*>(p.proj + (size_t)(qtok0 + wid * 16 + fr) * IN_E + 2560 + h * 64 + dt * 16 + fq * 4);
  const int cq = c0 + fr;
  int cstart = cq - 8; cstart = cstart < 0 ? 0 : (cstart > 48 ? 48 : cstart);
  float mrun = -1e30f, lrun = 0.f;
  f32x4 o[4] = {};
  const float scale = 0.125f;
  const int krow = tid >> 3, kchunk = tid & 7;
  const int vkey = tid & 127, vdh = tid >> 7;
  u32x4 kr[4], vr[4];
  auto prefetch = [&](int ss) {
    const u16* kb; const u16* vb; int ld;
    if (MODE == 0) { kb = p.proj + (size_t)(b * 256 + ss * 128) * IN_E + 1536 + h * 64; vb = kb + 512; ld = IN_E; }
    else if (ss < 4) { kb = p.proj + (size_t)(NP + b * 1024 + (rs + ss * 2) * 64) * IN_E + 1536 + h * 64; vb = kb + 512; ld = IN_E; }
    else { kb = p.kcb + ((size_t)(b * 8 + h) * 256 + (ss - 4) * 128) * 64; vb = p.vcb + ((size_t)(b * 8 + h) * 256 + (ss - 4) * 128) * 64; ld = 64; }
#pragma unroll
    for (int i = 0; i < 4; ++i) kr[i] = *reinterpret_cast<const u32x4*>(kb + (size_t)(krow + 32 * i) * ld + kchunk * 8);
#pragma unroll
    for (int i = 0; i < 4; ++i) vr[i] = *reinterpret_cast<const u32x4*>(vb + (size_t)vkey * ld + vdh * 32 + i * 8);
  };
  prefetch(0);
  if (MODE == 1) {
    __syncthreads();
    for (int i = tid; i < 15 * 31; i += NTHR) rpl[i] = p.rpb[h * 465 + i];
  }
#pragma unroll 1
  for (int ss = 0; ss < NSS; ++ss) {
    const bool local = (MODE == 1 && ss < 4);
    __syncthreads();
#pragma unroll
    for (int i = 0; i < 4; ++i) {
      const int row = krow + 32 * i;
      *reinterpret_cast<u32x4*>(Ks + row * 128 + ((kchunk ^ ((row >> 1) & 7)) << 4)) = kr[i];
    }
    {
      u16* vt = Vt + (vkey >> 6) * 4608 + (vdh * 32) * 72 + (vkey & 63);
#pragma unroll
      for (int i = 0; i < 4; ++i) {
        const unsigned w[4] = {vr[i].x, vr[i].y, vr[i].z, vr[i].w};
#pragma unroll
        for (int j = 0; j < 4; ++j) {
          vt[(i * 8 + 2 * j) * 72] = (u16)(w[j] & 0xffff);
          vt[(i * 8 + 2 * j + 1) * 72] = (u16)(w[j] >> 16);
        }
      }
    }
    if (ss + 1 < NSS) prefetch(ss + 1);
    __syncthreads();
#pragma unroll
    for (int s2 = 0; s2 < 2; ++s2) {
      const u16* Vs = Vt + s2 * 4608;
      const int nchunk = local ? 1 : 2;
      const int kbase = local ? ksc : 0;
      const float* rp = rpl + (rs + ss * 2 + s2 - r + 7) * 31 + 15 - cq;
      for (int ch = 0; ch < nchunk; ++ch) {
        f32x4 sv[2];
#pragma unroll
        for (int t2 = 0; t2 < 2; ++t2) {
          const int koff = kbase + ch * 32 + t2 * 16;
          const int row = s2 * 64 + koff + fr;
          const int sw = (row >> 1) & 7;
          const bf16x8 kf0 = *reinterpret_cast<const bf16x8*>(Ks + row * 128 + ((fq ^ sw) << 4));
          const bf16x8 kf1 = *reinterpret_cast<const bf16x8*>(Ks + row * 128 + (((4 + fq) ^ sw) << 4));
          f32x4 z = {0.f, 0.f, 0.f, 0.f};
          z = __builtin_amdgcn_mfma_f32_16x16x32_bf16(kf0, qf[0], z, 0, 0, 0);
          z = __builtin_amdgcn_mfma_f32_16x16x32_bf16(kf1, qf[1], z, 0, 0, 0);
          if (local) {
#pragma unroll
            for (int j = 0; j < 4; ++j) {
              const int ck = koff + fq * 4 + j;
              int dcl = ck - cq; dcl = dcl < -15 ? -15 : (dcl > 15 ? 15 : dcl);
              const float bias = rp[dcl + cq];
              const bool ok = (ck >= cstart) && (ck < cstart + 16);
              z[j] = ok ? z[j] * scale + bias : -1e30f;
            }
          } else {
#pragma unroll
            for (int j = 0; j < 4; ++j) z[j] *= scale;
          }
          sv[t2] = z;
        }
        float mx = fmaxf(fmaxf(fmaxf(sv[0][0], sv[0][1]), fmaxf(sv[0][2], sv[0][3])), fmaxf(fmaxf(sv[1][0], sv[1][1]), fmaxf(sv[1][2], sv[1][3])));
        mx = fmaxf(mx, __shfl_xor(mx, 16));
        mx = fmaxf(mx, __shfl_xor(mx, 32));
        const float mnew = fmaxf(mrun, mx);
        const float corr = __expf(mrun - mnew);
        mrun = mnew;
        float pv[8];
        float psum = 0.f;
#pragma unroll
        for (int j = 0; j < 4; ++j) { pv[j] = __expf(sv[0][j] - mnew); pv[4 + j] = __expf(sv[1][j] - mnew); }
#pragma unroll
        for (int j = 0; j < 8; ++j) psum += pv[j];
        lrun = lrun * corr + psum;
        u32x4 pk;
        pk.x = pack2(pv[0], pv[1]); pk.y = pack2(pv[2], pv[3]); pk.z = pack2(pv[4], pv[5]); pk.w = pack2(pv[6], pv[7]);
        const bf16x8 pfrag = __builtin_bit_cast(bf16x8, pk);
        const int k0 = kbase + ch * 32;
#pragma unroll
        for (int dt = 0; dt < 4; ++dt) {
          const u16* vp = Vs + (dt * 16 + fr) * 72 + k0 + fq * 4;
          u32x2 v0 = *reinterpret_cast<const u32x2*>(vp);
          u32x2 v1 = *reinterpret_cast<const u32x2*>(vp + 16);
          u32x4 vv; vv.x = v0.x; vv.y = v0.y; vv.z = v1.x; vv.w = v1.y;
          f32x4 oo = o[dt];
          oo[0] *= corr; oo[1] *= corr; oo[2] *= corr; oo[3] *= corr;
          o[dt] = __builtin_amdgcn_mfma_f32_16x16x32_bf16(__builtin_bit_cast(bf16x8, vv), pfrag, oo, 0, 0, 0);
        }
      }
    }
  }
  lrun += __shfl_xor(lrun, 16);
  lrun += __shfl_xor(lrun, 32);
  const float linv = 1.f / lrun;
  const int tok = qtok0 + wid * 16 + fr;
#pragma unroll
  for (int dt = 0; dt < 4; ++dt) {
    const int dd = h * 64 + dt * 16 + fq * 4;
    const u32x2 gb = gbv[dt];
    float r0 = o[dt][0] * linv * bflo(gb.x);
    float r1 = o[dt][1] * linv * bfhi(gb.x);
    float r2 = o[dt][2] * linv * bflo(gb.y);
    float r3 = o[dt][3] * linv * bfhi(gb.y);
    u32x2 ov; ov.x = pack2(r0, r1); ov.y = pack2(r2, r3);
    *reinterpret_cast<u32x2*>(p.cat + (size_t)tok * D + 512 + dd) = ov;
  }
}

template <int G>
__device__ void pool_unit(const P& p, int tile, char* smem) {
  constexpr int HALF = 1 << G;
  constexpr int NR = 64 + 2 * HALF;
  int tid = threadIdx.x;
  asm volatile("" : "+v"(tid));
  const int wid = tid >> 6, lane = tid & 63, fr = lane & 15, fq = lane >> 4;
  char* U = smem;
  char* W = smem + 80 * 272;
  const int T0 = tile * 64;
  int sb, se;
  if (T0 < NP) { sb = T0 & ~255; se = sb + 256; } else { sb = NP + ((T0 - NP) & ~1023); se = sb + 1024; }
  __syncthreads();
  {
    constexpr int NIT = (NR * 16 + NTHR - 1) / NTHR;
    u32x4 sv[NIT];
#pragma unroll
    for (int i = 0; i < NIT; ++i) {
      const int c = tid + i * NTHR, rr = c >> 4, c16 = c & 15;
      int tt = T0 - HALF + rr; tt = tt < sb ? sb : (tt >= se ? se - 1 : tt);
      sv[i] = *reinterpret_cast<const u32x4*>(p.proj + (size_t)tt * IN_E + G * 128 + c16 * 8);
    }
#pragma unroll
    for (int i = 0; i < NIT; ++i) {
      const int c = tid + i * NTHR, rr = c >> 4, c16 = c & 15;
      if (c < NR * 16) *reinterpret_cast<u32x4*>(U + rr * 272 + c16 * 16) = sv[i];
    }
  }
#pragma unroll
  for (int i = 0; i < 8; ++i) {
    const int c = tid + i * NTHR, rr = c >> 4, c16 = c & 15;
    *reinterpret_cast<u32x4*>(W + rr * 272 + c16 * 16) = *reinterpret_cast<const u32x4*>(p.wpt + (size_t)G * 16384 + rr * 128 + c16 * 8);
  }
  __syncthreads();
  const int t = T0 + wid * 16 + fr;
  int lo = t - HALF; lo = lo < sb ? sb : lo;
  int hi = t + HALF; hi = hi > se ? se : hi;
  const float inv = 1.f / (float)(hi - lo);
  f32x4 acc[8] = {};
#pragma unroll 1
  for (int ks = 0; ks < 4; ++ks) {
    const char* ub = U + (wid * 16 + fr) * 272 + (ks * 4 + fq) * 16;
    float sum[8] = {};
#pragma unroll
    for (int i = 0; i < 2 * HALF; ++i) {
      const int tt = t - HALF + i;
      const float m = (tt >= lo && tt < hi) ? 1.f : 0.f;
      const u32x4 w2 = *reinterpret_cast<const u32x4*>(ub + i * 272);
      sum[0] += m * bflo(w2.x); sum[1] += m * bfhi(w2.x); sum[2] += m * bflo(w2.y); sum[3] += m * bfhi(w2.y);
      sum[4] += m * bflo(w2.z); sum[5] += m * bfhi(w2.z); sum[6] += m * bflo(w2.w); sum[7] += m * bfhi(w2.w);
    }
    const u32x4 w = *reinterpret_cast<const u32x4*>(ub + HALF * 272);
    const float uu[8] = {bflo(w.x), bfhi(w.x), bflo(w.y), bfhi(w.y), bflo(w.z), bfhi(w.z), bflo(w.w), bfhi(w.w)};
    u32x4 pk;
    pk.x = pack2(sum[0] * inv - uu[0], sum[1] * inv - uu[1]);
    pk.y = pack2(sum[2] * inv - uu[2], sum[3] * inv - uu[3]);
    pk.z = pack2(sum[4] * inv - uu[4], sum[5] * inv - uu[5]);
    pk.w = pack2(sum[6] * inv - uu[6], sum[7] * inv - uu[7]);
    const bf16x8 af = __builtin_bit_cast(bf16x8, pk);
#pragma unroll
    for (int n = 0; n < 8; ++n) {
      const bf16x8 bfr = *reinterpret_cast<const bf16x8*>(W + (n * 16 + fr) * 272 + (ks * 4 + fq) * 16);
      acc[n] = __builtin_amdgcn_mfma_f32_16x16x32_bf16(bfr, af, acc[n], 0, 0, 0);
    }
  }
#pragma unroll
  for (int n = 0; n < 8; ++n) {
    const int dd = G * 128 + n * 16 + fq * 4;
    const float4 ps = *reinterpret_cast<const float4*>(p.pool_scale + dd);
    const u32x2 ga = *reinterpret_cast<const u32x2*>(p.proj + (size_t)t * IN_E + 512 + dd);
    u32x2 ov;
    ov.x = pack2(acc[n][0] * ps.x * bflo(ga.x), acc[n][1] * ps.y * bfhi(ga.x));
    ov.y = pack2(acc[n][2] * ps.z * bflo(ga.y), acc[n][3] * ps.w * bfhi(ga.y));
    *reinterpret_cast<u32x2*>(p.cat + (size_t)t * D + dd) = ov;
  }
}

__device__ void phase_even_mix(const P& p, char* smem) {
  if (gridDim.x == 512) {
    const int bx = blockIdx.x;
    if (bx < 256) {
      attn_unit<1>(p, bx, smem);
      const int g = (bx >> 3) & 3, tile = (bx & 7) * 12 + (bx >> 5);
      if (g == 0) pool_unit<0>(p, tile, smem); else if (g == 1) pool_unit<1>(p, tile, smem); else if (g == 2) pool_unit<2>(p, tile, smem); else pool_unit<3>(p, tile, smem);
    } else {
      attn_unit<0>(p, (bx - 256) * 2, smem);
      attn_unit<0>(p, (bx - 256) * 2 + 1, smem);
      if (bx < 384) {
        const int g = (bx >> 3) & 3, tile = (bx & 7) * 12 + (bx >> 5);
        if (g == 0) pool_unit<0>(p, tile, smem); else if (g == 1) pool_unit<1>(p, tile, smem); else if (g == 2) pool_unit<2>(p, tile, smem); else pool_unit<3>(p, tile, smem);
      }
    }
    return;
  }
  constexpr int U_N = 256, U_C = 512, U_P = 384;
  for (int u = blockIdx.x; u < U_N + U_C + U_P; u += gridDim.x) {
    if (u < U_N) attn_unit<1>(p, u, smem);
    else if (u < U_N + U_C) attn_unit<0>(p, u - U_N, smem);
    else {
      const int q = u - U_N - U_C, g = q & 3, tile = q >> 2;
      if (g == 0) pool_unit<0>(p, tile, smem); else if (g == 1) pool_unit<1>(p, tile, smem); else if (g == 2) pool_unit<2>(p, tile, smem); else pool_unit<3>(p, tile, smem);
    }
  }
}

__device__ void odd_unit(const P& p, int u, char* smem) {
  int tid = threadIdx.x;
  asm volatile("" : "+v"(tid));
  const int lane = tid & 63, wid = tid >> 6;
  u16* G = reinterpret_cast<u16*>(smem);
  float* red = reinterpret_cast<float*>(smem + 46 * 1024);
  const int t0 = u * 16;
  int sb, se;
  if (t0 < NP) { sb = t0 & ~255; se = sb + 256; } else { sb = NP + ((t0 - NP) & ~1023); se = sb + 1024; }
  const int ch = tid * 2;
  u32x4 sv[12];
#pragma unroll
  for (int i = 0; i < 12; ++i) {
    const int c = tid + i * NTHR, rr = c >> 6, c16 = c & 63;
    const int tt = t0 - 15 + rr;
    sv[i] = u32x4{0u, 0u, 0u, 0u};
    if (c < 46 * 64 && tt >= sb && tt < se) sv[i] = *reinterpret_cast<const u32x4*>(p.proj + (size_t)tt * 2048 + 1024 + c16 * 8);
  }
  unsigned cxw[18], bww[16], gdw[16];
#pragma unroll
  for (int q = 0; q < 18; ++q) {
    const int tt = t0 + q - 1;
    cxw[q] = 0u;
    if (tt >= sb && tt < se) cxw[q] = *reinterpret_cast<const unsigned*>(p.proj + (size_t)tt * 2048 + 512 + ch);
  }
#pragma unroll
  for (int i = 0; i < 16; ++i) {
    bww[i] = *reinterpret_cast<const unsigned*>(p.proj + (size_t)(t0 + i) * 2048 + ch);
    gdw[i] = *reinterpret_cast<const unsigned*>(p.proj + (size_t)(t0 + i) * 2048 + 1536 + ch);
  }
  float2 w[31];
#pragma unroll
  for (int j = 0; j < 31; ++j) w[j] = *reinterpret_cast<const float2*>(p.conv_d + j * 512 + ch);
  const float2 bias = *reinterpret_cast<const float2*>(p.conv_d_b + ch);
  const float2 lg = *reinterpret_cast<const float2*>(p.ln_g + ch);
  const float2 lb = *reinterpret_cast<const float2*>(p.ln_b + ch);
  const float2 wc0 = *reinterpret_cast<const float2*>(p.conv_c + ch);
  const float2 wc1 = *reinterpret_cast<const float2*>(p.conv_c + 512 + ch);
  const float2 wc2 = *reinterpret_cast<const float2*>(p.conv_c + 1024 + ch);
  __syncthreads();
#pragma unroll
  for (int i = 0; i < 12; ++i) {
    const int c = tid + i * NTHR, rr = c >> 6, c16 = c & 63;
    if (c < 46 * 64) *reinterpret_cast<u32x4*>(G + rr * 512 + c16 * 8) = sv[i];
  }
#pragma unroll
  for (int i = 0; i < 16; ++i) {
    const int tok = t0 + i;
    const float c0 = bflo(bww[i]) * (wc0.x * bflo(cxw[i]) + wc1.x * bflo(cxw[i + 1]) + wc2.x * bflo(cxw[i + 2]));
    const float c1 = bfhi(bww[i]) * (wc0.y * bfhi(cxw[i]) + wc1.y * bfhi(cxw[i + 1]) + wc2.y * bfhi(cxw[i + 2]));
    *reinterpret_cast<unsigned*>(p.cat + (size_t)tok * D + ch) = pack2(c0, c1);
  }
  __syncthreads();
#pragma unroll
  for (int hf = 0; hf < 2; ++hf) {
    float2 z[8];
#pragma unroll
    for (int i = 0; i < 8; ++i) z[i] = bias;
    const u16* Gh = G + hf * 8 * 512 + ch;
#pragma unroll
    for (int r = 0; r < 38; ++r) {
      const unsigned gv = *reinterpret_cast<const unsigned*>(Gh + r * 512);
      const float g0 = bflo(gv), g1 = bfhi(gv);
#pragma unroll
      for (int i = 0; i < 8; ++i) {
        const int j = r - i;
        if (j >= 0 && j <= 30) { z[i].x += w[j].x * g0; z[i].y += w[j].y * g1; }
      }
    }
    float* rd = red + hf * 64;
#pragma unroll
    for (int i = 0; i < 8; ++i) {
      const float sv2 = wave_sum(z[i].x + z[i].y);
      if (lane == 0) rd[wid * 8 + i] = sv2;
    }
    __syncthreads();
    float mu[8];
#pragma unroll
    for (int i = 0; i < 8; ++i) mu[i] = (rd[i] + rd[8 + i] + rd[16 + i] + rd[24 + i]) * (1.f / 512.f);
#pragma unroll
    for (int i = 0; i < 8; ++i) {
      const float d0 = z[i].x - mu[i], d1 = z[i].y - mu[i];
      const float sv2 = wave_sum(d0 * d0 + d1 * d1);
      if (lane == 0) rd[32 + wid * 8 + i] = sv2;
    }
    __syncthreads();
#pragma unroll
    for (int i = 0; i < 8; ++i) {
      const float rstd = rsqrtf((rd[32 + i] + rd[40 + i] + rd[48 + i] + rd[56 + i]) * (1.f / 512.f) + 1e-6f);
      const int tok = t0 + hf * 8 + i;
      const unsigned gd = gdw[hf * 8 + i];
      const float l0 = (z[i].x - mu[i]) * rstd * lg.x + lb.x;
      const float l1 = (z[i].y - mu[i]) * rstd * lg.y + lb.y;
      *reinterpret_cast<unsigned*>(p.cat + (size_t)tok * D + 512 + ch) = pack2(silu_f(l0) * bflo(gd), silu_f(l1) * bfhi(gd));
    }
  }
}

__device__ void phase_odd_mix(const P& p, char* smem) {
  if ((gridDim.x & 7) == 0) {
    const int xcd = blockIdx.x & 7, gl = gridDim.x >> 3;
    for (int j = blockIdx.x >> 3; j < 48; j += gl) odd_unit(p, xcd * 48 + j, smem);
    return;
  }
  for (int u = blockIdx.x; u < NTOK / 16; u += gridDim.x) odd_unit(p, u, smem);
}

__device__ void phase_final(const P& p) {
  const int lane = threadIdx.x & 63, wid = threadIdx.x >> 6;
  const bool xpart = (gridDim.x & 7) == 0;
  const int nrow = xpart ? 768 : NTOK, rstep = xpart ? (int)(gridDim.x >> 3) * 4 : (int)gridDim.x * 4;
  for (int rr = (xpart ? (int)(blockIdx.x >> 3) : (int)blockIdx.x) * 4 + wid; rr < nrow; rr += rstep) {
    const int tok = xpart ? (int)(blockIdx.x & 7) * 768 + rr : rr;
    const float* x = p.x1 + (size_t)tok * D;
    float4 v[4];
    float ss = 0.f;
#pragma unroll
    for (int i = 0; i < 4; ++i) {
      v[i] = *reinterpret_cast<const float4*>(x + i * 256 + lane * 4);
      ss += v[i].x * v[i].x + v[i].y * v[i].y + v[i].z * v[i].z + v[i].w * v[i].w;
    }
    ss = wave_sum(ss);
    const float rinv = rsqrtf(ss * (1.f / 1024.f) + 1e-6f);
#pragma unroll
    for (int i = 0; i < 4; ++i) {
      const int k = i * 256 + lane * 4;
      float4 gg = *reinterpret_cast<const float4*>(p.final_g + k);
      float4 o = make_float4(v[i].x * rinv * gg.x, v[i].y * rinv * gg.y, v[i].z * rinv * gg.z, v[i].w * rinv * gg.w);
      *reinterpret_cast<float4*>(p.out + (size_t)tok * D + k) = o;
    }
  }
}

#define XB_TMO      128
#define XB_XCNT(j)  (256  + 64 * (j))
#define XB_XSUB(j)  (1280 + 64 * (j))
#define XB_XGEN(j)  (2304 + 64 * (j))
#define XB_TOP      3328
#define XB_TOPGEN   3392
#define XCD_BAR_WORDS 3456
#define XB_SPIN_CAP (1u << 18)
#define LAS __attribute__((address_space(3)))

__device__ __forceinline__ unsigned xb_ld(unsigned* p)              { return __hip_atomic_load(p, __ATOMIC_RELAXED, __HIP_MEMORY_SCOPE_AGENT); }
__device__ __forceinline__ unsigned xb_add(unsigned* p, unsigned v) { return __hip_atomic_fetch_add(p, v, __ATOMIC_RELAXED, __HIP_MEMORY_SCOPE_AGENT); }
__device__ __forceinline__ unsigned xb_xcc_id() { return (unsigned)__builtin_amdgcn_s_getreg((3 << 11) | 20) & 0xFu; }
#define XB_SPIN(cond, bar) do { unsigned _sp = 0; while (cond) { __builtin_amdgcn_s_sleep(1); \
    if ((++_sp & 255u) == 0u) { if (xb_ld(&(bar)[XB_TMO])) break; if (_sp > XB_SPIN_CAP) { atomicAdd(&(bar)[XB_TMO], 1u); break; } } } } while (0)

struct XcdBarrier {
    unsigned* bar; unsigned x;
    unsigned nloc, nx;
    volatile unsigned* st;
};

__device__ __forceinline__ XcdBarrier xcd_barrier_post(unsigned* bar, volatile unsigned* st) {
    XcdBarrier b; b.bar = bar; b.x = xb_xcc_id(); b.st = st; b.nloc = 0u; b.nx = 0u;
    if (threadIdx.x == 0) (void)xb_add(&bar[XB_XCNT(b.x)], 1u);
    return b;
}
__device__ __forceinline__ void xcd_barrier_complete(unsigned* bar, unsigned x, unsigned& nloc, unsigned& nx) {
    const unsigned G = gridDim.x * gridDim.y * gridDim.z;
    unsigned sum, cnt, mine, sp = 0u;
    for (;;) {
        sum = 0u; cnt = 0u; mine = 0u;
#pragma unroll
        for (unsigned j = 0; j < 16; ++j) { const unsigned c = xb_ld(&bar[XB_XCNT(j)]); sum += c; cnt += (c > 0u) ? 1u : 0u; mine = (j == x) ? c : mine; }
        if (sum == G) break;
        __builtin_amdgcn_s_sleep(1);
        if ((++sp & 255u) == 0u) { if (xb_ld(&bar[XB_TMO])) break; if (sp > XB_SPIN_CAP) { atomicAdd(&bar[XB_TMO], 1u); break; } }
    }
    nloc = mine > 0u ? mine : 1u; nx = cnt > 0u ? cnt : 1u;
}

__device__ __forceinline__ void xcd_barrier(XcdBarrier& b) {
    asm volatile("s_waitcnt vmcnt(0)" ::: "memory");
    __syncthreads();
    if (threadIdx.x == 0) {
        unsigned* bar = b.bar;
        __builtin_amdgcn_s_waitcnt(0);
        unsigned nloc = b.nloc, nx = b.nx;
        if (nloc == 0u) { xcd_barrier_complete(bar, b.x, nloc, nx); b.nloc = nloc; b.nx = nx; }
        const unsigned old = xb_add(&bar[XB_XSUB(b.x)], 1u);
        const unsigned gen = old / nloc;
        if (old + 1u == (gen + 1u) * nloc) {
            __builtin_amdgcn_fence(__ATOMIC_RELEASE, "agent");
            asm volatile("s_waitcnt vmcnt(0)" ::: "memory");
            const unsigned og = xb_add(&bar[XB_TOP], 1u);
            const unsigned tg = og / nx;
            if (og + 1u == (tg + 1u) * nx) xb_add(&bar[XB_TOPGEN], 1u);
            else XB_SPIN(xb_ld(&bar[XB_TOPGEN]) == tg, bar);
            __builtin_amdgcn_fence(__ATOMIC_ACQUIRE, "agent");
            xb_add(&bar[XB_XGEN(b.x)], 1u);
            asm volatile("s_waitcnt vmcnt(0)" ::: "memory");
        } else {
            XB_SPIN(xb_ld(&bar[XB_XGEN(b.x)]) == gen, bar);
            __builtin_amdgcn_fence(__ATOMIC_ACQUIRE, "agent");
            asm volatile("s_waitcnt vmcnt(0)" ::: "memory");
        }
    }
    __syncthreads();
}


template <int PH>
__device__ __forceinline__ void run_phase(const P& p, char* smem) {
  if (PH == 0) phase0(p, smem);
  if (PH == 1) phase_norm(p, 0, p.x_prompt, p.x_sample);
  if (PH == 2) gemm_phase<0, 128>(p, p.h, p.wt_in_even, IN_E, smem);
  if (PH == 3) phase_even_mix(p, smem);
  if (PH == 4) gemm_phase<1, 96>(p, p.cat, p.wt_out_even, D, smem);
  if (PH == 6) gemm_phase<2, 128>(p, p.h, p.wt_in_odd, IN_O, smem);
  if (PH == 7) phase_odd_mix(p, smem);
  if (PH == 8) gemm_phase<3, 96>(p, p.cat, p.wt_out_odd, D, smem);
  if (PH == 9) phase_final(p);
}

__global__ void __launch_bounds__(NTHR, 2) mega_kernel(P p) {
  __shared__ __attribute__((aligned(16))) char smem[SMEM_BYTES];
  cg::grid_group grid = cg::this_grid();
  XcdBarrier xb = xcd_barrier_post(p.bar, (volatile unsigned*)(p.bar + XCD_BAR_WORDS + 64 * blockIdx.x));
  if (p.use_cg) grid.sync();
#define RUNP(PH) do { run_phase<PH>(p, smem); if ((PROBE_REPEAT >> PH) & 1) { xcd_barrier(xb); run_phase<PH>(p, smem); } } while (0)
#define GSYNC() do { xcd_barrier(xb); if (PROBE_SYNC2) xcd_barrier(xb); } while (0)
  RUNP(0); GSYNC();
  RUNP(1); GSYNC();
  RUNP(2); GSYNC();
  RUNP(3); GSYNC();
  RUNP(4); GSYNC();
  RUNP(6); GSYNC();
  RUNP(7); GSYNC();
  run_phase<8>(p, smem); GSYNC();
  RUNP(9);
}

template <int PH>
__global__ void __launch_bounds__(NTHR, 2) phase_kernel(P p) {
  __shared__ __attribute__((aligned(16))) char smem[SMEM_BYTES];
  run_phase<PH>(p, smem);
}

constexpr int BAR_TOTAL_WORDS = XCD_BAR_WORDS + 64 * 2048;
static inline size_t align_up(size_t x) { return (x + 255) & ~(size_t)255; }

extern "C" void kernel_launch(void* const* d_in, const int* in_sizes, int n_in, void* d_out, int out_size, void* d_ws,
                              size_t ws_size, hipStream_t stream) {
  P p{};
  const float** f = reinterpret_cast<const float**>(&p);
  for (int i = 0; i < 22; ++i) f[i] = (const float*)d_in[i];
  p.out = (float*)d_out;
  char* w = (char*)d_ws;
  size_t off = 0;
  p.mod = (float*)(w + off); off = align_up(off + (size_t)2 * 3 * 3072 * 4);
  p.wt_in_even = (u16*)(w + off); off = align_up(off + (size_t)IN_E * D * 2);
  p.wt_out_even = (u16*)(w + off); off = align_up(off + (size_t)D * D * 2);
  p.wt_in_odd = (u16*)(w + off); off = align_up(off + (size_t)IN_O * D * 2);
  p.wt_out_odd = (u16*)(w + off); off = align_up(off + (size_t)D * D * 2);
  p.wpt = (u16*)(w + off); off = align_up(off + (size_t)4 * 128 * 128 * 2);
  p.h = (u16*)(w + off); off = align_up(off + (size_t)NTOK * D * 2);
  p.proj = (u16*)(w + off); off = align_up(off + (size_t)NTOK * IN_O * 2);
  p.cat = (u16*)(w + off); off = align_up(off + (size_t)NTOK * D * 2);
  p.x1 = (float*)(w + off); off = align_up(off + (size_t)NTOK * D * 4);
  p.kcb = (u16*)(w + off); off = align_up(off + (size_t)262144 * 2);
  p.vcb = (u16*)(w + off); off = align_up(off + (size_t)262144 * 2);
  p.rowss = (float*)(w + off); off = align_up(off + (size_t)NTOK * 16 * 4);
  p.bias1 = (float*)(w + off); off = align_up(off + (size_t)3 * IN_O * 4);
  p.bar = (unsigned*)(w + off); off = align_up(off + (size_t)BAR_TOTAL_WORDS * 4);
  p.use_cg = 0ull;

#if MULTI_LAUNCH
  const int G = 1024;
  phase_kernel<0><<<G, NTHR, 0, stream>>>(p);
  phase_kernel<1><<<G, NTHR, 0, stream>>>(p);
  phase_kernel<2><<<G, NTHR, 0, stream>>>(p);
  phase_kernel<3><<<G, NTHR, 0, stream>>>(p);
  phase_kernel<4><<<G, NTHR, 0, stream>>>(p);
  phase_kernel<6><<<G, NTHR, 0, stream>>>(p);
  phase_kernel<7><<<G, NTHR, 0, stream>>>(p);
  phase_kernel<8><<<G, NTHR, 0, stream>>>(p);
  phase_kernel<9><<<G, NTHR, 0, stream>>>(p);
#else
  static int grid_blocks = 0;
  if (!grid_blocks) {
    int dev = 0, cus = 0, per_cu = 0;
    hipGetDevice(&dev);
    hipDeviceGetAttribute(&cus, hipDeviceAttributeMultiprocessorCount, dev);
    hipOccupancyMaxActiveBlocksPerMultiprocessor(&per_cu, mega_kernel, NTHR, 0);
    if (per_cu < 1) per_cu = 1;
    grid_blocks = cus * per_cu;
  }
  (void)hipMemsetAsync(p.bar, 0, (size_t)BAR_TOTAL_WORDS * 4, stream);
  void* args[] = {&p};
  hipError_t e = hipLaunchCooperativeKernel((void*)mega_kernel, dim3(grid_blocks), dim3(NTHR), args, 0, stream);
  if (e != hipSuccess) fprintf(stderr, "cooperative launch failed: %s (grid %d)\n", hipGetErrorString(e), grid_blocks);
#endif
}
```

```cpp
#include <hip/hip_runtime.h>
#include <hip/hip_cooperative_groups.h>
#include <cstdio>
namespace cg = cooperative_groups;

#define PROBE_REPEAT 0x00
#define PROBE_SYNC2 0
#ifndef MULTI_LAUNCH
#define MULTI_LAUNCH 0
#endif

typedef unsigned short u16;
using bf16x8 = __attribute__((ext_vector_type(8))) short;
using f32x4 = __attribute__((ext_vector_type(4))) float;
using u32x4 = __attribute__((ext_vector_type(4))) unsigned;
using u32x2 = __attribute__((ext_vector_type(2))) unsigned;

constexpr int D = 1024;
constexpr int NP = 4096;
constexpr int NS = 2048;
constexpr int NTOK = NP + NS;
constexpr int IN_E = 3072;
constexpr int IN_O = 3584;
constexpr int NTHR = 256;
constexpr int SMEM_BYTES = 64 * 1024;

struct P {
  const float *x_prompt, *x_sample, *cache_k, *cache_v, *c, *c_ctx, *norm_g, *w_mod, *b_mod, *w_in_even, *w_pool,
      *pool_scale, *rpb, *w_out_even, *w_in_odd, *conv_c, *conv_d, *conv_d_b, *ln_g, *ln_b, *w_out_odd, *final_g;
  float* out;
  float* mod;
  u16 *wt_in_even, *wt_out_even, *wt_in_odd, *wt_out_odd, *wpt;
  u16 *h, *proj, *cat;
  u16 *kcb, *vcb;
  float *rowss;
  float *bias1;
  float* x1;
  unsigned* bar;
  unsigned long long use_cg;
};

typedef __bf16 hbf2 __attribute__((ext_vector_type(2)));
typedef float hf2 __attribute__((ext_vector_type(2)));
__device__ __forceinline__ unsigned pack2(float a, float b) {
  const hf2 v = {a, b};
  return __builtin_bit_cast(unsigned, __builtin_convertvector(v, hbf2));
}
__device__ __forceinline__ u16 f2bf(float f) { return (u16)(pack2(f, 0.f) & 0xffffu); }
__device__ __forceinline__ float bf2f(u16 h) { return __uint_as_float(((unsigned)h) << 16); }
__device__ __forceinline__ float bflo(unsigned u) { return __uint_as_float(u << 16); }
__device__ __forceinline__ float bfhi(unsigned u) { return __uint_as_float(u & 0xffff0000u); }
__device__ __forceinline__ float silu_f(float x) { return x * __builtin_amdgcn_rcpf(1.f + __expf(-x)); }
__device__ __forceinline__ float sigmoid_f(float x) { return __builtin_amdgcn_rcpf(1.f + __expf(-x)); }
__device__ __forceinline__ float wave_sum(float v) {
#pragma unroll
  for (int o = 32; o >= 1; o >>= 1) v += __shfl_xor(v, o);
  return v;
}
__device__ __forceinline__ int cond_of_token(int tok) { return tok < NP ? 0 : 1 + ((tok - NP) >> 10); }

__device__ void mod_unit(const P& p, int u, float* sm) {
  const int layer = u / 96, cg32 = u % 96;
  const int tid = threadIdx.x;
  float* sc = sm;
  float* red = sm + 3 * 1024;
  __syncthreads();
#pragma unroll
  for (int q = 0; q < 12; ++q) {
    const int i = tid + q * NTHR;
    const int cv = i >> 10, k = i & 1023;
    const float v = (cv == 0) ? p.c_ctx[k] : p.c[(cv - 1) * 1024 + k];
    sc[i] = silu_f(v);
  }
  __syncthreads();
  const int cq = tid & 7, ks = tid >> 3;
  const float* W = p.w_mod + (size_t)layer * 1024 * 3072 + cg32 * 32 + cq * 4;
  float a[3][4] = {};
#pragma unroll 8
  for (int i = 0; i < 32; ++i) {
    int k = ks * 32 + i;
    using nf4 = __attribute__((ext_vector_type(4))) float;
    const nf4 wq = __builtin_nontemporal_load(reinterpret_cast<const nf4*>(W + (size_t)k * 3072));
    float4 w = make_float4(wq.x, wq.y, wq.z, wq.w);
#pragma unroll
    for (int cv = 0; cv < 3; ++cv) {
      float s = sc[cv * 1024 + k];
      a[cv][0] += s * w.x; a[cv][1] += s * w.y; a[cv][2] += s * w.z; a[cv][3] += s * w.w;
    }
  }
#pragma unroll
  for (int cv = 0; cv < 3; ++cv)
#pragma unroll
    for (int j = 0; j < 4; ++j) {
      float v = a[cv][j];
      v += __shfl_xor(v, 8); v += __shfl_xor(v, 16); v += __shfl_xor(v, 32);
      a[cv][j] = v;
    }
  const int lane = tid & 63, wid = tid >> 6;
  if (lane < 8) {
#pragma unroll
    for (int cv = 0; cv < 3; ++cv)
#pragma unroll
      for (int j = 0; j < 4; ++j) red[wid * 96 + cv * 32 + lane * 4 + j] = a[cv][j];
  }
  __syncthreads();
  if (tid < 96) {
    int cv = tid >> 5, col = tid & 31;
    float v = red[tid] + red[96 + tid] + red[192 + tid] + red[288 + tid];
    int n = cg32 * 32 + col;
    v += p.b_mod[layer * 3072 + n];
    p.mod[(layer * 3 + cv) * 3072 + n] = v;
  }
}

__device__ __forceinline__ int perm_row_general(int s) {
  const int tile = s >> 7, c = s & 127, wc = c >> 6, q = c & 63;
  const int n = ((q >> 5) << 1) | ((q >> 2) & 1), i = (((q >> 3) & 3) << 2) | (q & 3);
  return tile * 128 + wc * 64 + n * 16 + i;
}
__device__ __forceinline__ int perm_row_odd(int s) {
  if (s >= 3072) return perm_row_general(s);
  const int region = s >> 9, ch = s & 511;
  const int type = (region == 0 || region == 3) ? 0 : (region <= 2 ? 1 : 2);
  const int member = (region == 0 || region == 1 || region == 4) ? 0 : 1;
  const int chunk = ch >> 6, wc = (ch >> 5) & 1, cw = ch & 31;
  const int n = member * 2 + ((cw >> 2) & 1), i = ((cw >> 3) << 2) | (cw & 3);
  return (type * 8 + chunk) * 128 + wc * 64 + n * 16 + i;
}
template <int MODE>
__device__ void transpose_tile(const float* __restrict__ src, u16* __restrict__ dst, int K, int N, int t, float* sm) {
  const int tid = threadIdx.x;
  const int ntn = N >> 6;
  const int k0 = (t / ntn) * 64, n0 = (t % ntn) * 64;
  __syncthreads();
  {
    const int r = tid >> 4, c4 = tid & 15;
#pragma unroll
    for (int i = 0; i < 4; ++i) {
      int k = r + 16 * i;
      using nf4 = __attribute__((ext_vector_type(4))) float;
      const nf4 vq = __builtin_nontemporal_load(reinterpret_cast<const nf4*>(src + (size_t)(k0 + k) * N + n0 + c4 * 4));
      float4 v = make_float4(vq.x, vq.y, vq.z, vq.w);
      float* d = sm + k * 65 + c4 * 4;
      d[0] = v.x; d[1] = v.y; d[2] = v.z; d[3] = v.w;
    }
  }
  __syncthreads();
  {
    const int kc = tid & 7, nl = tid >> 3;
#pragma unroll
    for (int i = 0; i < 2; ++i) {
      int n = nl + 32 * i;
      float v[8];
#pragma unroll
      for (int j = 0; j < 8; ++j) v[j] = sm[(kc * 8 + j) * 65 + n];
      u32x4 o;
      o.x = pack2(v[0], v[1]); o.y = pack2(v[2], v[3]); o.z = pack2(v[4], v[5]); o.w = pack2(v[6], v[7]);
      const int drow = MODE == 0 ? (n0 + n) : (MODE == 1 ? perm_row_general(n0 + n) : perm_row_odd(n0 + n));
      *reinterpret_cast<u32x4*>(dst + (size_t)drow * K + k0 + kc * 8) = o;
    }
  }
}

__device__ void phase0(const P& p, char* smem) {
  float* sm = reinterpret_cast<float*>(smem);
  constexpr int T0 = 192, T1 = T0 + 768, T2 = T1 + 256, T3 = T2 + 896, T4 = T3 + 256, T5 = T4 + 16;
  for (int u = blockIdx.x; u < T5; u += gridDim.x) {
    if (u < T0) mod_unit(p, u, sm);
    else if (u < T1) transpose_tile<1>(p.w_in_even, p.wt_in_even, 1024, 3072, u - T0, sm);
    else if (u < T2) transpose_tile<1>(p.w_out_even, p.wt_out_even, 1024, 1024, u - T1, sm);
    else if (u < T3) transpose_tile<2>(p.w_in_odd, p.wt_in_odd, 1024, 3584, u - T2, sm);
    else if (u < T4) transpose_tile<1>(p.w_out_odd, p.wt_out_odd, 1024, 1024, u - T3, sm);
    else { int t = u - T4; int g = t >> 2; transpose_tile<0>(p.w_pool + g * 16384, p.wpt + g * 16384, 128, 128, t & 3, sm); }
  }
}

__device__ void phase_norm(const P& p, int layer, const float* xa, const float* xb) {
  const int lane = threadIdx.x & 63, wid = threadIdx.x >> 6;
  if (layer == 0) {
    for (int prow = blockIdx.x * 4 + wid; prow < IN_O; prow += gridDim.x * 4) {
      const u16* wrow = p.wt_in_odd + (size_t)prow * D + lane * 16;
      const u32x4 w0 = *reinterpret_cast<const u32x4*>(wrow), w1 = *reinterpret_cast<const u32x4*>(wrow + 8);
      const float wf[16] = {bflo(w0.x), bfhi(w0.x), bflo(w0.y), bfhi(w0.y), bflo(w0.z), bfhi(w0.z), bflo(w0.w), bfhi(w0.w),
                            bflo(w1.x), bfhi(w1.x), bflo(w1.y), bfhi(w1.y), bflo(w1.z), bfhi(w1.z), bflo(w1.w), bfhi(w1.w)};
#pragma unroll
      for (int cv = 0; cv < 3; ++cv) {
        const float* sh = p.mod + (size_t)(3 + cv) * 3072 + lane * 16;
        float a = 0.f;
#pragma unroll
        for (int q = 0; q < 4; ++q) {
          const float4 s4 = *reinterpret_cast<const float4*>(sh + q * 4);
          a += s4.x * wf[q * 4] + s4.y * wf[q * 4 + 1] + s4.z * wf[q * 4 + 2] + s4.w * wf[q * 4 + 3];
        }
        a = wave_sum(a);
        if (lane == 0) p.bias1[cv * IN_O + prow] = a;
      }
    }
    for (int i = blockIdx.x * NTHR + threadIdx.x; i < 2 * 32768; i += gridDim.x * NTHR) {
      const float* src = (i < 32768 ? p.cache_k : p.cache_v) + (size_t)(i & 32767) * 8;
      u16* dst = (i < 32768 ? p.kcb : p.vcb) + (size_t)(i & 32767) * 8;
      const float4 a = *reinterpret_cast<const float4*>(src), c = *reinterpret_cast<const float4*>(src + 4);
      u32x4 o; o.x = pack2(a.x, a.y); o.y = pack2(a.z, a.w); o.z = pack2(c.x, c.y); o.w = pack2(c.z, c.w);
      *reinterpret_cast<u32x4*>(dst) = o;
    }
  }
  const float* g = p.norm_g + layer * 1024;
  const bool xpart = (gridDim.x & 7) == 0;
  const int nrow = xpart ? 768 : NTOK, rstep = xpart ? (int)(gridDim.x >> 3) * 4 : (int)gridDim.x * 4;
  for (int rr = (xpart ? (int)(blockIdx.x >> 3) : (int)blockIdx.x) * 4 + wid; rr < nrow; rr += rstep) {
    const int tok = xpart ? (int)(blockIdx.x & 7) * 768 + rr : rr;
    const float* x = tok < NP ? xa + (size_t)tok * D : xb + (size_t)(tok - NP) * D;
    const float* m = p.mod + (size_t)(layer * 3 + cond_of_token(tok)) * 3072;
    float4 v[4], ggv[4], shv[4], scv[4];
    float ss = 0.f;
#pragma unroll
    for (int i = 0; i < 4; ++i) {
      const int k = i * 256 + lane * 4;
      v[i] = *reinterpret_cast<const float4*>(x + k);
      ggv[i] = *reinterpret_cast<const float4*>(g + k);
      shv[i] = *reinterpret_cast<const float4*>(m + k);
      scv[i] = *reinterpret_cast<const float4*>(m + 1024 + k);
    }
#pragma unroll
    for (int i = 0; i < 4; ++i) ss += v[i].x * v[i].x + v[i].y * v[i].y + v[i].z * v[i].z + v[i].w * v[i].w;
    ss = wave_sum(ss);
    const float rinv = rsqrtf(ss * (1.f / 1024.f) + 1e-6f);
#pragma unroll
    for (int i = 0; i < 4; ++i) {
      const int k = i * 256 + lane * 4;
      const float4 gg = ggv[i], sh = shv[i], sc = scv[i];
      float h0 = v[i].x * rinv * gg.x * (1.f + sc.x) + sh.x;
      float h1 = v[i].y * rinv * gg.y * (1.f + sc.y) + sh.y;
      float h2 = v[i].z * rinv * gg.z * (1.f + sc.z) + sh.z;
      float h3 = v[i].w * rinv * gg.w * (1.f + sc.w) + sh.w;
      u32x2 o; o.x = pack2(h0, h1); o.y = pack2(h2, h3);
      *reinterpret_cast<u32x2*>(p.h + (size_t)tok * D + k) = o;
    }
  }
}

template <int EPI, int BM>
__device__ void gemm_phase(const P& p, const u16* __restrict__ A, const u16* __restrict__ Bt, int N, char* smem) {
  constexpr int K = 1024, BK = 64;
  const int tid = threadIdx.x, wid = tid >> 6, lane = tid & 63, wr = wid >> 1, wc = wid & 1, fr = lane & 15, fq = lane >> 4;
  const int NT = N >> 7;
  constexpr int MI = BM / 32;
  constexpr int NAL = BM / 32;
  const int ntiles = (NTOK / BM) * NT;
  const int srow = tid >> 3;
  const int schunk = (tid & 7) ^ ((tid >> 4) & 7);
  const bool xpart = (gridDim.x & 7) == 0;
  constexpr int MPX = 768 / BM;
  const int xcd = blockIdx.x & 7;
  const int jfirst = xpart ? (int)(blockIdx.x >> 3) : (int)blockIdx.x;
  const int jstep = xpart ? (int)(gridDim.x >> 3) : (int)gridDim.x;
  const int jend = xpart ? MPX * NT : ntiles;
  const u16* ga = nullptr; const u16* gb = nullptr;
  if (jfirst < jend) {
    const int mt0 = xpart ? xcd * MPX + jfirst % MPX : jfirst / NT, nt0 = xpart ? jfirst / MPX : jfirst % NT;
    ga = A + (size_t)(mt0 * BM + srow) * K + schunk * 8;
    gb = Bt + (size_t)(nt0 * 128 + srow) * K + schunk * 8;
    __syncthreads();
#pragma unroll
    for (int i = 0; i < NAL; ++i)
      __builtin_amdgcn_global_load_lds((const unsigned*)(ga + (size_t)(32 * i) * K), (unsigned*)(smem + i * 4096 + tid * 16), 16, 0, 0);
#pragma unroll
    for (int i = 0; i < 4; ++i)
      __builtin_amdgcn_global_load_lds((const unsigned*)(gb + (size_t)(32 * i) * K), (unsigned*)(smem + 16384 + i * 4096 + tid * 16), 16, 0, 0);
  }
  for (int tile = jfirst; tile < jend; tile += jstep) {
    const int mt = xpart ? xcd * MPX + tile % MPX : tile / NT, nt = xpart ? tile / MPX : tile % NT;
    const int brow = mt * BM, bcol = nt * 128;
    f32x4 acc[MI][4] = {};
    for (int t = 0; t < K / BK; ++t) {
      char* SA = smem + (t & 1) * 32768;
      char* SB = SA + 16384;
      asm volatile("s_waitcnt vmcnt(0)" ::: "memory");
      __syncthreads();
      if (t + 1 < K / BK) {
        char* NA = smem + ((t + 1) & 1) * 32768;
#pragma unroll
        for (int i = 0; i < NAL; ++i)
          __builtin_amdgcn_global_load_lds((const unsigned*)(ga + (size_t)(32 * i) * K + (t + 1) * BK), (unsigned*)(NA + i * 4096 + tid * 16), 16, 0, 0);
#pragma unroll
        for (int i = 0; i < 4; ++i)
          __builtin_amdgcn_global_load_lds((const unsigned*)(gb + (size_t)(32 * i) * K + (t + 1) * BK), (unsigned*)(NA + 16384 + i * 4096 + tid * 16), 16, 0, 0);
      } else {
        const int tn = tile + jstep;
        if (tn < jend) {
          const int mtn = xpart ? xcd * MPX + tn % MPX : tn / NT, ntn = xpart ? tn / MPX : tn % NT;
          ga = A + (size_t)(mtn * BM + srow) * K + schunk * 8;
          gb = Bt + (size_t)(ntn * 128 + srow) * K + schunk * 8;
#pragma unroll
          for (int i = 0; i < NAL; ++i)
            __builtin_amdgcn_global_load_lds((const unsigned*)(ga + (size_t)(32 * i) * K), (unsigned*)(smem + i * 4096 + tid * 16), 16, 0, 0);
#pragma unroll
          for (int i = 0; i < 4; ++i)
            __builtin_amdgcn_global_load_lds((const unsigned*)(gb + (size_t)(32 * i) * K), (unsigned*)(smem + 16384 + i * 4096 + tid * 16), 16, 0, 0);
        }
      }
      {
        bf16x8 af[2][MI], bfr[2][4];
#pragma unroll
        for (int kk = 0; kk < 2; ++kk) {
#pragma unroll
          for (int n = 0; n < 4; ++n) {
            const int r = wc * 64 + n * 16 + fr;
            bfr[kk][n] = *reinterpret_cast<const bf16x8*>(SB + r * 128 + (((kk * 4 + fq) ^ ((r >> 1) & 7)) << 4));
          }
#pragma unroll
          for (int m = 0; m < MI; ++m) {
            const int r = wr * (BM / 2) + m * 16 + fr;
            af[kk][m] = *reinterpret_cast<const bf16x8*>(SA + r * 128 + (((kk * 4 + fq) ^ ((r >> 1) & 7)) << 4));
          }
        }
#pragma unroll
        for (int kk = 0; kk < 2; ++kk)
#pragma unroll
          for (int m = 0; m < MI; ++m)
#pragma unroll
            for (int n = 0; n < 4; ++n) acc[m][n] = __builtin_amdgcn_mfma_f32_16x16x32_bf16(bfr[kk][n], af[kk][m], acc[m][n], 0, 0, 0);
        __builtin_amdgcn_sched_group_barrier(0x100, MI + 4, 0);
#pragma unroll
        for (int i = 0; i < MI + 4; ++i) {
          __builtin_amdgcn_sched_group_barrier(0x008, 2, 0);
          __builtin_amdgcn_sched_group_barrier(0x100, 1, 0);
        }
        __builtin_amdgcn_sched_group_barrier(0x008, 8 * MI - 2 * (MI + 4), 0);
      }
    }
    if (EPI == 0) {
      const bool gate_tile = (nt >= 4 && nt < 8) || nt >= 20;
#pragma unroll
      for (int m = 0; m < MI; ++m) {
        const int row = brow + wr * (BM / 2) + m * 16 + fr;
#pragma unroll
        for (int np = 0; np < 2; ++np) {
          const int col = bcol + wc * 64 + np * 32 + fq * 8;
          float v[8];
#pragma unroll
          for (int j = 0; j < 4; ++j) { v[j] = acc[m][np * 2][j]; v[4 + j] = acc[m][np * 2 + 1][j]; }
          if (gate_tile) {
#pragma unroll
            for (int j = 0; j < 8; ++j) v[j] = silu_f(v[j]);
          }
          u32x4 o; o.x = pack2(v[0], v[1]); o.y = pack2(v[2], v[3]); o.z = pack2(v[4], v[5]); o.w = pack2(v[6], v[7]);
          *reinterpret_cast<u32x4*>(p.proj + (size_t)row * IN_E + col) = o;
          if (brow < NP && nt >= 12 && nt < 20) {
            const bool isv = nt >= 16;
            float* dst = p.out + (size_t)NTOK * D + (isv ? (size_t)16 * 8 * 256 * 64 : 0);
            const int cc = col - (isv ? 2048 : 1536);
            const int b = row >> 8, tt = row & 255, hh = cc >> 6, dd = cc & 63;
            float* d2 = dst + (((size_t)b * 8 + hh) * 256 + tt) * 64 + dd;
            *reinterpret_cast<float4*>(d2) = make_float4(v[0], v[1], v[2], v[3]);
            *reinterpret_cast<float4*>(d2 + 4) = make_float4(v[4], v[5], v[6], v[7]);
          }
        }
      }
    } else if (EPI == 2) {
      {
        float rinv[MI];
        int cvm[MI];
#pragma unroll
        for (int m = 0; m < MI; ++m) {
          const int row = brow + wr * (BM / 2) + m * 16 + fr;
          cvm[m] = cond_of_token(row);
          const float* rs = p.rowss + (size_t)row * 16;
          const float4 a = *reinterpret_cast<const float4*>(rs), b2 = *reinterpret_cast<const float4*>(rs + 4);
          const float4 c2 = *reinterpret_cast<const float4*>(rs + 8), d2 = *reinterpret_cast<const float4*>(rs + 12);
          const float tot = (a.x + a.y + a.z + a.w) + (b2.x + b2.y + b2.z + b2.w) + (c2.x + c2.y + c2.z + c2.w) + (d2.x + d2.y + d2.z + d2.w);
          rinv[m] = rsqrtf(tot * (1.f / 1024.f) + 1e-6f);
        }
#pragma unroll
        for (int n = 0; n < 4; ++n) {
#pragma unroll
          for (int m = 0; m < MI; ++m) {
            const float4 bz = *reinterpret_cast<const float4*>(p.bias1 + (size_t)cvm[m] * IN_O + bcol + wc * 64 + n * 16 + fq * 4);
            acc[m][n][0] = acc[m][n][0] * rinv[m] + bz.x; acc[m][n][1] = acc[m][n][1] * rinv[m] + bz.y;
            acc[m][n][2] = acc[m][n][2] * rinv[m] + bz.z; acc[m][n][3] = acc[m][n][3] * rinv[m] + bz.w;
          }
        }
      }
      if (nt < 24) {
        const int type = nt >> 3, chunk = nt & 7;
#pragma unroll
        for (int m = 0; m < MI; ++m) {
          const int row = brow + wr * (BM / 2) + m * 16 + fr;
          float v[8];
#pragma unroll
          for (int nl = 0; nl < 2; ++nl)
#pragma unroll
            for (int j = 0; j < 4; ++j) {
              const float a = acc[m][nl][j], b = acc[m][2 + nl][j];
              v[nl * 4 + j] = type == 0 ? a * silu_f(b) : (type == 1 ? a * b : a * sigmoid_f(b));
            }
          u32x4 o; o.x = pack2(v[0], v[1]); o.y = pack2(v[2], v[3]); o.z = pack2(v[4], v[5]); o.w = pack2(v[6], v[7]);
          *reinterpret_cast<u32x4*>(p.proj + (size_t)row * 2048 + type * 512 + chunk * 64 + wc * 32 + fq * 8) = o;
        }
      } else {
#pragma unroll
        for (int m = 0; m < MI; ++m) {
          const int row = brow + wr * (BM / 2) + m * 16 + fr;
#pragma unroll
          for (int np = 0; np < 2; ++np) {
            float v[8];
#pragma unroll
            for (int j = 0; j < 4; ++j) { v[j] = silu_f(acc[m][np * 2][j]); v[4 + j] = silu_f(acc[m][np * 2 + 1][j]); }
            u32x4 o; o.x = pack2(v[0], v[1]); o.y = pack2(v[2], v[3]); o.z = pack2(v[4], v[5]); o.w = pack2(v[6], v[7]);
            *reinterpret_cast<u32x4*>(p.proj + (size_t)row * 2048 + 1536 + (nt - 24) * 128 + wc * 64 + np * 32 + fq * 8) = o;
          }
        }
      }
    } else {
      const int layer = (EPI == 1) ? 0 : 1;
      float ssq[MI] = {};
#pragma unroll
      for (int np = 0; np < 2; ++np) {
        const int col = bcol + wc * 64 + np * 32 + fq * 8;
        float4 n0 = {}, n1 = {};
        if (EPI == 1) { n0 = *reinterpret_cast<const float4*>(p.norm_g + 1024 + col); n1 = *reinterpret_cast<const float4*>(p.norm_g + 1024 + col + 4); }
#pragma unroll
        for (int m = 0; m < MI; ++m) {
          const int row = brow + wr * (BM / 2) + m * 16 + fr;
          const int cv = cond_of_token(row);
          const float* gate = p.mod + (size_t)(layer * 3 + cv) * 3072 + 2048 + col;
          const float4 g0 = *reinterpret_cast<const float4*>(gate);
          const float4 g1 = *reinterpret_cast<const float4*>(gate + 4);
          const float* xin = (EPI == 1) ? (row < NP ? p.x_prompt + (size_t)row * D + col : p.x_sample + (size_t)(row - NP) * D + col)
                                        : p.x1 + (size_t)row * D + col;
          const float4 x0 = *reinterpret_cast<const float4*>(xin);
          const float4 x1v = *reinterpret_cast<const float4*>(xin + 4);
          float4 o0, o1;
          o0.x = x0.x + g0.x * acc[m][np * 2][0]; o0.y = x0.y + g0.y * acc[m][np * 2][1];
          o0.z = x0.z + g0.z * acc[m][np * 2][2]; o0.w = x0.w + g0.w * acc[m][np * 2][3];
          o1.x = x1v.x + g1.x * acc[m][np * 2 + 1][0]; o1.y = x1v.y + g1.y * acc[m][np * 2 + 1][1];
          o1.z = x1v.z + g1.z * acc[m][np * 2 + 1][2]; o1.w = x1v.w + g1.w * acc[m][np * 2 + 1][3];
          float* xo = p.x1 + (size_t)row * D + col;
          *reinterpret_cast<float4*>(xo) = o0;
          *reinterpret_cast<float4*>(xo + 4) = o1;
          if (EPI == 1) {
            const float* sc = p.mod + (size_t)(3 + cv) * 3072 + 1024 + col;
            const float4 s0 = *reinterpret_cast<const float4*>(sc), s1 = *reinterpret_cast<const float4*>(sc + 4);
            ssq[m] += o0.x * o0.x + o0.y * o0.y + o0.z * o0.z + o0.w * o0.w + o1.x * o1.x + o1.y * o1.y + o1.z * o1.z + o1.w * o1.w;
            u32x4 hv;
            hv.x = pack2(o0.x * n0.x * (1.f + s0.x), o0.y * n0.y * (1.f + s0.y)); hv.y = pack2(o0.z * n0.z * (1.f + s0.z), o0.w * n0.w * (1.f + s0.w));
            hv.z = pack2(o1.x * n1.x * (1.f + s1.x), o1.y * n1.y * (1.f + s1.y)); hv.w = pack2(o1.z * n1.z * (1.f + s1.z), o1.w * n1.w * (1.f + s1.w));
            *reinterpret_cast<u32x4*>(p.h + (size_t)row * D + col) = hv;
          }
        }
      }
      if (EPI == 1) {
#pragma unroll
        for (int m = 0; m < MI; ++m) {
          float v = ssq[m];
          v += __shfl_xor(v, 16); v += __shfl_xor(v, 32);
          if (fq == 0) p.rowss[(size_t)(brow + wr * (BM / 2) + m * 16 + fr) * 16 + nt * 2 + wc] = v;
        }
      }
    }
  }
}

template <int MODE>
__device__ void attn_unit(const P& p, int u, char* smem) {
  const int tid = threadIdx.x, wid = tid >> 6, lane = tid & 63, fr = lane & 15, fq = lane >> 4;
  char* Ks = smem;
  u16* Vt = reinterpret_cast<u16*>(smem + 16384);
  float* rpl = reinterpret_cast<float*>(smem + 16384 + 18432);
  int h, qtok0, b, r = 0;
  if (MODE == 0) { b = u >> 5; h = (u >> 2) & 7; qtok0 = b * 256 + (u & 3) * 64; }
  else { b = u >> 7; r = (u >> 3) & 15; h = u & 7; qtok0 = NP + b * 1024 + r * 64; }
  constexpr int NSS = MODE == 0 ? 2 : 6;
  const int c0 = wid * 16;
  int ksc = c0 - 8; ksc = ksc < 0 ? 0 : (ksc > 32 ? 32 : ksc);
  const int rs = (r - 4) < 0 ? 0 : ((r - 4) > 8 ? 8 : (r - 4));
  bf16x8 qf[2];
  {
    const u16* q = p.proj + (size_t)(qtok0 + wid * 16 + fr) * IN_E + 1024 + h * 64 + fq * 8;
    qf[0] = *reinterpret_cast<const bf16x8*>(q);
    qf[1] = *reinterpret_cast<const bf16x8*>(q + 32);
  }
  u32x2 gbv[4];
#pragma unroll
  for (int dt = 0; dt < 4; ++dt)
    gbv[dt] = *reinterpret_cast<const u32x2*>(p.proj + (size_t)(qtok0 + wid * 16 + fr) * IN_E + 2560 + h * 64 + dt * 16 + fq * 4);
  const int cq = c0 + fr;
  int cstart = cq - 8; cstart = cstart < 0 ? 0 : (cstart > 48 ? 48 : cstart);
  float mrun = -1e30f, lrun = 0.f;
  f32x4 o[4] = {};
  const float scale = 0.125f;
  const int krow = tid >> 3, kchunk = tid & 7;
  const int vkey = tid & 127, vdh = tid >> 7;
  u32x4 kr[4], vr[4];
  auto prefetch = [&](int ss) {
    const u16* kb; const u16* vb; int ld;
    if (MODE == 0) { kb = p.proj + (size_t)(b * 256 + ss * 128) * IN_E + 1536 + h * 64; vb = kb + 512; ld = IN_E; }
    else if (ss < 4) { kb = p.proj + (size_t)(NP + b * 1024 + (rs + ss * 2) * 64) * IN_E + 1536 + h * 64; vb = kb + 512; ld = IN_E; }
    else { kb = p.kcb + ((size_t)(b * 8 + h) * 256 + (ss - 4) * 128) * 64; vb = p.vcb + ((size_t)(b * 8 + h) * 256 + (ss - 4) * 128) * 64; ld = 64; }
#pragma unroll
    for (int i = 0; i < 4; ++i) kr[i] = *reinterpret_cast<const u32x4*>(kb + (size_t)(krow + 32 * i) * ld + kchunk * 8);
#pragma unroll
    for (int i = 0; i < 4; ++i) vr[i] = *reinterpret_cast<const u32x4*>(vb + (size_t)vkey * ld + vdh * 32 + i * 8);
  };
  prefetch(0);
  if (MODE == 1) {
    __syncthreads();
    for (int i = tid; i < 15 * 31; i += NTHR) rpl[i] = p.rpb[h * 465 + i];
  }
#pragma unroll 1
  for (int ss = 0; ss < NSS; ++ss) {
    const bool local = (MODE == 1 && ss < 4);
    __syncthreads();
#pragma unroll
    for (int i = 0; i < 4; ++i) {
      const int row = krow + 32 * i;
      *reinterpret_cast<u32x4*>(Ks + row * 128 + ((kchunk ^ ((row >> 1) & 7)) << 4)) = kr[i];
    }
    {
      u16* vt = Vt + (vkey >> 6) * 4608 + (vdh * 32) * 72 + (vkey & 63);
#pragma unroll
      for (int i = 0; i < 4; ++i) {
        const unsigned w[4] = {vr[i].x, vr[i].y, vr[i].z, vr[i].w};
#pragma unroll
        for (int j = 0; j < 4; ++j) {
          vt[(i * 8 + 2 * j) * 72] = (u16)(w[j] & 0xffff);
          vt[(i * 8 + 2 * j + 1) * 72] = (u16)(w[j] >> 16);
        }
      }
    }
    if (ss + 1 < NSS) prefetch(ss + 1);
    __syncthreads();
#pragma unroll
    for (int s2 = 0; s2 < 2; ++s2) {
      const u16* Vs = Vt + s2 * 4608;
      const int nchunk = local ? 1 : 2;
      const int kbase = local ? ksc : 0;
      const float* rp = rpl + (rs + ss * 2 + s2 - r + 7) * 31 + 15 - cq;
      for (int ch = 0; ch < nchunk; ++ch) {
        f32x4 sv[2];
#pragma unroll
        for (int t2 = 0; t2 < 2; ++t2) {
          const int koff = kbase + ch * 32 + t2 * 16;
          const int row = s2 * 64 + koff + fr;
          const int sw = (row >> 1) & 7;
          const bf16x8 kf0 = *reinterpret_cast<const bf16x8*>(Ks + row * 128 + ((fq ^ sw) << 4));
          const bf16x8 kf1 = *reinterpret_cast<const bf16x8*>(Ks + row * 128 + (((4 + fq) ^ sw) << 4));
          f32x4 z = {0.f, 0.f, 0.f, 0.f};
          z = __builtin_amdgcn_mfma_f32_16x16x32_bf16(kf0, qf[0], z, 0, 0, 0);
          z = __builtin_amdgcn_mfma_f32_16x16x32_bf16(kf1, qf[1], z, 0, 0, 0);
          if (local) {
#pragma unroll
            for (int j = 0; j < 4; ++j) {
              const int ck = koff + fq * 4 + j;
              int dcl = ck - cq; dcl = dcl < -15 ? -15 : (dcl > 15 ? 15 : dcl);
              const float bias = rp[dcl + cq];
              const bool ok = (ck >= cstart) && (ck < cstart + 16);
              z[j] = ok ? z[j] * scale + bias : -1e30f;
            }
          } else {
#pragma unroll
            for (int j = 0; j < 4; ++j) z[j] *= scale;
          }
          sv[t2] = z;
        }
        float mx = fmaxf(fmaxf(fmaxf(sv[0][0], sv[0][1]), fmaxf(sv[0][2], sv[0][3])), fmaxf(fmaxf(sv[1][0], sv[1][1]), fmaxf(sv[1][2], sv[1][3])));
        mx = fmaxf(mx, __shfl_xor(mx, 16));
        mx = fmaxf(mx, __shfl_xor(mx, 32));
        const float mnew = fmaxf(mrun, mx);
        const float corr = __expf(mrun - mnew);
        mrun = mnew;
        float pv[8];
        float psum = 0.f;
#pragma unroll
        for (int j = 0; j < 4; ++j) { pv[j] = __expf(sv[0][j] - mnew); pv[4 + j] = __expf(sv[1][j] - mnew); }
#pragma unroll
        for (int j = 0; j < 8; ++j) psum += pv[j];
        lrun = lrun * corr + psum;
        u32x4 pk;
        pk.x = pack2(pv[0], pv[1]); pk.y = pack2(pv[2], pv[3]); pk.z = pack2(pv[4], pv[5]); pk.w = pack2(pv[6], pv[7]);
        const bf16x8 pfrag = __builtin_bit_cast(bf16x8, pk);
        const int k0 = kbase + ch * 32;
#pragma unroll
        for (int dt = 0; dt < 4; ++dt) {
          const u16* vp = Vs + (dt * 16 + fr) * 72 + k0 + fq * 4;
          u32x2 v0 = *reinterpret_cast<const u32x2*>(vp);
          u32x2 v1 = *reinterpret_cast<const u32x2*>(vp + 16);
          u32x4 vv; vv.x = v0.x; vv.y = v0.y; vv.z = v1.x; vv.w = v1.y;
          f32x4 oo = o[dt];
          oo[0] *= corr; oo[1] *= corr; oo[2] *= corr; oo[3] *= corr;
          o[dt] = __builtin_amdgcn_mfma_f32_16x16x32_bf16(__builtin_bit_cast(bf16x8, vv), pfrag, oo, 0, 0, 0);
        }
      }
    }
  }
  lrun += __shfl_xor(lrun, 16);
  lrun += __shfl_xor(lrun, 32);
  const float linv = 1.f / lrun;
  const int tok = qtok0 + wid * 16 + fr;
#pragma unroll
  for (int dt = 0; dt < 4; ++dt) {
    const int dd = h * 64 + dt * 16 + fq * 4;
    const u32x2 gb = gbv[dt];
    float r0 = o[dt][0] * linv * bflo(gb.x);
    float r1 = o[dt][1] * linv * bfhi(gb.x);
    float r2 = o[dt][2] * linv * bflo(gb.y);
    float r3 = o[dt][3] * linv * bfhi(gb.y);
    u32x2 ov; ov.x = pack2(r0, r1); ov.y = pack2(r2, r3);
    *reinterpret_cast<u32x2*>(p.cat + (size_t)tok * D + 512 + dd) = ov;
  }
}

template <int G>
__device__ void pool_unit(const P& p, int tile, char* smem) {
  constexpr int HALF = 1 << G;
  constexpr int NR = 64 + 2 * HALF;
  int tid = threadIdx.x;
  asm volatile("" : "+v"(tid));
  const int wid = tid >> 6, lane = tid & 63, fr = lane & 15, fq = lane >> 4;
  char* U = smem;
  char* W = smem + 80 * 272;
  const int T0 = tile * 64;
  int sb, se;
  if (T0 < NP) { sb = T0 & ~255; se = sb + 256; } else { sb = NP + ((T0 - NP) & ~1023); se = sb + 1024; }
  __syncthreads();
  {
    constexpr int NIT = (NR * 16 + NTHR - 1) / NTHR;
    u32x4 sv[NIT];
#pragma unroll
    for (int i = 0; i < NIT; ++i) {
      const int c = tid + i * NTHR, rr = c >> 4, c16 = c & 15;
      int tt = T0 - HALF + rr; tt = tt < sb ? sb : (tt >= se ? se - 1 : tt);
      sv[i] = *reinterpret_cast<const u32x4*>(p.proj + (size_t)tt * IN_E + G * 128 + c16 * 8);
    }
#pragma unroll
    for (int i = 0; i < NIT; ++i) {
      const int c = tid + i * NTHR, rr = c >> 4, c16 = c & 15;
      if (c < NR * 16) *reinterpret_cast<u32x4*>(U + rr * 272 + c16 * 16) = sv[i];
    }
  }
#pragma unroll
  for (int i = 0; i < 8; ++i) {
    const int c = tid + i * NTHR, rr = c >> 4, c16 = c & 15;
    *reinterpret_cast<u32x4*>(W + rr * 272 + c16 * 16) = *reinterpret_cast<const u32x4*>(p.wpt + (size_t)G * 16384 + rr * 128 + c16 * 8);
  }
  __syncthreads();
  const int t = T0 + wid * 16 + fr;
  int lo = t - HALF; lo = lo < sb ? sb : lo;
  int hi = t + HALF; hi = hi > se ? se : hi;
  const float inv = 1.f / (float)(hi - lo);
  f32x4 acc[8] = {};
#pragma unroll 1
  for (int ks = 0; ks < 4; ++ks) {
    const char* ub = U + (wid * 16 + fr) * 272 + (ks * 4 + fq) * 16;
    float sum[8] = {};
#pragma unroll
    for (int i = 0; i < 2 * HALF; ++i) {
      const int tt = t - HALF + i;
      const float m = (tt >= lo && tt < hi) ? 1.f : 0.f;
      const u32x4 w2 = *reinterpret_cast<const u32x4*>(ub + i * 272);
      sum[0] += m * bflo(w2.x); sum[1] += m * bfhi(w2.x); sum[2] += m * bflo(w2.y); sum[3] += m * bfhi(w2.y);
      sum[4] += m * bflo(w2.z); sum[5] += m * bfhi(w2.z); sum[6] += m * bflo(w2.w); sum[7] += m * bfhi(w2.w);
    }
    const u32x4 w = *reinterpret_cast<const u32x4*>(ub + HALF * 272);
    const float uu[8] = {bflo(w.x), bfhi(w.x), bflo(w.y), bfhi(w.y), bflo(w.z), bfhi(w.z), bflo(w.w), bfhi(w.w)};
    u32x4 pk;
    pk.x = pack2(sum[0] * inv - uu[0], sum[1] * inv - uu[1]);
    pk.y = pack2(sum[2] * inv - uu[2], sum[3] * inv - uu[3]);
    pk.z = pack2(sum[4] * inv - uu[4], sum[5] * inv - uu[5]);
    pk.w = pack2(sum[6] * inv - uu[6], sum[7] * inv - uu[7]);
    const bf16x8 af = __builtin_bit_cast(bf16x8, pk);
#pragma unroll
    for (int n = 0; n < 8; ++n) {
      const bf16x8 bfr = *reinterpret_cast<const bf16x8*>(W + (n * 16 + fr) * 272 + (ks * 4 + fq) * 16);
      acc[n] = __builtin_amdgcn_mfma_f32_16x16x32_bf16(bfr, af, acc[n], 0, 0, 0);
    }
  }
#pragma unroll
  for (int n = 0; n < 8; ++n) {
    const int dd = G * 128 + n * 16 + fq * 4;
    const float4 ps = *reinterpret_cast<const float4*>(p.pool_scale + dd);
    const u32x2 ga = *reinterpret_cast<const u32x2*>(p.proj + (size_t)t * IN_E + 512 + dd);
    u32x2 ov;
    ov.x = pack2(acc[n][0] * ps.x * bflo(ga.x), acc[n][1] * ps.y * bfhi(ga.x));
    ov.y = pack2(acc[n][2] * ps.z * bflo(ga.y), acc[n][3] * ps.w * bfhi(ga.y));
    *reinterpret_cast<u32x2*>(p.cat + (size_t)t * D + dd) = ov;
  }
}

__device__ void phase_even_mix(const P& p, char* smem) {
  if (gridDim.x == 512) {
    const int bx = blockIdx.x;
    if (bx < 256) {
      attn_unit<1>(p, bx, smem);
      const int g = (bx >> 3) & 3, tile = (bx & 7) * 12 + (bx >> 5);
      if (g == 0) pool_unit<0>(p, tile, smem); else if (g == 1) pool_unit<1>(p, tile, smem); else if (g == 2) pool_unit<2>(p, tile, smem); else pool_unit<3>(p, tile, smem);
    } else {
      attn_unit<0>(p, (bx - 256) * 2, smem);
      attn_unit<0>(p, (bx - 256) * 2 + 1, smem);
      if (bx < 384) {
        const int g = (bx >> 3) & 3, tile = (bx & 7) * 12 + (bx >> 5);
        if (g == 0) pool_unit<0>(p, tile, smem); else if (g == 1) pool_unit<1>(p, tile, smem); else if (g == 2) pool_unit<2>(p, tile, smem); else pool_unit<3>(p, tile, smem);
      }
    }
    return;
  }
  constexpr int U_N = 256, U_C = 512, U_P = 384;
  for (int u = blockIdx.x; u < U_N + U_C + U_P; u += gridDim.x) {
    if (u < U_N) attn_unit<1>(p, u, smem);
    else if (u < U_N + U_C) attn_unit<0>(p, u - U_N, smem);
    else {
      const int q = u - U_N - U_C, g = q & 3, tile = q >> 2;
      if (g == 0) pool_unit<0>(p, tile, smem); else if (g == 1) pool_unit<1>(p, tile, smem); else if (g == 2) pool_unit<2>(p, tile, smem); else pool_unit<3>(p, tile, smem);
    }
  }
}

__device__ void odd_unit(const P& p, int u, char* smem) {
  int tid = threadIdx.x;
  asm volatile("" : "+v"(tid));
  const int lane = tid & 63, wid = tid >> 6;
  u16* G = reinterpret_cast<u16*>(smem);
  float* red = reinterpret_cast<float*>(smem + 46 * 1024);
  const int t0 = u * 16;
  int sb, se;
  if (t0 < NP) { sb = t0 & ~255; se = sb + 256; } else { sb = NP + ((t0 - NP) & ~1023); se = sb + 1024; }
  const int ch = tid * 2;
  u32x4 sv[12];
#pragma unroll
  for (int i = 0; i < 12; ++i) {
    const int c = tid + i * NTHR, rr = c >> 6, c16 = c & 63;
    const int tt = t0 - 15 + rr;
    sv[i] = u32x4{0u, 0u, 0u, 0u};
    if (c < 46 * 64 && tt >= sb && tt < se) sv[i] = *reinterpret_cast<const u32x4*>(p.proj + (size_t)tt * 2048 + 1024 + c16 * 8);
  }
  unsigned cxw[18], bww[16], gdw[16];
#pragma unroll
  for (int q = 0; q < 18; ++q) {
    const int tt = t0 + q - 1;
    cxw[q] = 0u;
    if (tt >= sb && tt < se) cxw[q] = *reinterpret_cast<const unsigned*>(p.proj + (size_t)tt * 2048 + 512 + ch);
  }
#pragma unroll
  for (int i = 0; i < 16; ++i) {
    bww[i] = *reinterpret_cast<const unsigned*>(p.proj + (size_t)(t0 + i) * 2048 + ch);
    gdw[i] = *reinterpret_cast<const unsigned*>(p.proj + (size_t)(t0 + i) * 2048 + 1536 + ch);
  }
  float2 w[31];
#pragma unroll
  for (int j = 0; j < 31; ++j) w[j] = *reinterpret_cast<const float2*>(p.conv_d + j * 512 + ch);
  const float2 bias = *reinterpret_cast<const float2*>(p.conv_d_b + ch);
  const float2 lg = *reinterpret_cast<const float2*>(p.ln_g + ch);
  const float2 lb = *reinterpret_cast<const float2*>(p.ln_b + ch);
  const float2 wc0 = *reinterpret_cast<const float2*>(p.conv_c + ch);
  const float2 wc1 = *reinterpret_cast<const float2*>(p.conv_c + 512 + ch);
  const float2 wc2 = *reinterpret_cast<const float2*>(p.conv_c + 1024 + ch);
  __syncthreads();
#pragma unroll
  for (int i = 0; i < 12; ++i) {
    const int c = tid + i * NTHR, rr = c >> 6, c16 = c & 63;
    if (c < 46 * 64) *reinterpret_cast<u32x4*>(G + rr * 512 + c16 * 8) = sv[i];
  }
#pragma unroll
  for (int i = 0; i < 16; ++i) {
    const int tok = t0 + i;
    const float c0 = bflo(bww[i]) * (wc0.x * bflo(cxw[i]) + wc1.x * bflo(cxw[i + 1]) + wc2.x * bflo(cxw[i + 2]));
    const float c1 = bfhi(bww[i]) * (wc0.y * bfhi(cxw[i]) + wc1.y * bfhi(cxw[i + 1]) + wc2.y * bfhi(cxw[i + 2]));
    *reinterpret_cast<unsigned*>(p.cat + (size_t)tok * D + ch) = pack2(c0, c1);
  }
  __syncthreads();
#pragma unroll
  for (int hf = 0; hf < 2; ++hf) {
    float2 z[8];
#pragma unroll
    for (int i = 0; i < 8; ++i) z[i] = bias;
    const u16* Gh = G + hf * 8 * 512 + ch;
#pragma unroll
    for (int r = 0; r < 38; ++r) {
      const unsigned gv = *reinterpret_cast<const unsigned*>(Gh + r * 512);
      const float g0 = bflo(gv), g1 = bfhi(gv);
#pragma unroll
      for (int i = 0; i < 8; ++i) {
        const int j = r - i;
        if (j >= 0 && j <= 30) { z[i].x += w[j].x * g0; z[i].y += w[j].y * g1; }
      }
    }
    float* rd = red + hf * 64;
#pragma unroll
    for (int i = 0; i < 8; ++i) {
      const float sv2 = wave_sum(z[i].x + z[i].y);
      if (lane == 0) rd[wid * 8 + i] = sv2;
    }
    __syncthreads();
    float mu[8];
#pragma unroll
    for (int i = 0; i < 8; ++i) mu[i] = (rd[i] + rd[8 + i] + rd[16 + i] + rd[24 + i]) * (1.f / 512.f);
#pragma unroll
    for (int i = 0; i < 8; ++i) {
      const float d0 = z[i].x - mu[i], d1 = z[i].y - mu[i];
      const float sv2 = wave_sum(d0 * d0 + d1 * d1);
      if (lane == 0) rd[32 + wid * 8 + i] = sv2;
    }
    __syncthreads();
#pragma unroll
    for (int i = 0; i < 8; ++i) {
      const float rstd = rsqrtf((rd[32 + i] + rd[40 + i] + rd[48 + i] + rd[56 + i]) * (1.f / 512.f) + 1e-6f);
      const int tok = t0 + hf * 8 + i;
      const unsigned gd = gdw[hf * 8 + i];
      const float l0 = (z[i].x - mu[i]) * rstd * lg.x + lb.x;
      const float l1 = (z[i].y - mu[i]) * rstd * lg.y + lb.y;
      *reinterpret_cast<unsigned*>(p.cat + (size_t)tok * D + 512 + ch) = pack2(silu_f(l0) * bflo(gd), silu_f(l1) * bfhi(gd));
    }
  }
}

__device__ void phase_odd_mix(const P& p, char* smem) {
  if ((gridDim.x & 7) == 0) {
    const int xcd = blockIdx.x & 7, gl = gridDim.x >> 3;
    for (int j = blockIdx.x >> 3; j < 48; j += gl) odd_unit(p, xcd * 48 + j, smem);
    return;
  }
  for (int u = blockIdx.x; u < NTOK / 16; u += gridDim.x) odd_unit(p, u, smem);
}

__device__ void phase_final(const P& p) {
  const int lane = threadIdx.x & 63, wid = threadIdx.x >> 6;
  const bool xpart = (gridDim.x & 7) == 0;
  const int nrow = xpart ? 768 : NTOK, rstep = xpart ? (int)(gridDim.x >> 3) * 4 : (int)gridDim.x * 4;
  for (int rr = (xpart ? (int)(blockIdx.x >> 3) : (int)blockIdx.x) * 4 + wid; rr < nrow; rr += rstep) {
    const int tok = xpart ? (int)(blockIdx.x & 7) * 768 + rr : rr;
    const float* x = p.x1 + (size_t)tok * D;
    float4 v[4];
    float ss = 0.f;
#pragma unroll
    for (int i = 0; i < 4; ++i) {
      v[i] = *reinterpret_cast<const float4*>(x + i * 256 + lane * 4);
      ss += v[i].x * v[i].x + v[i].y * v[i].y + v[i].z * v[i].z + v[i].w * v[i].w;
    }
    ss = wave_sum(ss);
    const float rinv = rsqrtf(ss * (1.f / 1024.f) + 1e-6f);
#pragma unroll
    for (int i = 0; i < 4; ++i) {
      const int k = i * 256 + lane * 4;
      float4 gg = *reinterpret_cast<const float4*>(p.final_g + k);
      float4 o = make_float4(v[i].x * rinv * gg.x, v[i].y * rinv * gg.y, v[i].z * rinv * gg.z, v[i].w * rinv * gg.w);
      *reinterpret_cast<float4*>(p.out + (size_t)tok * D + k) = o;
    }
  }
}

#define XB_TMO      128
#define XB_XCNT(j)  (256  + 64 * (j))
#define XB_XSUB(j)  (1280 + 64 * (j))
#define XB_XGEN(j)  (2304 + 64 * (j))
#define XB_TOP      3328
#define XB_TOPGEN   3392
#define XCD_BAR_WORDS 3456
#define XB_SPIN_CAP (1u << 18)
#define LAS __attribute__((address_space(3)))

__device__ __forceinline__ unsigned xb_ld(unsigned* p)              { return __hip_atomic_load(p, __ATOMIC_RELAXED, __HIP_MEMORY_SCOPE_AGENT); }
__device__ __forceinline__ unsigned xb_add(unsigned* p, unsigned v) { return __hip_atomic_fetch_add(p, v, __ATOMIC_RELAXED, __HIP_MEMORY_SCOPE_AGENT); }
__device__ __forceinline__ unsigned xb_xcc_id() { return (unsigned)__builtin_amdgcn_s_getreg((3 << 11) | 20) & 0xFu; }
#define XB_SPIN(cond, bar) do { unsigned _sp = 0; while (cond) { __builtin_amdgcn_s_sleep(1); \
    if ((++_sp & 255u) == 0u) { if (xb_ld(&(bar)[XB_TMO])) break; if (_sp > XB_SPIN_CAP) { atomicAdd(&(bar)[XB_TMO], 1u); break; } } } } while (0)

struct XcdBarrier {
    unsigned* bar; unsigned x;
    unsigned nloc, nx;
    volatile unsigned* st;
};

__device__ __forceinline__ XcdBarrier xcd_barrier_post(unsigned* bar, volatile unsigned* st) {
    XcdBarrier b; b.bar = bar; b.x = xb_xcc_id(); b.st = st; b.nloc = 0u; b.nx = 0u;
    if (threadIdx.x == 0) (void)xb_add(&bar[XB_XCNT(b.x)], 1u);
    return b;
}
__device__ __forceinline__ void xcd_barrier_complete(unsigned* bar, unsigned x, unsigned& nloc, unsigned& nx) {
    const unsigned G = gridDim.x * gridDim.y * gridDim.z;
    unsigned sum, cnt, mine, sp = 0u;
    for (;;) {
        sum = 0u; cnt = 0u; mine = 0u;
#pragma unroll
        for (unsigned j = 0; j < 16; ++j) { const unsigned c = xb_ld(&bar[XB_XCNT(j)]); sum += c; cnt += (c > 0u) ? 1u : 0u; mine = (j == x) ? c : mine; }
        if (sum == G) break;
        __builtin_amdgcn_s_sleep(1);
        if ((++sp & 255u) == 0u) { if (xb_ld(&bar[XB_TMO])) break; if (sp > XB_SPIN_CAP) { atomicAdd(&bar[XB_TMO], 1u); break; } }
    }
    nloc = mine > 0u ? mine : 1u; nx = cnt > 0u ? cnt : 1u;
}

__device__ __forceinline__ void xcd_barrier(XcdBarrier& b) {
    asm volatile("s_waitcnt vmcnt(0)" ::: "memory");
    __syncthreads();
    if (threadIdx.x == 0) {
        unsigned* bar = b.bar;
        __builtin_amdgcn_s_waitcnt(0);
        unsigned nloc = b.nloc, nx = b.nx;
        if (nloc == 0u) { xcd_barrier_complete(bar, b.x, nloc, nx); b.nloc = nloc; b.nx = nx; }
        const unsigned old = xb_add(&bar[XB_XSUB(b.x)], 1u);
        const unsigned gen = old / nloc;
        if (old + 1u == (gen + 1u) * nloc) {
            __builtin_amdgcn_fence(__ATOMIC_RELEASE, "agent");
            asm volatile("s_waitcnt vmcnt(0)" ::: "memory");
            const unsigned og = xb_add(&bar[XB_TOP], 1u);
            const unsigned tg = og / nx;
            if (og + 1u == (tg + 1u) * nx) xb_add(&bar[XB_TOPGEN], 1u);
            else XB_SPIN(xb_ld(&bar[XB_TOPGEN]) == tg, bar);
            __builtin_amdgcn_fence(__ATOMIC_ACQUIRE, "agent");
            xb_add(&bar[XB_XGEN(b.x)], 1u);
            asm volatile("s_waitcnt vmcnt(0)" ::: "memory");
        } else {
            XB_SPIN(xb_ld(&bar[XB_XGEN(b.x)]) == gen, bar);
            __builtin_amdgcn_fence(__ATOMIC_ACQUIRE, "agent");
            asm volatile("s_waitcnt vmcnt(0)" ::: "memory");
        }
    }
    __syncthreads();
}


template <int PH>
__device__ __forceinline__ void run_phase(const P& p, char* smem) {
  if (PH == 0) phase0(p, smem);
  if (PH == 1) phase_norm(p, 0, p.x_prompt, p.x_sample);
  if (PH == 2) gemm_phase<0, 128>(p, p.h, p.wt_in_even, IN_E, smem);
  if (PH == 3) phase_even_mix(p, smem);
  if (PH == 4) gemm_phase<1, 96>(p, p.cat, p.wt_out_even, D, smem);
  if (PH == 6) gemm_phase<2, 96>(p, p.h, p.wt_in_odd, IN_O, smem);
  if (PH == 7) phase_odd_mix(p, smem);
  if (PH == 8) gemm_phase<3, 96>(p, p.cat, p.wt_out_odd, D, smem);
  if (PH == 9) phase_final(p);
}

__global__ void __launch_bounds__(NTHR, 2) mega_kernel(P p) {
  __shared__ __attribute__((aligned(16))) char smem[SMEM_BYTES];
  cg::grid_group grid = cg::this_grid();
  XcdBarrier xb = xcd_barrier_post(p.bar, (volatile unsigned*)(p.bar + XCD_BAR_WORDS + 64 * blockIdx.x));
  if (p.use_cg) grid.sync();
#define RUNP(PH) do { run_phase<PH>(p, smem); if ((PROBE_REPEAT >> PH) & 1) { xcd_barrier(xb); run_phase<PH>(p, smem); } } while (0)
#define GSYNC() do { xcd_barrier(xb); if (PROBE_SYNC2) xcd_barrier(xb); } while (0)
  RUNP(0); GSYNC();
  RUNP(1); GSYNC();
  RUNP(2); GSYNC();
  RUNP(3); GSYNC();
  RUNP(4); GSYNC();
  RUNP(6); GSYNC();
  RUNP(7); GSYNC();
  run_phase<8>(p, smem); GSYNC();
  RUNP(9);
}

template <int PH>
__global__ void __launch_bounds__(NTHR, 2) phase_kernel(P p) {
  __shared__ __attribute__((aligned(16))) char smem[SMEM_BYTES];
  run_phase<PH>(p, smem);
}

constexpr int BAR_TOTAL_WORDS = XCD_BAR_WORDS + 64 * 2048;
static inline size_t align_up(size_t x) { return (x + 255) & ~(size_t)255; }

extern "C" void kernel_launch(void* const* d_in, const int* in_sizes, int n_in, void* d_out, int out_size, void* d_ws,
                              size_t ws_size, hipStream_t stream) {
  P p{};
  const float** f = reinterpret_cast<const float**>(&p);
  for (int i = 0; i < 22; ++i) f[i] = (const float*)d_in[i];
  p.out = (float*)d_out;
  char* w = (char*)d_ws;
  size_t off = 0;
  p.mod = (float*)(w + off); off = align_up(off + (size_t)2 * 3 * 3072 * 4);
  p.wt_in_even = (u16*)(w + off); off = align_up(off + (size_t)IN_E * D * 2);
  p.wt_out_even = (u16*)(w + off); off = align_up(off + (size_t)D * D * 2);
  p.wt_in_odd = (u16*)(w + off); off = align_up(off + (size_t)IN_O * D * 2);
  p.wt_out_odd = (u16*)(w + off); off = align_up(off + (size_t)D * D * 2);
  p.wpt = (u16*)(w + off); off = align_up(off + (size_t)4 * 128 * 128 * 2);
  p.h = (u16*)(w + off); off = align_up(off + (size_t)NTOK * D * 2);
  p.proj = (u16*)(w + off); off = align_up(off + (size_t)NTOK * IN_O * 2);
  p.cat = (u16*)(w + off); off = align_up(off + (size_t)NTOK * D * 2);
  p.x1 = (float*)(w + off); off = align_up(off + (size_t)NTOK * D * 4);
  p.kcb = (u16*)(w + off); off = align_up(off + (size_t)262144 * 2);
  p.vcb = (u16*)(w + off); off = align_up(off + (size_t)262144 * 2);
  p.rowss = (float*)(w + off); off = align_up(off + (size_t)NTOK * 16 * 4);
  p.bias1 = (float*)(w + off); off = align_up(off + (size_t)3 * IN_O * 4);
  p.bar = (unsigned*)(w + off); off = align_up(off + (size_t)BAR_TOTAL_WORDS * 4);
  p.use_cg = 0ull;

#if MULTI_LAUNCH
  const int G = 1024;
  phase_kernel<0><<<G, NTHR, 0, stream>>>(p);
  phase_kernel<1><<<G, NTHR, 0, stream>>>(p);
  phase_kernel<2><<<G, NTHR, 0, stream>>>(p);
  phase_kernel<3><<<G, NTHR, 0, stream>>>(p);
  phase_kernel<4><<<G, NTHR, 0, stream>>>(p);
  phase_kernel<6><<<G, NTHR, 0, stream>>>(p);
  phase_kernel<7><<<G, NTHR, 0, stream>>>(p);
  phase_kernel<8><<<G, NTHR, 0, stream>>>(p);
  phase_kernel<9><<<G, NTHR, 0, stream>>>(p);
#else
  static int grid_blocks = 0;
  if (!grid_blocks) {
    int dev = 0, cus = 0, per_cu = 0;
    hipGetDevice(&dev);
    hipDeviceGetAttribute(&cus, hipDeviceAttributeMultiprocessorCount, dev);
    hipOccupancyMaxActiveBlocksPerMultiprocessor(&per_cu, mega_kernel, NTHR, 0);
    if (per_cu < 1) per_cu = 1;
    grid_blocks = cus * per_cu;
  }
  (void)hipMemsetAsync(p.bar, 0, (size_t)BAR_TOTAL_WORDS * 4, stream);
  void* args[] = {&p};
  hipError_t e = hipLaunchCooperativeKernel((void*)mega_kernel, dim3(grid_blocks), dim3(NTHR), args, 0, stream);
  if (e != hipSuccess) fprintf(stderr, "cooperative launch failed: %s (grid %d)\n", hipGetErrorString(e), grid_blocks);
#endif
}
```

```cpp
#include <hip/hip_runtime.h>
#include <hip/hip_cooperative_groups.h>
#include <cstdio>
namespace cg = cooperative_groups;

#define PROBE_REPEAT 0x00
#define PROBE_SYNC2 0
#ifndef MULTI_LAUNCH
#define MULTI_LAUNCH 0
#endif

typedef unsigned short u16;
using bf16x8 = __attribute__((ext_vector_type(8))) short;
using f32x4 = __attribute__((ext_vector_type(4))) float;
using u32x4 = __attribute__((ext_vector_type(4))) unsigned;
using u32x2 = __attribute__((ext_vector_type(2))) unsigned;

constexpr int D = 1024;
constexpr int NP = 4096;
constexpr int NS = 2048;
constexpr int NTOK = NP + NS;
constexpr int IN_E = 3072;
constexpr int IN_O = 3584;
constexpr int NTHR = 256;
constexpr int SMEM_BYTES = 64 * 1024;

struct P {
  const float *x_prompt, *x_sample, *cache_k, *cache_v, *c, *c_ctx, *norm_g, *w_mod, *b_mod, *w_in_even, *w_pool,
      *pool_scale, *rpb, *w_out_even, *w_in_odd, *conv_c, *conv_d, *conv_d_b, *ln_g, *ln_b, *w_out_odd, *final_g;
  float* out;
  float* mod;
  u16 *wt_in_even, *wt_out_even, *wt_in_odd, *wt_out_odd, *wpt;
  u16 *h, *proj, *cat;
  u16 *kcb, *vcb;
  float *rowss;
  float *bias1;
  float* x1;
  unsigned* bar;
  unsigned long long use_cg;
};

typedef __bf16 hbf2 __attribute__((ext_vector_type(2)));
typedef float hf2 __attribute__((ext_vector_type(2)));
__device__ __forceinline__ unsigned pack2(float a, float b) {
  const hf2 v = {a, b};
  return __builtin_bit_cast(unsigned, __builtin_convertvector(v, hbf2));
}
__device__ __forceinline__ u16 f2bf(float f) { return (u16)(pack2(f, 0.f) & 0xffffu); }
__device__ __forceinline__ float bf2f(u16 h) { return __uint_as_float(((unsigned)h) << 16); }
__device__ __forceinline__ float bflo(unsigned u) { return __uint_as_float(u << 16); }
__device__ __forceinline__ float bfhi(unsigned u) { return __uint_as_float(u & 0xffff0000u); }
__device__ __forceinline__ float silu_f(float x) { return x * __builtin_amdgcn_rcpf(1.f + __expf(-x)); }
__device__ __forceinline__ float sigmoid_f(float x) { return __builtin_amdgcn_rcpf(1.f + __expf(-x)); }
__device__ __forceinline__ float wave_sum(float v) {
#pragma unroll
  for (int o = 32; o >= 1; o >>= 1) v += __shfl_xor(v, o);
  return v;
}
__device__ __forceinline__ int cond_of_token(int tok) { return tok < NP ? 0 : 1 + ((tok - NP) >> 10); }

__device__ void mod_unit(const P& p, int u, float* sm) {
  const int layer = u / 96, cg32 = u % 96;
  const int tid = threadIdx.x;
  float* sc = sm;
  float* red = sm + 3 * 1024;
  __syncthreads();
#pragma unroll
  for (int q = 0; q < 12; ++q) {
    const int i = tid + q * NTHR;
    const int cv = i >> 10, k = i & 1023;
    const float v = (cv == 0) ? p.c_ctx[k] : p.c[(cv - 1) * 1024 + k];
    sc[i] = silu_f(v);
  }
  __syncthreads();
  const int cq = tid & 7, ks = tid >> 3;
  const float* W = p.w_mod + (size_t)layer * 1024 * 3072 + cg32 * 32 + cq * 4;
  float a[3][4] = {};
#pragma unroll 8
  for (int i = 0; i < 32; ++i) {
    int k = ks * 32 + i;
    using nf4 = __attribute__((ext_vector_type(4))) float;
    const nf4 wq = __builtin_nontemporal_load(reinterpret_cast<const nf4*>(W + (size_t)k * 3072));
    float4 w = make_float4(wq.x, wq.y, wq.z, wq.w);
#pragma unroll
    for (int cv = 0; cv < 3; ++cv) {
      float s = sc[cv * 1024 + k];
      a[cv][0] += s * w.x; a[cv][1] += s * w.y; a[cv][2] += s * w.z; a[cv][3] += s * w.w;
    }
  }
#pragma unroll
  for (int cv = 0; cv < 3; ++cv)
#pragma unroll
    for (int j = 0; j < 4; ++j) {
      float v = a[cv][j];
      v += __shfl_xor(v, 8); v += __shfl_xor(v, 16); v += __shfl_xor(v, 32);
      a[cv][j] = v;
    }
  const int lane = tid & 63, wid = tid >> 6;
  if (lane < 8) {
#pragma unroll
    for (int cv = 0; cv < 3; ++cv)
#pragma unroll
      for (int j = 0; j < 4; ++j) red[wid * 96 + cv * 32 + lane * 4 + j] = a[cv][j];
  }
  __syncthreads();
  if (tid < 96) {
    int cv = tid >> 5, col = tid & 31;
    float v = red[tid] + red[96 + tid] + red[192 + tid] + red[288 + tid];
    int n = cg32 * 32 + col;
    v += p.b_mod[layer * 3072 + n];
    p.mod[(layer * 3 + cv) * 3072 + n] = v;
  }
}

__device__ __forceinline__ int perm_row_general(int s) {
  const int tile = s >> 7, c = s & 127, wc = c >> 6, q = c & 63;
  const int n = ((q >> 5) << 1) | ((q >> 2) & 1), i = (((q >> 3) & 3) << 2) | (q & 3);
  return tile * 128 + wc * 64 + n * 16 + i;
}
__device__ __forceinline__ int perm_row_odd(int s) {
  if (s >= 3072) return perm_row_general(s);
  const int region = s >> 9, ch = s & 511;
  const int type = (region == 0 || region == 3) ? 0 : (region <= 2 ? 1 : 2);
  const int member = (region == 0 || region == 1 || region == 4) ? 0 : 1;
  const int chunk = ch >> 6, wc = (ch >> 5) & 1, cw = ch & 31;
  const int n = member * 2 + ((cw >> 2) & 1), i = ((cw >> 3) << 2) | (cw & 3);
  return (type * 8 + chunk) * 128 + wc * 64 + n * 16 + i;
}
template <int MODE>
__device__ void transpose_tile(const float* __restrict__ src, u16* __restrict__ dst, int K, int N, int t, float* sm) {
  const int tid = threadIdx.x;
  const int ntn = N >> 6;
  const int k0 = (t / ntn) * 64, n0 = (t % ntn) * 64;
  __syncthreads();
  {
    const int r = tid >> 4, c4 = tid & 15;
#pragma unroll
    for (int i = 0; i < 4; ++i) {
      int k = r + 16 * i;
      using nf4 = __attribute__((ext_vector_type(4))) float;
      const nf4 vq = __builtin_nontemporal_load(reinterpret_cast<const nf4*>(src + (size_t)(k0 + k) * N + n0 + c4 * 4));
      float4 v = make_float4(vq.x, vq.y, vq.z, vq.w);
      float* d = sm + k * 65 + c4 * 4;
      d[0] = v.x; d[1] = v.y; d[2] = v.z; d[3] = v.w;
    }
  }
  __syncthreads();
  {
    const int kc = tid & 7, nl = tid >> 3;
#pragma unroll
    for (int i = 0; i < 2; ++i) {
      int n = nl + 32 * i;
      float v[8];
#pragma unroll
      for (int j = 0; j < 8; ++j) v[j] = sm[(kc * 8 + j) * 65 + n];
      u32x4 o;
      o.x = pack2(v[0], v[1]); o.y = pack2(v[2], v[3]); o.z = pack2(v[4], v[5]); o.w = pack2(v[6], v[7]);
      const int drow = MODE == 0 ? (n0 + n) : (MODE == 1 ? perm_row_general(n0 + n) : perm_row_odd(n0 + n));
      *reinterpret_cast<u32x4*>(dst + (size_t)drow * K + k0 + kc * 8) = o;
    }
  }
}

__device__ void phase0(const P& p, char* smem) {
  float* sm = reinterpret_cast<float*>(smem);
  constexpr int T0 = 192, T1 = T0 + 768, T2 = T1 + 256, T3 = T2 + 896, T4 = T3 + 256, T5 = T4 + 16;
  for (int u = blockIdx.x; u < T5; u += gridDim.x) {
    if (u < T0) mod_unit(p, u, sm);
    else if (u < T1) transpose_tile<1>(p.w_in_even, p.wt_in_even, 1024, 3072, u - T0, sm);
    else if (u < T2) transpose_tile<1>(p.w_out_even, p.wt_out_even, 1024, 1024, u - T1, sm);
    else if (u < T3) transpose_tile<2>(p.w_in_odd, p.wt_in_odd, 1024, 3584, u - T2, sm);
    else if (u < T4) transpose_tile<1>(p.w_out_odd, p.wt_out_odd, 1024, 1024, u - T3, sm);
    else { int t = u - T4; int g = t >> 2; transpose_tile<0>(p.w_pool + g * 16384, p.wpt + g * 16384, 128, 128, t & 3, sm); }
  }
}

__device__ void phase_norm(const P& p, int layer, const float* xa, const float* xb) {
  const int lane = threadIdx.x & 63, wid = threadIdx.x >> 6;
  if (layer == 0) {
    for (int prow = blockIdx.x * 4 + wid; prow < IN_O; prow += gridDim.x * 4) {
      const u16* wrow = p.wt_in_odd + (size_t)prow * D + lane * 16;
      const u32x4 w0 = *reinterpret_cast<const u32x4*>(wrow), w1 = *reinterpret_cast<const u32x4*>(wrow + 8);
      const float wf[16] = {bflo(w0.x), bfhi(w0.x), bflo(w0.y), bfhi(w0.y), bflo(w0.z), bfhi(w0.z), bflo(w0.w), bfhi(w0.w),
                            bflo(w1.x), bfhi(w1.x), bflo(w1.y), bfhi(w1.y), bflo(w1.z), bfhi(w1.z), bflo(w1.w), bfhi(w1.w)};
#pragma unroll
      for (int cv = 0; cv < 3; ++cv) {
        const float* sh = p.mod + (size_t)(3 + cv) * 3072 + lane * 16;
        float a = 0.f;
#pragma unroll
        for (int q = 0; q < 4; ++q) {
          const float4 s4 = *reinterpret_cast<const float4*>(sh + q * 4);
          a += s4.x * wf[q * 4] + s4.y * wf[q * 4 + 1] + s4.z * wf[q * 4 + 2] + s4.w * wf[q * 4 + 3];
        }
        a = wave_sum(a);
        if (lane == 0) p.bias1[cv * IN_O + prow] = a;
      }
    }
    for (int i = blockIdx.x * NTHR + threadIdx.x; i < 2 * 32768; i += gridDim.x * NTHR) {
      const float* src = (i < 32768 ? p.cache_k : p.cache_v) + (size_t)(i & 32767) * 8;
      u16* dst = (i < 32768 ? p.kcb : p.vcb) + (size_t)(i & 32767) * 8;
      const float4 a = *reinterpret_cast<const float4*>(src), c = *reinterpret_cast<const float4*>(src + 4);
      u32x4 o; o.x = pack2(a.x, a.y); o.y = pack2(a.z, a.w); o.z = pack2(c.x, c.y); o.w = pack2(c.z, c.w);
      *reinterpret_cast<u32x4*>(dst) = o;
    }
  }
  const float* g = p.norm_g + layer * 1024;
  const bool xpart = (gridDim.x & 7) == 0;
  const int nrow = xpart ? 768 : NTOK, rstep = xpart ? (int)(gridDim.x >> 3) * 4 : (int)gridDim.x * 4;
  for (int rr = (xpart ? (int)(blockIdx.x >> 3) : (int)blockIdx.x) * 4 + wid; rr < nrow; rr += rstep) {
    const int tok = xpart ? (int)(blockIdx.x & 7) * 768 + rr : rr;
    const float* x = tok < NP ? xa + (size_t)tok * D : xb + (size_t)(tok - NP) * D;
    const float* m = p.mod + (size_t)(layer * 3 + cond_of_token(tok)) * 3072;
    float4 v[4], ggv[4], shv[4], scv[4];
    float ss = 0.f;
#pragma unroll
    for (int i = 0; i < 4; ++i) {
      const int k = i * 256 + lane * 4;
      v[i] = *reinterpret_cast<const float4*>(x + k);
      ggv[i] = *reinterpret_cast<const float4*>(g + k);
      shv[i] = *reinterpret_cast<const float4*>(m + k);
      scv[i] = *reinterpret_cast<const float4*>(m + 1024 + k);
    }
#pragma unroll
    for (int i = 0; i < 4; ++i) ss += v[i].x * v[i].x + v[i].y * v[i].y + v[i].z * v[i].z + v[i].w * v[i].w;
    ss = wave_sum(ss);
    const float rinv = rsqrtf(ss * (1.f / 1024.f) + 1e-6f);
#pragma unroll
    for (int i = 0; i < 4; ++i) {
      const int k = i * 256 + lane * 4;
      const float4 gg = ggv[i], sh = shv[i], sc = scv[i];
      float h0 = v[i].x * rinv * gg.x * (1.f + sc.x) + sh.x;
      float h1 = v[i].y * rinv * gg.y * (1.f + sc.y) + sh.y;
      float h2 = v[i].z * rinv * gg.z * (1.f + sc.z) + sh.z;
      float h3 = v[i].w * rinv * gg.w * (1.f + sc.w) + sh.w;
      u32x2 o; o.x = pack2(h0, h1); o.y = pack2(h2, h3);
      *reinterpret_cast<u32x2*>(p.h + (size_t)tok * D + k) = o;
    }
  }
}

template <int EPI, int BM>
__device__ void gemm_phase(const P& p, const u16* __restrict__ A, const u16* __restrict__ Bt, int N, char* smem) {
  constexpr int K = 1024, BK = 64;
  const int tid = threadIdx.x, wid = tid >> 6, lane = tid & 63, wr = wid >> 1, wc = wid & 1, fr = lane & 15, fq = lane >> 4;
  const int NT = N >> 7;
  constexpr int MI = BM / 32;
  constexpr int NAL = BM / 32;
  const int ntiles = (NTOK / BM) * NT;
  const int srow = tid >> 3;
  const int schunk = (tid & 7) ^ ((tid >> 4) & 7);
  const bool xpart = (gridDim.x & 7) == 0;
  constexpr int MPX = 768 / BM;
  const int xcd = blockIdx.x & 7;
  const int jfirst = xpart ? (int)(blockIdx.x >> 3) : (int)blockIdx.x;
  const int jstep = xpart ? (int)(gridDim.x >> 3) : (int)gridDim.x;
  const int jend = xpart ? MPX * NT : ntiles;
  const u16* ga = nullptr; const u16* gb = nullptr;
  if (jfirst < jend) {
    const int mt0 = xpart ? xcd * MPX + jfirst % MPX : jfirst / NT, nt0 = xpart ? jfirst / MPX : jfirst % NT;
    ga = A + (size_t)(mt0 * BM + srow) * K + schunk * 8;
    gb = Bt + (size_t)(nt0 * 128 + srow) * K + schunk * 8;
    __syncthreads();
#pragma unroll
    for (int i = 0; i < NAL; ++i)
      __builtin_amdgcn_global_load_lds((const unsigned*)(ga + (size_t)(32 * i) * K), (unsigned*)(smem + i * 4096 + tid * 16), 16, 0, 0);
#pragma unroll
    for (int i = 0; i < 4; ++i)
      __builtin_amdgcn_global_load_lds((const unsigned*)(gb + (size_t)(32 * i) * K), (unsigned*)(smem + 16384 + i * 4096 + tid * 16), 16, 0, 0);
  }
  for (int tile = jfirst; tile < jend; tile += jstep) {
    const int mt = xpart ? xcd * MPX + tile % MPX : tile / NT, nt = xpart ? tile / MPX : tile % NT;
    const int brow = mt * BM, bcol = nt * 128;
    f32x4 acc[MI][4] = {};
    for (int t = 0; t < K / BK; ++t) {
      char* SA = smem + (t & 1) * 32768;
      char* SB = SA + 16384;
      asm volatile("s_waitcnt vmcnt(0)" ::: "memory");
      __syncthreads();
      if (t + 1 < K / BK) {
        char* NA = smem + ((t + 1) & 1) * 32768;
#pragma unroll
        for (int i = 0; i < NAL; ++i)
          __builtin_amdgcn_global_load_lds((const unsigned*)(ga + (size_t)(32 * i) * K + (t + 1) * BK), (unsigned*)(NA + i * 4096 + tid * 16), 16, 0, 0);
#pragma unroll
        for (int i = 0; i < 4; ++i)
          __builtin_amdgcn_global_load_lds((const unsigned*)(gb + (size_t)(32 * i) * K + (t + 1) * BK), (unsigned*)(NA + 16384 + i * 4096 + tid * 16), 16, 0, 0);
      } else {
        const int tn = tile + jstep;
        if (tn < jend) {
          const int mtn = xpart ? xcd * MPX + tn % MPX : tn / NT, ntn = xpart ? tn / MPX : tn % NT;
          ga = A + (size_t)(mtn * BM + srow) * K + schunk * 8;
          gb = Bt + (size_t)(ntn * 128 + srow) * K + schunk * 8;
#pragma unroll
          for (int i = 0; i < NAL; ++i)
            __builtin_amdgcn_global_load_lds((const unsigned*)(ga + (size_t)(32 * i) * K), (unsigned*)(smem + i * 4096 + tid * 16), 16, 0, 0);
#pragma unroll
          for (int i = 0; i < 4; ++i)
            __builtin_amdgcn_global_load_lds((const unsigned*)(gb + (size_t)(32 * i) * K), (unsigned*)(smem + 16384 + i * 4096 + tid * 16), 16, 0, 0);
        }
      }
      {
        bf16x8 af[2][MI], bfr[2][4];
#pragma unroll
        for (int kk = 0; kk < 2; ++kk) {
#pragma unroll
          for (int n = 0; n < 4; ++n) {
            const int r = wc * 64 + n * 16 + fr;
            bfr[kk][n] = *reinterpret_cast<const bf16x8*>(SB + r * 128 + (((kk * 4 + fq) ^ ((r >> 1) & 7)) << 4));
          }
#pragma unroll
          for (int m = 0; m < MI; ++m) {
            const int r = wr * (BM / 2) + m * 16 + fr;
            af[kk][m] = *reinterpret_cast<const bf16x8*>(SA + r * 128 + (((kk * 4 + fq) ^ ((r >> 1) & 7)) << 4));
          }
        }
#pragma unroll
        for (int kk = 0; kk < 2; ++kk)
#pragma unroll
          for (int m = 0; m < MI; ++m)
#pragma unroll
            for (int n = 0; n < 4; ++n) acc[m][n] = __builtin_amdgcn_mfma_f32_16x16x32_bf16(bfr[kk][n], af[kk][m], acc[m][n], 0, 0, 0);
        __builtin_amdgcn_sched_group_barrier(0x100, MI + 4, 0);
#pragma unroll
        for (int i = 0; i < MI + 4; ++i) {
          __builtin_amdgcn_sched_group_barrier(0x008, 2, 0);
          __builtin_amdgcn_sched_group_barrier(0x100, 1, 0);
        }
        __builtin_amdgcn_sched_group_barrier(0x008, 8 * MI - 2 * (MI + 4), 0);
      }
    }
    if (EPI == 0) {
      const bool gate_tile = (nt >= 4 && nt < 8) || nt >= 20;
#pragma unroll
      for (int m = 0; m < MI; ++m) {
        const int row = brow + wr * (BM / 2) + m * 16 + fr;
#pragma unroll
        for (int np = 0; np < 2; ++np) {
          const int col = bcol + wc * 64 + np * 32 + fq * 8;
          float v[8];
#pragma unroll
          for (int j = 0; j < 4; ++j) { v[j] = acc[m][np * 2][j]; v[4 + j] = acc[m][np * 2 + 1][j]; }
          if (gate_tile) {
#pragma unroll
            for (int j = 0; j < 8; ++j) v[j] = silu_f(v[j]);
          }
          u32x4 o; o.x = pack2(v[0], v[1]); o.y = pack2(v[2], v[3]); o.z = pack2(v[4], v[5]); o.w = pack2(v[6], v[7]);
          *reinterpret_cast<u32x4*>(p.proj + (size_t)row * IN_E + col) = o;
          if (row < NP && nt >= 12 && nt < 20) {
            const bool isv = nt >= 16;
            float* dst = p.out + (size_t)NTOK * D + (isv ? (size_t)16 * 8 * 256 * 64 : 0);
            const int cc = col - (isv ? 2048 : 1536);
            const int b = row >> 8, tt = row & 255, hh = cc >> 6, dd = cc & 63;
            float* d2 = dst + (((size_t)b * 8 + hh) * 256 + tt) * 64 + dd;
            *reinterpret_cast<float4*>(d2) = make_float4(v[0], v[1], v[2], v[3]);
            *reinterpret_cast<float4*>(d2 + 4) = make_float4(v[4], v[5], v[6], v[7]);
          }
        }
      }
    } else if (EPI == 2) {
      {
        float rinv[MI];
        int cvm[MI];
#pragma unroll
        for (int m = 0; m < MI; ++m) {
          const int row = brow + wr * (BM / 2) + m * 16 + fr;
          cvm[m] = cond_of_token(row);
          const float* rs = p.rowss + (size_t)row * 16;
          const float4 a = *reinterpret_cast<const float4*>(rs), b2 = *reinterpret_cast<const float4*>(rs + 4);
          const float4 c2 = *reinterpret_cast<const float4*>(rs + 8), d2 = *reinterpret_cast<const float4*>(rs + 12);
          const float tot = (a.x + a.y + a.z + a.w) + (b2.x + b2.y + b2.z + b2.w) + (c2.x + c2.y + c2.z + c2.w) + (d2.x + d2.y + d2.z + d2.w);
          rinv[m] = rsqrtf(tot * (1.f / 1024.f) + 1e-6f);
        }
#pragma unroll
        for (int n = 0; n < 4; ++n) {
#pragma unroll
          for (int m = 0; m < MI; ++m) {
            const float4 bz = *reinterpret_cast<const float4*>(p.bias1 + (size_t)cvm[m] * IN_O + bcol + wc * 64 + n * 16 + fq * 4);
            acc[m][n][0] = acc[m][n][0] * rinv[m] + bz.x; acc[m][n][1] = acc[m][n][1] * rinv[m] + bz.y;
            acc[m][n][2] = acc[m][n][2] * rinv[m] + bz.z; acc[m][n][3] = acc[m][n][3] * rinv[m] + bz.w;
          }
        }
      }
      if (nt < 24) {
        const int type = nt >> 3, chunk = nt & 7;
#pragma unroll
        for (int m = 0; m < MI; ++m) {
          const int row = brow + wr * (BM / 2) + m * 16 + fr;
          float v[8];
#pragma unroll
          for (int nl = 0; nl < 2; ++nl)
#pragma unroll
            for (int j = 0; j < 4; ++j) {
              const float a = acc[m][nl][j], b = acc[m][2 + nl][j];
              v[nl * 4 + j] = type == 0 ? a * silu_f(b) : (type == 1 ? a * b : a * sigmoid_f(b));
            }
          u32x4 o; o.x = pack2(v[0], v[1]); o.y = pack2(v[2], v[3]); o.z = pack2(v[4], v[5]); o.w = pack2(v[6], v[7]);
          *reinterpret_cast<u32x4*>(p.proj + (size_t)row * 2048 + type * 512 + chunk * 64 + wc * 32 + fq * 8) = o;
        }
      } else {
#pragma unroll
        for (int m = 0; m < MI; ++m) {
          const int row = brow + wr * (BM / 2) + m * 16 + fr;
#pragma unroll
          for (int np = 0; np < 2; ++np) {
            float v[8];
#pragma unroll
            for (int j = 0; j < 4; ++j) { v[j] = silu_f(acc[m][np * 2][j]); v[4 + j] = silu_f(acc[m][np * 2 + 1][j]); }
            u32x4 o; o.x = pack2(v[0], v[1]); o.y = pack2(v[2], v[3]); o.z = pack2(v[4], v[5]); o.w = pack2(v[6], v[7]);
            *reinterpret_cast<u32x4*>(p.proj + (size_t)row * 2048 + 1536 + (nt - 24) * 128 + wc * 64 + np * 32 + fq * 8) = o;
          }
        }
      }
    } else {
      const int layer = (EPI == 1) ? 0 : 1;
      float ssq[MI] = {};
#pragma unroll
      for (int np = 0; np < 2; ++np) {
        const int col = bcol + wc * 64 + np * 32 + fq * 8;
        float4 n0 = {}, n1 = {};
        if (EPI == 1) { n0 = *reinterpret_cast<const float4*>(p.norm_g + 1024 + col); n1 = *reinterpret_cast<const float4*>(p.norm_g + 1024 + col + 4); }
#pragma unroll
        for (int m = 0; m < MI; ++m) {
          const int row = brow + wr * (BM / 2) + m * 16 + fr;
          const int cv = cond_of_token(row);
          const float* gate = p.mod + (size_t)(layer * 3 + cv) * 3072 + 2048 + col;
          const float4 g0 = *reinterpret_cast<const float4*>(gate);
          const float4 g1 = *reinterpret_cast<const float4*>(gate + 4);
          const float* xin = (EPI == 1) ? (row < NP ? p.x_prompt + (size_t)row * D + col : p.x_sample + (size_t)(row - NP) * D + col)
                                        : p.x1 + (size_t)row * D + col;
          const float4 x0 = *reinterpret_cast<const float4*>(xin);
          const float4 x1v = *reinterpret_cast<const float4*>(xin + 4);
          float4 o0, o1;
          o0.x = x0.x + g0.x * acc[m][np * 2][0]; o0.y = x0.y + g0.y * acc[m][np * 2][1];
          o0.z = x0.z + g0.z * acc[m][np * 2][2]; o0.w = x0.w + g0.w * acc[m][np * 2][3];
          o1.x = x1v.x + g1.x * acc[m][np * 2 + 1][0]; o1.y = x1v.y + g1.y * acc[m][np * 2 + 1][1];
          o1.z = x1v.z + g1.z * acc[m][np * 2 + 1][2]; o1.w = x1v.w + g1.w * acc[m][np * 2 + 1][3];
          float* xo = p.x1 + (size_t)row * D + col;
          *reinterpret_cast<float4*>(xo) = o0;
          *reinterpret_cast<float4*>(xo + 4) = o1;
          if (EPI == 1) {
            const float* sc = p.mod + (size_t)(3 + cv) * 3072 + 1024 + col;
            const float4 s0 = *reinterpret_cast<const float4*>(sc), s1 = *reinterpret_cast<const float4*>(sc + 4);
            ssq[m] += o0.x * o0.x + o0.y * o0.y + o0.z * o0.z + o0.w * o0.w + o1.x * o1.x + o1.y * o1.y + o1.z * o1.z + o1.w * o1.w;
            u32x4 hv;
            hv.x = pack2(o0.x * n0.x * (1.f + s0.x), o0.y * n0.y * (1.f + s0.y)); hv.y = pack2(o0.z * n0.z * (1.f + s0.z), o0.w * n0.w * (1.f + s0.w));
            hv.z = pack2(o1.x * n1.x * (1.f + s1.x), o1.y * n1.y * (1.f + s1.y)); hv.w = pack2(o1.z * n1.z * (1.f + s1.z), o1.w * n1.w * (1.f + s1.w));
            *reinterpret_cast<u32x4*>(p.h + (size_t)row * D + col) = hv;
          }
        }
      }
      if (EPI == 1) {
#pragma unroll
        for (int m = 0; m < MI; ++m) {
          float v = ssq[m];
          v += __shfl_xor(v, 16); v += __shfl_xor(v, 32);
          if (fq == 0) p.rowss[(size_t)(brow + wr * (BM / 2) + m * 16 + fr) * 16 + nt * 2 + wc] = v;
        }
      }
    }
  }
}

template <int MODE>
__device__ void attn_unit(const P& p, int u, char* smem) {
  const int tid = threadIdx.x, wid = tid >> 6, lane = tid & 63, fr = lane & 15, fq = lane >> 4;
  char* Ks = smem;
  u16* Vt = reinterpret_cast<u16*>(smem + 16384);
  float* rpl = reinterpret_cast<float*>(smem + 16384 + 18432);
  int h, qtok0, b, r = 0;
  if (MODE == 0) { b = u >> 5; h = (u >> 2) & 7; qtok0 = b * 256 + (u & 3) * 64; }
  else { b = u >> 7; r = (u >> 3) & 15; h = u & 7; qtok0 = NP + b * 1024 + r * 64; }
  constexpr int NSS = MODE == 0 ? 2 : 6;
  const int c0 = wid * 16;
  int ksc = c0 - 8; ksc = ksc < 0 ? 0 : (ksc > 32 ? 32 : ksc);
  const int rs = (r - 4) < 0 ? 0 : ((r - 4) > 8 ? 8 : (r - 4));
  bf16x8 qf[2];
  {
    const u16* q = p.proj + (size_t)(qtok0 + wid * 16 + fr) * IN_E + 1024 + h * 64 + fq * 8;
    qf[0] = *reinterpret_cast<const bf16x8*>(q);
    qf[1] = *reinterpret_cast<const bf16x8*>(q + 32);
  }
  u32x2 gbv[4];
#pragma unroll
  for (int dt = 0; dt < 4; ++dt)
    gbv[dt] = *reinterpret_cast<const u32x2*>(p.proj + (size_t)(qtok0 + wid * 16 + fr) * IN_E + 2560 + h * 64 + dt * 16 + fq * 4);
  const int cq = c0 + fr;
  int cstart = cq - 8; cstart = cstart < 0 ? 0 : (cstart > 48 ? 48 : cstart);
  float mrun = -1e30f, lrun = 0.f;
  f32x4 o[4] = {};
  const float scale = 0.125f;
  const int krow = tid >> 3, kchunk = tid & 7;
  const int vkey = tid & 127, vdh = tid >> 7;
  u32x4 kr[4], vr[4];
  auto prefetch = [&](int ss) {
    const u16* kb; const u16* vb; int ld;
    if (MODE == 0) { kb = p.proj + (size_t)(b * 256 + ss * 128) * IN_E + 1536 + h * 64; vb = kb + 512; ld = IN_E; }
    else if (ss < 4) { kb = p.proj + (size_t)(NP + b * 1024 + (rs + ss * 2) * 64) * IN_E + 1536 + h * 64; vb = kb + 512; ld = IN_E; }
    else { kb = p.kcb + ((size_t)(b * 8 + h) * 256 + (ss - 4) * 128) * 64; vb = p.vcb + ((size_t)(b * 8 + h) * 256 + (ss - 4) * 128) * 64; ld = 64; }
#pragma unroll
    for (int i = 0; i < 4; ++i) kr[i] = *reinterpret_cast<const u32x4*>(kb + (size_t)(krow + 32 * i) * ld + kchunk * 8);
#pragma unroll
    for (int i = 0; i < 4; ++i) vr[i] = *reinterpret_cast<const u32x4*>(vb + (size_t)vkey * ld + vdh * 32 + i * 8);
  };
  prefetch(0);
  if (MODE == 1) {
    __syncthreads();
    for (int i = tid; i < 15 * 31; i += NTHR) rpl[i] = p.rpb[h * 465 + i];
  }
#pragma unroll 1
  for (int ss = 0; ss < NSS; ++ss) {
    const bool local = (MODE == 1 && ss < 4);
    __syncthreads();
#pragma unroll
    for (int i = 0; i < 4; ++i) {
      const int row = krow + 32 * i;
      *reinterpret_cast<u32x4*>(Ks + row * 128 + ((kchunk ^ ((row >> 1) & 7)) << 4)) = kr[i];
    }
    {
      u16* vt = Vt + (vkey >> 6) * 4608 + (vdh * 32) * 72 + (vkey & 63);
#pragma unroll
      for (int i = 0; i < 4; ++i) {
        const unsigned w[4] = {vr[i].x, vr[i].y, vr[i].z, vr[i].w};
#pragma unroll
        for (int j = 0; j < 4; ++j) {
          vt[(i * 8 + 2 * j) * 72] = (u16)(w[j] & 0xffff);
          vt[(i * 8 + 2 * j + 1) * 72] = (u16)(w[j] >> 16);
        }
      }
    }
    if (ss + 1 < NSS) prefetch(ss + 1);
    __syncthreads();
#pragma unroll
    for (int s2 = 0; s2 < 2; ++s2) {
      const u16* Vs = Vt + s2 * 4608;
      const int nchunk = local ? 1 : 2;
      const int kbase = local ? ksc : 0;
      const float* rp = rpl + (rs + ss * 2 + s2 - r + 7) * 31 + 15 - cq;
      for (int ch = 0; ch < nchunk; ++ch) {
        f32x4 sv[2];
#pragma unroll
        for (int t2 = 0; t2 < 2; ++t2) {
          const int koff = kbase + ch * 32 + t2 * 16;
          const int row = s2 * 64 + koff + fr;
          const int sw = (row >> 1) & 7;
          const bf16x8 kf0 = *reinterpret_cast<const bf16x8*>(Ks + row * 128 + ((fq ^ sw) << 4));
          const bf16x8 kf1 = *reinterpret_cast<const bf16x8*>(Ks + row * 128 + (((4 + fq) ^ sw) << 4));
          f32x4 z = {0.f, 0.f, 0.f, 0.f};
          z = __builtin_amdgcn_mfma_f32_16x16x32_bf16(kf0, qf[0], z, 0, 0, 0);
          z = __builtin_amdgcn_mfma_f32_16x16x32_bf16(kf1, qf[1], z, 0, 0, 0);
          if (local) {
#pragma unroll
            for (int j = 0; j < 4; ++j) {
              const int ck = koff + fq * 4 + j;
              int dcl = ck - cq; dcl = dcl < -15 ? -15 : (dcl > 15 ? 15 : dcl);
              const float bias = rp[dcl + cq];
              const bool ok = (ck >= cstart) && (ck < cstart + 16);
              z[j] = ok ? z[j] * scale + bias : -1e30f;
            }
          } else {
#pragma unroll
            for (int j = 0; j < 4; ++j) z[j] *= scale;
          }
          sv[t2] = z;
        }
        float mx = fmaxf(fmaxf(fmaxf(sv[0][0], sv[0][1]), fmaxf(sv[0][2], sv[0][3])), fmaxf(fmaxf(sv[1][0], sv[1][1]), fmaxf(sv[1][2], sv[1][3])));
        mx = fmaxf(mx, __shfl_xor(mx, 16));
        mx = fmaxf(mx, __shfl_xor(mx, 32));
        const float mnew = fmaxf(mrun, mx);
        const float corr = __expf(mrun - mnew);
        mrun = mnew;
        float pv[8];
        float psum = 0.f;
#pragma unroll
        for (int j = 0; j < 4; ++j) { pv[j] = __expf(sv[0][j] - mnew); pv[4 + j] = __expf(sv[1][j] - mnew); }
#pragma unroll
        for (int j = 0; j < 8; ++j) psum += pv[j];
        lrun = lrun * corr + psum;
        u32x4 pk;
        pk.x = pack2(pv[0], pv[1]); pk.y = pack2(pv[2], pv[3]); pk.z = pack2(pv[4], pv[5]); pk.w = pack2(pv[6], pv[7]);
        const bf16x8 pfrag = __builtin_bit_cast(bf16x8, pk);
        const int k0 = kbase + ch * 32;
#pragma unroll
        for (int dt = 0; dt < 4; ++dt) {
          const u16* vp = Vs + (dt * 16 + fr) * 72 + k0 + fq * 4;
          u32x2 v0 = *reinterpret_cast<const u32x2*>(vp);
          u32x2 v1 = *reinterpret_cast<const u32x2*>(vp + 16);
          u32x4 vv; vv.x = v0.x; vv.y = v0.y; vv.z = v1.x; vv.w = v1.y;
          f32x4 oo = o[dt];
          oo[0] *= corr; oo[1] *= corr; oo[2] *= corr; oo[3] *= corr;
          o[dt] = __builtin_amdgcn_mfma_f32_16x16x32_bf16(__builtin_bit_cast(bf16x8, vv), pfrag, oo, 0, 0, 0);
        }
      }
    }
  }
  lrun += __shfl_xor(lrun, 16);
  lrun += __shfl_xor(lrun, 32);
  const float linv = 1.f / lrun;
  const int tok = qtok0 + wid * 16 + fr;
#pragma unroll
  for (int dt = 0; dt < 4; ++dt) {
    const int dd = h * 64 + dt * 16 + fq * 4;
    const u32x2 gb = gbv[dt];
    float r0 = o[dt][0] * linv * bflo(gb.x);
    float r1 = o[dt][1] * linv * bfhi(gb.x);
    float r2 = o[dt][2] * linv * bflo(gb.y);
    float r3 = o[dt][3] * linv * bfhi(gb.y);
    u32x2 ov; ov.x = pack2(r0, r1); ov.y = pack2(r2, r3);
    *reinterpret_cast<u32x2*>(p.cat + (size_t)tok * D + 512 + dd) = ov;
  }
}

template <int G>
__device__ void pool_unit(const P& p, int tile, char* smem) {
  constexpr int HALF = 1 << G;
  constexpr int NR = 64 + 2 * HALF;
  int tid = threadIdx.x;
  asm volatile("" : "+v"(tid));
  const int wid = tid >> 6, lane = tid & 63, fr = lane & 15, fq = lane >> 4;
  char* U = smem;
  char* W = smem + 80 * 272;
  const int T0 = tile * 64;
  int sb, se;
  if (T0 < NP) { sb = T0 & ~255; se = sb + 256; } else { sb = NP + ((T0 - NP) & ~1023); se = sb + 1024; }
  __syncthreads();
  {
    constexpr int NIT = (NR * 16 + NTHR - 1) / NTHR;
    u32x4 sv[NIT];
#pragma unroll
    for (int i = 0; i < NIT; ++i) {
      const int c = tid + i * NTHR, rr = c >> 4, c16 = c & 15;
      int tt = T0 - HALF + rr; tt = tt < sb ? sb : (tt >= se ? se - 1 : tt);
      sv[i] = *reinterpret_cast<const u32x4*>(p.proj + (size_t)tt * IN_E + G * 128 + c16 * 8);
    }
#pragma unroll
    for (int i = 0; i < NIT; ++i) {
      const int c = tid + i * NTHR, rr = c >> 4, c16 = c & 15;
      if (c < NR * 16) *reinterpret_cast<u32x4*>(U + rr * 272 + c16 * 16) = sv[i];
    }
  }
#pragma unroll
  for (int i = 0; i < 8; ++i) {
    const int c = tid + i * NTHR, rr = c >> 4, c16 = c & 15;
    *reinterpret_cast<u32x4*>(W + rr * 272 + c16 * 16) = *reinterpret_cast<const u32x4*>(p.wpt + (size_t)G * 16384 + rr * 128 + c16 * 8);
  }
  __syncthreads();
  const int t = T0 + wid * 16 + fr;
  int lo = t - HALF; lo = lo < sb ? sb : lo;
  int hi = t + HALF; hi = hi > se ? se : hi;
  const float inv = 1.f / (float)(hi - lo);
  f32x4 acc[8] = {};
#pragma unroll 1
  for (int ks = 0; ks < 4; ++ks) {
    const char* ub = U + (wid * 16 + fr) * 272 + (ks * 4 + fq) * 16;
    float sum[8] = {};
#pragma unroll
    for (int i = 0; i < 2 * HALF; ++i) {
      const int tt = t - HALF + i;
      const float m = (tt >= lo && tt < hi) ? 1.f : 0.f;
      const u32x4 w2 = *reinterpret_cast<const u32x4*>(ub + i * 272);
      sum[0] += m * bflo(w2.x); sum[1] += m * bfhi(w2.x); sum[2] += m * bflo(w2.y); sum[3] += m * bfhi(w2.y);
      sum[4] += m * bflo(w2.z); sum[5] += m * bfhi(w2.z); sum[6] += m * bflo(w2.w); sum[7] += m * bfhi(w2.w);
    }
    const u32x4 w = *reinterpret_cast<const u32x4*>(ub + HALF * 272);
    const float uu[8] = {bflo(w.x), bfhi(w.x), bflo(w.y), bfhi(w.y), bflo(w.z), bfhi(w.z), bflo(w.w), bfhi(w.w)};
    u32x4 pk;
    pk.x = pack2(sum[0] * inv - uu[0], sum[1] * inv - uu[1]);
    pk.y = pack2(sum[2] * inv - uu[2], sum[3] * inv - uu[3]);
    pk.z = pack2(sum[4] * inv - uu[4], sum[5] * inv - uu[5]);
    pk.w = pack2(sum[6] * inv - uu[6], sum[7] * inv - uu[7]);
    const bf16x8 af = __builtin_bit_cast(bf16x8, pk);
#pragma unroll
    for (int n = 0; n < 8; ++n) {
      const bf16x8 bfr = *reinterpret_cast<const bf16x8*>(W + (n * 16 + fr) * 272 + (ks * 4 + fq) * 16);
      acc[n] = __builtin_amdgcn_mfma_f32_16x16x32_bf16(bfr, af, acc[n], 0, 0, 0);
    }
  }
#pragma unroll
  for (int n = 0; n < 8; ++n) {
    const int dd = G * 128 + n * 16 + fq * 4;
    const float4 ps = *reinterpret_cast<const float4*>(p.pool_scale + dd);
    const u32x2 ga = *reinterpret_cast<const u32x2*>(p.proj + (size_t)t * IN_E + 512 + dd);
    u32x2 ov;
    ov.x = pack2(acc[n][0] * ps.x * bflo(ga.x), acc[n][1] * ps.y * bfhi(ga.x));
    ov.y = pack2(acc[n][2] * ps.z * bflo(ga.y), acc[n][3] * ps.w * bfhi(ga.y));
    *reinterpret_cast<u32x2*>(p.cat + (size_t)t * D + dd) = ov;
  }
}

__device__ void phase_even_mix(const P& p, char* smem) {
  if (gridDim.x == 512) {
    const int bx = blockIdx.x;
    if (bx < 256) {
      attn_unit<1>(p, bx, smem);
      const int g = (bx >> 3) & 3, tile = (bx & 7) * 12 + (bx >> 5);
      if (g == 0) pool_unit<0>(p, tile, smem); else if (g == 1) pool_unit<1>(p, tile, smem); else if (g == 2) pool_unit<2>(p, tile, smem); else pool_unit<3>(p, tile, smem);
    } else {
      attn_unit<0>(p, (bx - 256) * 2, smem);
      attn_unit<0>(p, (bx - 256) * 2 + 1, smem);
      if (bx < 384) {
        const int g = (bx >> 3) & 3, tile = (bx & 7) * 12 + (bx >> 5);
        if (g == 0) pool_unit<0>(p, tile, smem); else if (g == 1) pool_unit<1>(p, tile, smem); else if (g == 2) pool_unit<2>(p, tile, smem); else pool_unit<3>(p, tile, smem);
      }
    }
    return;
  }
  constexpr int U_N = 256, U_C = 512, U_P = 384;
  for (int u = blockIdx.x; u < U_N + U_C + U_P; u += gridDim.x) {
    if (u < U_N) attn_unit<1>(p, u, smem);
    else if (u < U_N + U_C) attn_unit<0>(p, u - U_N, smem);
    else {
      const int q = u - U_N - U_C, g = q & 3, tile = q >> 2;
      if (g == 0) pool_unit<0>(p, tile, smem); else if (g == 1) pool_unit<1>(p, tile, smem); else if (g == 2) pool_unit<2>(p, tile, smem); else pool_unit<3>(p, tile, smem);
    }
  }
}

__device__ void odd_unit(const P& p, int u, char* smem) {
  int tid = threadIdx.x;
  asm volatile("" : "+v"(tid));
  const int lane = tid & 63, wid = tid >> 6;
  u16* G = reinterpret_cast<u16*>(smem);
  float* red = reinterpret_cast<float*>(smem + 46 * 1024);
  const int t0 = u * 16;
  int sb, se;
  if (t0 < NP) { sb = t0 & ~255; se = sb + 256; } else { sb = NP + ((t0 - NP) & ~1023); se = sb + 1024; }
  const int ch = tid * 2;
  u32x4 sv[12];
#pragma unroll
  for (int i = 0; i < 12; ++i) {
    const int c = tid + i * NTHR, rr = c >> 6, c16 = c & 63;
    const int tt = t0 - 15 + rr;
    sv[i] = u32x4{0u, 0u, 0u, 0u};
    if (c < 46 * 64 && tt >= sb && tt < se) sv[i] = *reinterpret_cast<const u32x4*>(p.proj + (size_t)tt * 2048 + 1024 + c16 * 8);
  }
  unsigned cxw[18], bww[16], gdw[16];
#pragma unroll
  for (int q = 0; q < 18; ++q) {
    const int tt = t0 + q - 1;
    cxw[q] = 0u;
    if (tt >= sb && tt < se) cxw[q] = *reinterpret_cast<const unsigned*>(p.proj + (size_t)tt * 2048 + 512 + ch);
  }
#pragma unroll
  for (int i = 0; i < 16; ++i) {
    bww[i] = *reinterpret_cast<const unsigned*>(p.proj + (size_t)(t0 + i) * 2048 + ch);
    gdw[i] = *reinterpret_cast<const unsigned*>(p.proj + (size_t)(t0 + i) * 2048 + 1536 + ch);
  }
  float2 w[31];
#pragma unroll
  for (int j = 0; j < 31; ++j) w[j] = *reinterpret_cast<const float2*>(p.conv_d + j * 512 + ch);
  const float2 bias = *reinterpret_cast<const float2*>(p.conv_d_b + ch);
  const float2 lg = *reinterpret_cast<const float2*>(p.ln_g + ch);
  const float2 lb = *reinterpret_cast<const float2*>(p.ln_b + ch);
  const float2 wc0 = *reinterpret_cast<const float2*>(p.conv_c + ch);
  const float2 wc1 = *reinterpret_cast<const float2*>(p.conv_c + 512 + ch);
  const float2 wc2 = *reinterpret_cast<const float2*>(p.conv_c + 1024 + ch);
  __syncthreads();
#pragma unroll
  for (int i = 0; i < 12; ++i) {
    const int c = tid + i * NTHR, rr = c >> 6, c16 = c & 63;
    if (c < 46 * 64) *reinterpret_cast<u32x4*>(G + rr * 512 + c16 * 8) = sv[i];
  }
#pragma unroll
  for (int i = 0; i < 16; ++i) {
    const int tok = t0 + i;
    const float c0 = bflo(bww[i]) * (wc0.x * bflo(cxw[i]) + wc1.x * bflo(cxw[i + 1]) + wc2.x * bflo(cxw[i + 2]));
    const float c1 = bfhi(bww[i]) * (wc0.y * bfhi(cxw[i]) + wc1.y * bfhi(cxw[i + 1]) + wc2.y * bfhi(cxw[i + 2]));
    *reinterpret_cast<unsigned*>(p.cat + (size_t)tok * D + ch) = pack2(c0, c1);
  }
  __syncthreads();
#pragma unroll
  for (int hf = 0; hf < 2; ++hf) {
    float2 z[8];
#pragma unroll
    for (int i = 0; i < 8; ++i) z[i] = bias;
    const u16* Gh = G + hf * 8 * 512 + ch;
#pragma unroll
    for (int r = 0; r < 38; ++r) {
      const unsigned gv = *reinterpret_cast<const unsigned*>(Gh + r * 512);
      const float g0 = bflo(gv), g1 = bfhi(gv);
#pragma unroll
      for (int i = 0; i < 8; ++i) {
        const int j = r - i;
        if (j >= 0 && j <= 30) { z[i].x += w[j].x * g0; z[i].y += w[j].y * g1; }
      }
    }
    float* rd = red + hf * 64;
#pragma unroll
    for (int i = 0; i < 8; ++i) {
      const float sv2 = wave_sum(z[i].x + z[i].y);
      if (lane == 0) rd[wid * 8 + i] = sv2;
    }
    __syncthreads();
    float mu[8];
#pragma unroll
    for (int i = 0; i < 8; ++i) mu[i] = (rd[i] + rd[8 + i] + rd[16 + i] + rd[24 + i]) * (1.f / 512.f);
#pragma unroll
    for (int i = 0; i < 8; ++i) {
      const float d0 = z[i].x - mu[i], d1 = z[i].y - mu[i];
      const float sv2 = wave_sum(d0 * d0 + d1 * d1);
      if (lane == 0) rd[32 + wid * 8 + i] = sv2;
    }
    __syncthreads();
#pragma unroll
    for (int i = 0; i < 8; ++i) {
      const float rstd = rsqrtf((rd[32 + i] + rd[40 + i] + rd[48 + i] + rd[56 + i]) * (1.f / 512.f) + 1e-6f);
      const int tok = t0 + hf * 8 + i;
      const unsigned gd = gdw[hf * 8 + i];
      const float l0 = (z[i].x - mu[i]) * rstd * lg.x + lb.x;
      const float l1 = (z[i].y - mu[i]) * rstd * lg.y + lb.y;
      *reinterpret_cast<unsigned*>(p.cat + (size_t)tok * D + 512 + ch) = pack2(silu_f(l0) * bflo(gd), silu_f(l1) * bfhi(gd));
    }
  }
}

__device__ void phase_odd_mix(const P& p, char* smem) {
  if ((gridDim.x & 7) == 0) {
    const int xcd = blockIdx.x & 7, gl = gridDim.x >> 3;
    for (int j = blockIdx.x >> 3; j < 48; j += gl) odd_unit(p, xcd * 48 + j, smem);
    return;
  }
  for (int u = blockIdx.x; u < NTOK / 16; u += gridDim.x) odd_unit(p, u, smem);
}

__device__ void phase_final(const P& p) {
  const int lane = threadIdx.x & 63, wid = threadIdx.x >> 6;
  const bool xpart = (gridDim.x & 7) == 0;
  const int nrow = xpart ? 768 : NTOK, rstep = xpart ? (int)(gridDim.x >> 3) * 4 : (int)gridDim.x * 4;
  for (int rr = (xpart ? (int)(blockIdx.x >> 3) : (int)blockIdx.x) * 4 + wid; rr < nrow; rr += rstep) {
    const int tok = xpart ? (int)(blockIdx.x & 7) * 768 + rr : rr;
    const float* x = p.x1 + (size_t)tok * D;
    float4 v[4];
    float ss = 0.f;
#pragma unroll
    for (int i = 0; i < 4; ++i) {
      v[i] = *reinterpret_cast<const float4*>(x + i * 256 + lane * 4);
      ss += v[i].x * v[i].x + v[i].y * v[i].y + v[i].z * v[i].z + v[i].w * v[i].w;
    }
    ss = wave_sum(ss);
    const float rinv = rsqrtf(ss * (1.f / 1024.f) + 1e-6f);
#pragma unroll
    for (int i = 0; i < 4; ++i) {
      const int k = i * 256 + lane * 4;
      float4 gg = *reinterpret_cast<const float4*>(p.final_g + k);
      float4 o = make_float4(v[i].x * rinv * gg.x, v[i].y * rinv * gg.y, v[i].z * rinv * gg.z, v[i].w * rinv * gg.w);
      *reinterpret_cast<float4*>(p.out + (size_t)tok * D + k) = o;
    }
  }
}

#define XB_TMO      128
#define XB_XCNT(j)  (256  + 64 * (j))
#define XB_XSUB(j)  (1280 + 64 * (j))
#define XB_XGEN(j)  (2304 + 64 * (j))
#define XB_TOP      3328
#define XB_TOPGEN   3392
#define XCD_BAR_WORDS 3456
#define XB_SPIN_CAP (1u << 18)
#define LAS __attribute__((address_space(3)))

__device__ __forceinline__ unsigned xb_ld(unsigned* p)              { return __hip_atomic_load(p, __ATOMIC_RELAXED, __HIP_MEMORY_SCOPE_AGENT); }
__device__ __forceinline__ unsigned xb_add(unsigned* p, unsigned v) { return __hip_atomic_fetch_add(p, v, __ATOMIC_RELAXED, __HIP_MEMORY_SCOPE_AGENT); }
__device__ __forceinline__ unsigned xb_xcc_id() { return (unsigned)__builtin_amdgcn_s_getreg((3 << 11) | 20) & 0xFu; }
#define XB_SPIN(cond, bar) do { unsigned _sp = 0; while (cond) { __builtin_amdgcn_s_sleep(1); \
    if ((++_sp & 255u) == 0u) { if (xb_ld(&(bar)[XB_TMO])) break; if (_sp > XB_SPIN_CAP) { atomicAdd(&(bar)[XB_TMO], 1u); break; } } } } while (0)

struct XcdBarrier {
    unsigned* bar; unsigned x;
    unsigned nloc, nx;
    volatile unsigned* st;
};

__device__ __forceinline__ XcdBarrier xcd_barrier_post(unsigned* bar, volatile unsigned* st) {
    XcdBarrier b; b.bar = bar; b.x = xb_xcc_id(); b.st = st; b.nloc = 0u; b.nx = 0u;
    if (threadIdx.x == 0) (void)xb_add(&bar[XB_XCNT(b.x)], 1u);
    return b;
}
__device__ __forceinline__ void xcd_barrier_complete(unsigned* bar, unsigned x, unsigned& nloc, unsigned& nx) {
    const unsigned G = gridDim.x * gridDim.y * gridDim.z;
    unsigned sum, cnt, mine, sp = 0u;
    for (;;) {
        sum = 0u; cnt = 0u; mine = 0u;
#pragma unroll
        for (unsigned j = 0; j < 16; ++j) { const unsigned c = xb_ld(&bar[XB_XCNT(j)]); sum += c; cnt += (c > 0u) ? 1u : 0u; mine = (j == x) ? c : mine; }
        if (sum == G) break;
        __builtin_amdgcn_s_sleep(1);
        if ((++sp & 255u) == 0u) { if (xb_ld(&bar[XB_TMO])) break; if (sp > XB_SPIN_CAP) { atomicAdd(&bar[XB_TMO], 1u); break; } }
    }
    nloc = mine > 0u ? mine : 1u; nx = cnt > 0u ? cnt : 1u;
}

__device__ __forceinline__ void xcd_barrier(XcdBarrier& b) {
    asm volatile("s_waitcnt vmcnt(0)" ::: "memory");
    __syncthreads();
    if (threadIdx.x == 0) {
        unsigned* bar = b.bar;
        __builtin_amdgcn_s_waitcnt(0);
        unsigned nloc = b.nloc, nx = b.nx;
        if (nloc == 0u) { xcd_barrier_complete(bar, b.x, nloc, nx); b.nloc = nloc; b.nx = nx; }
        const unsigned old = xb_add(&bar[XB_XSUB(b.x)], 1u);
        const unsigned gen = old / nloc;
        if (old + 1u == (gen + 1u) * nloc) {
            __builtin_amdgcn_fence(__ATOMIC_RELEASE, "agent");
            asm volatile("s_waitcnt vmcnt(0)" ::: "memory");
            const unsigned og = xb_add(&bar[XB_TOP], 1u);
            const unsigned tg = og / nx;
            if (og + 1u == (tg + 1u) * nx) xb_add(&bar[XB_TOPGEN], 1u);
            else XB_SPIN(xb_ld(&bar[XB_TOPGEN]) == tg, bar);
            __builtin_amdgcn_fence(__ATOMIC_ACQUIRE, "agent");
            xb_add(&bar[XB_XGEN(b.x)], 1u);
            asm volatile("s_waitcnt vmcnt(0)" ::: "memory");
        } else {
            XB_SPIN(xb_ld(&bar[XB_XGEN(b.x)]) == gen, bar);
            __builtin_amdgcn_fence(__ATOMIC_ACQUIRE, "agent");
            asm volatile("s_waitcnt vmcnt(0)" ::: "memory");
        }
    }
    __syncthreads();
}


template <int PH>
__device__ __forceinline__ void run_phase(const P& p, char* smem) {
  if (PH == 0) phase0(p, smem);
  if (PH == 1) phase_norm(p, 0, p.x_prompt, p.x_sample);
  if (PH == 2) gemm_phase<0, 96>(p, p.h, p.wt_in_even, IN_E, smem);
  if (PH == 3) phase_even_mix(p, smem);
  if (PH == 4) gemm_phase<1, 96>(p, p.cat, p.wt_out_even, D, smem);
  if (PH == 6) gemm_phase<2, 96>(p, p.h, p.wt_in_odd, IN_O, smem);
  if (PH == 7) phase_odd_mix(p, smem);
  if (PH == 8) gemm_phase<3, 96>(p, p.cat, p.wt_out_odd, D, smem);
  if (PH == 9) phase_final(p);
}

__global__ void __launch_bounds__(NTHR, 2) mega_kernel(P p) {
  __shared__ __attribute__((aligned(16))) char smem[SMEM_BYTES];
  cg::grid_group grid = cg::this_grid();
  XcdBarrier xb = xcd_barrier_post(p.bar, (volatile unsigned*)(p.bar + XCD_BAR_WORDS + 64 * blockIdx.x));
  if (p.use_cg) grid.sync();
#define RUNP(PH) do { run_phase<PH>(p, smem); if ((PROBE_REPEAT >> PH) & 1) { xcd_barrier(xb); run_phase<PH>(p, smem); } } while (0)
#define GSYNC() do { xcd_barrier(xb); if (PROBE_SYNC2) xcd_barrier(xb); } while (0)
  RUNP(0); GSYNC();
  RUNP(1); GSYNC();
  RUNP(2); GSYNC();
  RUNP(3); GSYNC();
  RUNP(4); GSYNC();
  RUNP(6); GSYNC();
  RUNP(7); GSYNC();
  run_phase<8>(p, smem); GSYNC();
  RUNP(9);
}

template <int PH>
__global__ void __launch_bounds__(NTHR, 2) phase_kernel(P p) {
  __shared__ __attribute__((aligned(16))) char smem[SMEM_BYTES];
  run_phase<PH>(p, smem);
}

constexpr int BAR_TOTAL_WORDS = XCD_BAR_WORDS + 64 * 2048;
static inline size_t align_up(size_t x) { return (x + 255) & ~(size_t)255; }

extern "C" void kernel_launch(void* const* d_in, const int* in_sizes, int n_in, void* d_out, int out_size, void* d_ws,
                              size_t ws_size, hipStream_t stream) {
  P p{};
  const float** f = reinterpret_cast<const float**>(&p);
  for (int i = 0; i < 22; ++i) f[i] = (const float*)d_in[i];
  p.out = (float*)d_out;
  char* w = (char*)d_ws;
  size_t off = 0;
  p.mod = (float*)(w + off); off = align_up(off + (size_t)2 * 3 * 3072 * 4);
  p.wt_in_even = (u16*)(w + off); off = align_up(off + (size_t)IN_E * D * 2);
  p.wt_out_even = (u16*)(w + off); off = align_up(off + (size_t)D * D * 2);
  p.wt_in_odd = (u16*)(w + off); off = align_up(off + (size_t)IN_O * D * 2);
  p.wt_out_odd = (u16*)(w + off); off = align_up(off + (size_t)D * D * 2);
  p.wpt = (u16*)(w + off); off = align_up(off + (size_t)4 * 128 * 128 * 2);
  p.h = (u16*)(w + off); off = align_up(off + (size_t)NTOK * D * 2);
  p.proj = (u16*)(w + off); off = align_up(off + (size_t)NTOK * IN_O * 2);
  p.cat = (u16*)(w + off); off = align_up(off + (size_t)NTOK * D * 2);
  p.x1 = (float*)(w + off); off = align_up(off + (size_t)NTOK * D * 4);
  p.kcb = (u16*)(w + off); off = align_up(off + (size_t)262144 * 2);
  p.vcb = (u16*)(w + off); off = align_up(off + (size_t)262144 * 2);
  p.rowss = (float*)(w + off); off = align_up(off + (size_t)NTOK * 16 * 4);
  p.bias1 = (float*)(w + off); off = align_up(off + (size_t)3 * IN_O * 4);
  p.bar = (unsigned*)(w + off); off = align_up(off + (size_t)BAR_TOTAL_WORDS * 4);
  p.use_cg = 0ull;

#if MULTI_LAUNCH
  const int G = 1024;
  phase_kernel<0><<<G, NTHR, 0, stream>>>(p);
  phase_kernel<1><<<G, NTHR, 0, stream>>>(p);
  phase_kernel<2><<<G, NTHR, 0, stream>>>(p);
  phase_kernel<3><<<G, NTHR, 0, stream>>>(p);
  phase_kernel<4><<<G, NTHR, 0, stream>>>(p);
  phase_kernel<6><<<G, NTHR, 0, stream>>>(p);
  phase_kernel<7><<<G, NTHR, 0, stream>>>(p);
  phase_kernel<8><<<G, NTHR, 0, stream>>>(p);
  phase_kernel<9><<<G, NTHR, 0, stream>>>(p);
#else
  static int grid_blocks = 0;
  if (!grid_blocks) {
    int dev = 0, cus = 0, per_cu = 0;
    hipGetDevice(&dev);
    hipDeviceGetAttribute(&cus, hipDeviceAttributeMultiprocessorCount, dev);
    hipOccupancyMaxActiveBlocksPerMultiprocessor(&per_cu, mega_kernel, NTHR, 0);
    if (per_cu < 1) per_cu = 1;
    grid_blocks = cus * per_cu;
  }
  (void)hipMemsetAsync(p.bar, 0, (size_t)BAR_TOTAL_WORDS * 4, stream);
  void* args[] = {&p};
  hipError_t e = hipLaunchCooperativeKernel((void*)mega_kernel, dim3(grid_blocks), dim3(NTHR), args, 0, stream);
  if (e != hipSuccess) fprintf(stderr, "cooperative launch failed: %s (grid %d)\n", hipGetErrorString(e), grid_blocks);
#endif
}
```
